# Optimizing an MI355X kernel written in HIP

```python
import jax, jax.numpy as jnp
from jax import lax
import numpy as np

D_MODEL = 1024
BATCH = 4
SEQ = 8192
DEPTH = 2

CHUNK = 64
PLE_DIM = 256
EPS = 1e-6
POOL_WINDOWS = (2, 4, 8, 16)
POOL_GROUPS = len(POOL_WINDOWS)
POOL_WIDTH = D_MODEL // 4
POOL_GROUP_DIM = POOL_WIDTH // POOL_GROUPS
SGU_BLOCK = 128
SGU_WIDTH = D_MODEL // 4
SGU_GROUPS = 4
SGU_GROUP_DIM = SGU_WIDTH // SGU_GROUPS
HEAD_DIM = 64
ATT_WIDTH = D_MODEL // 2
ATT_HEADS = ATT_WIDTH // HEAD_DIM
LEFT_CHUNKS = 8
BAND = (LEFT_CHUNKS + 1) * CHUNK
REL_CLIP = 128
N_BRANCH = 3
SPLITS = (POOL_WIDTH, SGU_WIDTH, SGU_WIDTH, ATT_WIDTH, ATT_WIDTH, ATT_WIDTH)
IN_WIDTH = sum(SPLITS) + N_BRANCH * D_MODEL
N_GROUPS = 4
EXPERTS_PER_GROUP = 8
N_EXPERTS = N_GROUPS * EXPERTS_PER_GROUP
D_EXPERT = 128
TOP_K = 2

kernel_name = "hybrid_pool_sgu_chunkattn_hmoe_ple"


def rms_norm(x, g):
    xf = x.astype(jnp.float32)
    y = xf * lax.rsqrt(jnp.mean(xf * xf, axis=-1, keepdims=True) + EPS)
    return (y * g.astype(jnp.float32)).astype(x.dtype)


def pool_mixer(a, w_pool, scale):
    B, S, _ = a.shape
    a4 = a.reshape(B, S, POOL_GROUPS, POOL_GROUP_DIM)
    af = a4.astype(jnp.float32)
    cs = jnp.cumsum(af, axis=1)
    pos = jnp.arange(1, S + 1, dtype=jnp.float32)
    means = []
    for gi, w in enumerate(POOL_WINDOWS):
        c = cs[:, :, gi]
        lag = jnp.pad(c, ((0, 0), (w, 0), (0, 0)))[:, :S]
        cnt = jnp.minimum(pos, float(w))[None, :, None]
        means.append((c - lag) / cnt)
    pooled = (jnp.stack(means, axis=2) - af).astype(a.dtype)
    y = jnp.einsum('bsgc,gcd->bsgd', pooled, w_pool)
    return y.reshape(B, S, POOL_WIDTH) * scale


def sgu_mixer(u, v, g_norm, w_s, b_s):
    B, S, _ = u.shape
    nb = S // SGU_BLOCK
    v = rms_norm(v, g_norm)
    vb = v.reshape(B, nb, SGU_BLOCK, SGU_GROUPS, SGU_GROUP_DIM)
    i = jnp.arange(SGU_BLOCK)
    mask = (i[None, :] // CHUNK) <= (i[:, None] // CHUNK)
    w = jnp.where(mask[None], w_s, 0)
    mixed = jnp.einsum('gij,bnjgc->bnigc', w, vb) + b_s.T[None, None, :, :, None]
    return u * mixed.reshape(B, S, SGU_WIDTH)


def chunk_attention(q, k, v, gq, gk, rel_bias):
    B, S, H, Dh = q.shape
    nc = S // CHUNK
    q = rms_norm(q, gq)
    k = rms_norm(k, gk)
    pad = LEFT_CHUNKS * CHUNK
    kp = jnp.pad(k, ((0, 0), (pad, 0), (0, 0), (0, 0))).reshape(B, nc + LEFT_CHUNKS, CHUNK, H, Dh)
    vp = jnp.pad(v, ((0, 0), (pad, 0), (0, 0), (0, 0))).reshape(B, nc + LEFT_CHUNKS, CHUNK, H, Dh)
    qc = q.reshape(B, nc, CHUNK, H, Dh)
    band_idx = jnp.arange(nc)[:, None] + jnp.arange(LEFT_CHUNKS + 1)[None, :]
    valid = jnp.repeat(band_idx >= LEFT_CHUNKS, CHUNK, axis=1)
    rel = jnp.clip(jnp.arange(CHUNK)[:, None] + pad - jnp.arange(BAND)[None, :],
                   -REL_CLIP, REL_CLIP) + REL_CLIP
    bias = rel_bias[:, rel].astype(jnp.float32)
    scale = HEAD_DIM ** -0.5

    def one_sequence(args):
        qb, kb, vb = args
        kband = kb[band_idx].reshape(nc, BAND, H, Dh)
        vband = vb[band_idx].reshape(nc, BAND, H, Dh)
        s = jnp.einsum('nqhd,nkhd->nhqk', qb, kband).astype(jnp.float32) * scale + bias[None]
        s = jnp.where(valid[:, None, None, :], s, -1e30)
        pr = jax.nn.softmax(s, axis=-1).astype(vb.dtype)
        return jnp.einsum('nhqk,nkhd->nqhd', pr, vband)

    o = lax.map(one_sequence, (qc, kp, vp))
    return o.reshape(B, S, H * Dh)


def hier_moe(h, w_gr, b_gr, w_er, b_er, w_e_in, w_e_out):
    def per_sequence(hs):
        S = hs.shape[0]
        g_prob = jax.nn.softmax((hs @ w_gr).astype(jnp.float32) + b_gr, axis=-1)
        g_p, g_idx = lax.top_k(g_prob, 1)
        e_logits = ((hs @ w_er).astype(jnp.float32) + b_er).reshape(S, N_GROUPS, EXPERTS_PER_GROUP)
        e_logits = jnp.einsum('sge,sg->se', e_logits,
                              jax.nn.one_hot(g_idx[:, 0], N_GROUPS, dtype=jnp.float32))
        e_prob = jax.nn.softmax(e_logits, axis=-1)
        e_p, e_idx = lax.top_k(e_prob, TOP_K)
        w = g_p * e_p / jnp.sum(e_p, axis=-1, keepdims=True)
        gid = g_idx * EXPERTS_PER_GROUP + e_idx
        gates = jnp.einsum('sk,ske->se', w, jax.nn.one_hot(gid, N_EXPERTS, dtype=jnp.float32))
        hu = jnp.einsum('sd,edf->sef', hs, w_e_in)
        gt, up = jnp.split(hu, 2, axis=-1)
        act = jax.nn.silu(gt) * up * gates[:, :, None].astype(hs.dtype)
        return jnp.einsum('sef,efd->sd', act, w_e_out)
    return lax.map(per_sequence, h)


def setup_inputs(seed: int = 0) -> dict:
    key = jax.random.key(seed)
    ks = iter(jax.random.split(key, 32))
    f32 = jnp.float32

    def nrm(shape, scale):
        return jax.random.normal(next(ks), shape, f32) * scale

    L = DEPTH
    return {
        "x": nrm((BATCH, SEQ, D_MODEL), 1.0),
        "p": nrm((DEPTH, BATCH, SEQ, PLE_DIM), 1.0),
        "mix_norm_g": 1.0 + nrm((L, D_MODEL), 0.05),
        "w_in": nrm((L, D_MODEL, IN_WIDTH), D_MODEL ** -0.5),
        "pool_w": nrm((L, POOL_GROUPS, POOL_GROUP_DIM, POOL_GROUP_DIM), POOL_GROUP_DIM ** -0.5),
        "pool_scale": 1.0 + nrm((L, POOL_WIDTH), 0.1),
        "sgu_norm_g": 1.0 + nrm((L, SGU_WIDTH), 0.05),
        "sgu_w": nrm((L, SGU_GROUPS, SGU_BLOCK, SGU_BLOCK), SGU_BLOCK ** -0.5),
        "sgu_b": 1.0 + nrm((L, SGU_GROUPS, SGU_BLOCK), 0.1),
        "q_norm_g": 1.0 + nrm((L, HEAD_DIM), 0.05),
        "k_norm_g": 1.0 + nrm((L, HEAD_DIM), 0.05),
        "rel_bias": nrm((L, ATT_HEADS, 2 * REL_CLIP + 1), 0.5),
        "gate_b": nrm((L, N_BRANCH, D_MODEL), 0.1),
        "w_branch_a": nrm((L, POOL_WIDTH, D_MODEL), POOL_WIDTH ** -0.5),
        "w_branch_b": nrm((L, SGU_WIDTH, D_MODEL), SGU_WIDTH ** -0.5),
        "w_branch_c": nrm((L, ATT_WIDTH, D_MODEL), ATT_WIDTH ** -0.5),
        "w_out": nrm((L, D_MODEL, D_MODEL), D_MODEL ** -0.5),
        "ffn_norm_g": 1.0 + nrm((L, D_MODEL), 0.05),
        "w_group_router": nrm((L, D_MODEL, N_GROUPS), D_MODEL ** -0.5),
        "b_group_router": nrm((L, N_GROUPS), 0.01),
        "w_expert_router": nrm((L, D_MODEL, N_EXPERTS), D_MODEL ** -0.5),
        "b_expert_router": nrm((L, N_EXPERTS), 0.01),
        "w_expert_in": nrm((L, N_EXPERTS, D_MODEL, 2 * D_EXPERT), D_MODEL ** -0.5),
        "w_expert_out": nrm((L, N_EXPERTS, D_EXPERT, D_MODEL), D_EXPERT ** -0.5),
        "ple_norm_g": 1.0 + nrm((L, D_MODEL), 0.05),
        "w_ple_in": nrm((L, PLE_DIM, D_MODEL), PLE_DIM ** -0.5),
        "w_ple_gate": nrm((L, D_MODEL, D_MODEL), D_MODEL ** -0.5),
    }


def reference(x, p, mix_norm_g, w_in, pool_w, pool_scale, sgu_norm_g, sgu_w, sgu_b,
              q_norm_g, k_norm_g, rel_bias, gate_b, w_branch_a, w_branch_b, w_branch_c,
              w_out, ffn_norm_g, w_group_router, b_group_router, w_expert_router,
              b_expert_router, w_expert_in, w_expert_out, ple_norm_g, w_ple_in, w_ple_gate):
    B, S, D = x.shape
    cuts = list(np.cumsum(SPLITS))
    for l in range(DEPTH):
        h = rms_norm(x, mix_norm_g[l])
        z = h @ w_in[l]
        a, u, v, q, k, vv, g = jnp.split(z, cuts, axis=-1)
        y_a = pool_mixer(a, pool_w[l], pool_scale[l])
        y_b = sgu_mixer(jax.nn.gelu(u), jax.nn.gelu(v), sgu_norm_g[l], sgu_w[l], sgu_b[l])
        y_c = chunk_attention(q.reshape(B, S, ATT_HEADS, HEAD_DIM),
                              k.reshape(B, S, ATT_HEADS, HEAD_DIM),
                              vv.reshape(B, S, ATT_HEADS, HEAD_DIM),
                              q_norm_g[l], k_norm_g[l], rel_bias[l])
        gates = jax.nn.sigmoid(g.reshape(B, S, N_BRANCH, D) + gate_b[l])
        merged = (gates[:, :, 0] * (y_a @ w_branch_a[l])
                  + gates[:, :, 1] * (y_b @ w_branch_b[l])
                  + gates[:, :, 2] * (y_c @ w_branch_c[l]))
        x = x + merged @ w_out[l]
        x = x + hier_moe(rms_norm(x, ffn_norm_g[l]), w_group_router[l], b_group_router[l],
                         w_expert_router[l], b_expert_router[l], w_expert_in[l], w_expert_out[l])
        x = x + (p[l] @ w_ple_in[l]) * jax.nn.sigmoid(rms_norm(x, ple_norm_g[l]) @ w_ple_gate[l])
    return x
```

```cpp
#include <hip/hip_runtime.h>
#include <cstdio>
#include <cstdint>

#define LAS __attribute__((address_space(3)))
#define GAS __attribute__((address_space(1)))
typedef unsigned short bf16_t;
typedef short bf16x8 __attribute__((ext_vector_type(8)));
typedef float f32x4 __attribute__((ext_vector_type(4)));
typedef float f32x2 __attribute__((ext_vector_type(2)));
typedef unsigned u32x4 __attribute__((ext_vector_type(4)));
typedef unsigned u32x2 __attribute__((ext_vector_type(2)));
typedef GAS unsigned gu32;
typedef const float* const __attribute__((address_space(4)))* inptr_t;

constexpr int M = 32768, D = 1024, SEQ = 8192, NIN = 5376, DEPTH = 2, PLE = 256;
constexpr int NEXP = 32, DEXP = 128, NPAIR = 112, CAP = 32768;
constexpr float EPS = 1e-6f;
constexpr float LOG2E = 1.4426950408889634f;
constexpr float C2 = 0.125f * LOG2E;

constexpr size_t MiB = 1u << 20;
constexpr size_t WS_CTL = 0, CTL_ZERO_BYTES = 1 * MiB;
constexpr size_t WS_MISC = 1 * MiB;
constexpr size_t MISC_ATTM = 0, MISC_GQK = 1024, MISC_TB = 4096, MISC_TOKE = 32768, MISC_TOKW = 196608, MISC_WM = 524288;
constexpr size_t WS_WR = 2 * MiB, WR_BIAS = 896 * 1024;
constexpr size_t WS_SSX = 3 * MiB, WS_SS1 = 5 * MiB, WS_SS2 = 7 * MiB, WS_SSV = 9 * MiB;
constexpr size_t WS_WGATE = 10 * MiB, WS_WPLE = 14 * MiB;
constexpr size_t WS_WIN = 16 * MiB, WS_WBR = 27 * MiB, WS_WOUT = 29 * MiB, WS_WEIN = 31 * MiB, WS_WEOUT = 47 * MiB;
constexpr size_t WS_PB = 58 * MiB;
constexpr size_t WS_XA = 74 * MiB, WS_XB = 138 * MiB;
constexpr size_t WS_ZA = 202 * MiB, WS_ZU = 218 * MiB, WS_ZV = 234 * MiB, WS_V = 250 * MiB, WS_G = 282 * MiB;
constexpr size_t WS_MERGED = 202 * MiB, WS_H = 202 * MiB, WS_ELIST = 218 * MiB, WS_PLIST = 222 * MiB;
constexpr size_t WS_WIN8 = 21 * MiB;
constexpr size_t WS_X8 = 474 * MiB, WS_X8P = 236 * MiB;
constexpr size_t WS_END = 506 * MiB;
constexpr float SX8 = 8.0f, SW8 = 64.0f, INV_S8 = 1.0f / (8.0f * 64.0f);
constexpr size_t DO_PY = 0, DO_Q = 64 * MiB, DO_K = 96 * MiB;
constexpr int CW_TMO = 0, CW_BAR = 4096, CW_CNT = 16384;

constexpr int LDS_BYTES = 152576;
constexpr int LDSCTL_OFF = 152576 - 2048;

__device__ __forceinline__ float bflo(unsigned w) { return __uint_as_float(w << 16); }
__device__ __forceinline__ float bfhi(unsigned w) { return __uint_as_float(w & 0xffff0000u); }
__device__ __forceinline__ float bf2f(bf16_t h) { return __uint_as_float((unsigned)h << 16); }
typedef __bf16 bf16x2_t __attribute__((ext_vector_type(2)));
__device__ __forceinline__ unsigned cvt_pk_bf16(float lo, float hi) { const f32x2 v = {lo, hi}; const bf16x2_t b = __builtin_convertvector(v, bf16x2_t); return __builtin_bit_cast(unsigned, b); }
__device__ __forceinline__ bf16_t f2bf(float f) { return (bf16_t)(cvt_pk_bf16(f, 0.f) & 0xffffu); }
__device__ __forceinline__ u32x2 pack8_fp8(f32x4 a, f32x4 b, float sc) {
    int lo = __builtin_amdgcn_cvt_pk_fp8_f32(a[0] * sc, a[1] * sc, 0, false); lo = __builtin_amdgcn_cvt_pk_fp8_f32(a[2] * sc, a[3] * sc, lo, true);
    int hi = __builtin_amdgcn_cvt_pk_fp8_f32(b[0] * sc, b[1] * sc, 0, false); hi = __builtin_amdgcn_cvt_pk_fp8_f32(b[2] * sc, b[3] * sc, hi, true);
    return (u32x2){(unsigned)lo, (unsigned)hi}; }
__device__ __forceinline__ float fast_rcp(float x) { return __builtin_amdgcn_rcpf(x); }
__device__ __forceinline__ float fast_exp2(float x) { return __builtin_amdgcn_exp2f(x); }
__device__ __forceinline__ float gelu_t(float x) { const float u = x + 0.044715f * x * x * x; return x * fast_rcp(1.f + fast_exp2(-2.302208198f * u)); }
__device__ __forceinline__ float sigmoid_f(float x) { return fast_rcp(1.f + fast_exp2(-LOG2E * x)); }
__device__ __forceinline__ float silu_f(float x) { return x * sigmoid_f(x); }
__device__ __forceinline__ int opaque(int v) { asm volatile("" : "+v"(v)); return v; }
__device__ __forceinline__ float wave_sum(float v) {
#pragma unroll
    for (int o = 1; o < 64; o <<= 1) v += __shfl_xor(v, o);
    return v;
}
__device__ __forceinline__ u32x4 pack8(f32x4 a, f32x4 b) { u32x4 w; w.x = cvt_pk_bf16(a[0], a[1]); w.y = cvt_pk_bf16(a[2], a[3]); w.z = cvt_pk_bf16(b[0], b[1]); w.w = cvt_pk_bf16(b[2], b[3]); return w; }
__device__ __forceinline__ void unpack8(u32x4 w, f32x4& a, f32x4& b) { a = (f32x4){bflo(w.x), bfhi(w.x), bflo(w.y), bfhi(w.y)}; b = (f32x4){bflo(w.z), bfhi(w.z), bflo(w.w), bfhi(w.w)}; }
__device__ __forceinline__ float sq4(f32x4 a) { return (a[0] * a[0] + a[1] * a[1]) + (a[2] * a[2] + a[3] * a[3]); }
__device__ __forceinline__ float sqpk(u32x4 w) { f32x4 a, b; unpack8(w, a, b); return sq4(a) + sq4(b); }

namespace g8 {
constexpr int BM = 256, BK = 64, HALF = 128, HTB = HALF * BK * 2, STAGE_BYTES = 8 * HTB, NXCD = 8, WGM = 8;
__host__ __device__ __forceinline__ int lds_byte(int r, int c) { const int st = (r >> 4) * 2 + (c >> 5), rr = r & 15, cc = c & 31, ob = rr * 64 + cc * 2; return st * 1024 + (ob ^ (((ob >> 9) & 1) << 5)); }
__host__ __device__ __forceinline__ void stage_rc(int b, int& R, int& C) { const int st = b / 1024, sb = b % 1024, swz = sb ^ (((sb >> 9) & 1) << 5); R = (st >> 1) * 16 + swz / 64; C = (st & 1) * 32 + (swz % 64) / 2; }
__host__ __device__ __forceinline__ int perm32(int rho) { const int n = rho >> 4, i = rho & 15; return 8 * (i >> 2) + 4 * n + (i & 3); }

struct Unit { int pm, pn; };
struct StaticOrder {
    int nM, nN, nwg, G, c;
    __device__ void init(int Mr, int N, int G_, int c_) { nM = Mr / BM; nN = N / BM; nwg = nM * nN; G = G_; c = c_; }
    __device__ bool next(int i, Unit& u) const { return map((long)i * G + c, u); }
    __device__ bool map(long L, Unit& u) const {
        if (L >= nwg) return false;
        int wgid = (int)L; { const int q = nwg / NXCD, r = nwg % NXCD, xcd = wgid % NXCD, off = wgid / NXCD; wgid = (xcd < r ? xcd * (q + 1) : r * (q + 1) + (xcd - r) * q) + off; }
        const int nig = WGM * nN, gid = wgid / nig, fm = gid * WGM, gsz = (nM - fm) < WGM ? (nM - fm) : WGM;
        u.pm = fm + ((wgid % nig) % gsz); u.pn = (wgid % nig) / gsz; return true;
    }
};
struct DenseBase {
    typedef g8::Unit Unit;
    const char* a_base; unsigned lda; const char* b_base; unsigned ldb; int nt; StaticOrder ord;
    unsigned char* ws; unsigned char* dout; inptr_t inq; int l;
    __device__ __forceinline__ bool next(int i, Unit& u) const { return ord.next(i, u); }
    static constexpr bool GATHER = false;
    __device__ __forceinline__ void a_off(const Unit&, const int (&)[2], const int (&)[2], unsigned (&)[2][2]) const {}
    __device__ __forceinline__ const char* a_tile(const Unit& u) const { return a_base + (size_t)u.pm * BM * lda; }
    __device__ __forceinline__ const char* b_tile(const Unit& u, int kt) const { return b_base + (size_t)u.pn * BM * ldb + (size_t)kt * (BK * 2); }
    __device__ __forceinline__ void mid(f32x4 (&)[2][2][4][2], const Unit&, int, int, int, int, int) const {}
};

template <class P, bool HOOK = false, bool FP8 = false>
__device__ __forceinline__ void gemm_phase(LAS unsigned char* lds, const P& S) {
    typedef int v8i __attribute__((ext_vector_type(8))); typedef int v4i __attribute__((ext_vector_type(4)));
    typedef typename P::Unit Unit;
    const int tid = opaque(threadIdx.x), wid = __builtin_amdgcn_readfirstlane(tid >> 6), lane = tid & 63, wr = wid >> 2, wc = wid & 3, fr = lane & 15, fq = lane >> 4;
    const int nt = S.nt;
    int R[2], C[2]; unsigned voffB[2];
#pragma unroll
    for (int i = 0; i < 2; ++i) { stage_rc(tid * 16 + i * 8192, R[i], C[i]); const int Rb = P::PERM ? ((R[i] & ~31) + perm32(R[i] & 31)) : R[i]; voffB[i] = (unsigned)Rb * S.ldb + (unsigned)C[i] * 2u; }
    const size_t hstepB = (size_t)HALF * S.ldb;
    unsigned voffA[2] = {0u, 0u}; size_t hstepA = 0;
    if constexpr (!P::GATHER) { hstepA = (size_t)HALF * S.lda;
#pragma unroll
        for (int i = 0; i < 2; ++i) voffA[i] = (unsigned)R[i] * S.lda + (unsigned)C[i] * 2u; }
    const unsigned ldsw = (unsigned)wid * 1024u;
    const int aoff = lds_byte(wr * 64 + fr, fq * 8), boff = lds_byte(wc * 32 + fr, fq * 8);
    const char* const Ab = S.a_base;
#define G8_SA(b, h) (((b) * 2 + (h)) * HTB)
#define G8_SB(b, h) ((4 + (b) * 2 + (h)) * HTB)
#define G8_STAGE_A(bufoff, sel, h, kt) do { if constexpr (P::GATHER) { _Pragma("unroll") for (int _i = 0; _i < 2; ++_i) \
        __builtin_amdgcn_global_load_lds((const unsigned*)(Ab + (size_t)((sel) ? no[h][_i] : co[h][_i]) + (size_t)(kt) * (BK * 2)), (LAS unsigned*)(lds + (bufoff) + ldsw + _i * 8192), 16, 0, 0); } \
      else { const char* _g = ((sel) ? nA : cA) + (size_t)(h) * hstepA + (size_t)(kt) * (BK * 2); _Pragma("unroll") for (int _i = 0; _i < 2; ++_i) \
        __builtin_amdgcn_global_load_lds((const unsigned*)(_g + voffA[_i]), (LAS unsigned*)(lds + (bufoff) + ldsw + _i * 8192), 16, 0, 0); } } while (0)
#define G8_STAGE_B(bufoff, gbase) do { _Pragma("unroll") for (int _i = 0; _i < 2; ++_i) \
        __builtin_amdgcn_global_load_lds((const unsigned*)((const char*)(gbase) + voffB[_i]), (LAS unsigned*)(lds + (bufoff) + ldsw + _i * 8192), 16, 0, 0); } while (0)
#define G8_LDA(dst, b, h) do { if constexpr (FP8) { _Pragma("unroll") for (int m = 0; m < 4; ++m) { dst##8[m].lo = *(const LAS v4i*)(lds + G8_SA(b, h) + aoff + m * 2048); dst##8[m].hi = *(const LAS v4i*)(lds + G8_SA(b, h) + aoff + m * 2048 + 1024); } } \
      else { _Pragma("unroll") for (int m = 0; m < 4; ++m) _Pragma("unroll") for (int k = 0; k < 2; ++k) dst[m][k] = *(const LAS bf16x8*)(lds + G8_SA(b, h) + aoff + m * 2048 + k * 1024); } } while (0)
#define G8_LDB(dst, b, h) do { if constexpr (FP8) { _Pragma("unroll") for (int n = 0; n < 2; ++n) { dst##8[n].lo = *(const LAS v4i*)(lds + G8_SB(b, h) + boff + n * 2048); dst##8[n].hi = *(const LAS v4i*)(lds + G8_SB(b, h) + boff + n * 2048 + 1024); } } \
      else { _Pragma("unroll") for (int n = 0; n < 2; ++n) _Pragma("unroll") for (int k = 0; k < 2; ++k) dst[n][k] = *(const LAS bf16x8*)(lds + G8_SB(b, h) + boff + n * 2048 + k * 1024); } } while (0)
#define G8_MMA(ai, bj, At, Bt) do { __builtin_amdgcn_s_setprio(1); if constexpr (FP8) { _Pragma("unroll") for (int m = 0; m < 4; ++m) _Pragma("unroll") for (int n = 0; n < 2; ++n) \
        asm volatile("v_mfma_f32_16x16x128_f8f6f4 %0, %1, %2, %0" : "+v"(acc[ai][bj][m][n]) : "v"(Bt##8[n]), "v"(At##8[m])); } \
      else { _Pragma("unroll") for (int m = 0; m < 4; ++m) _Pragma("unroll") for (int n = 0; n < 2; ++n) _Pragma("unroll") for (int k = 0; k < 2; ++k) \
        acc[ai][bj][m][n] = __builtin_amdgcn_mfma_f32_16x16x32_bf16(Bt[n][k], At[m][k], acc[ai][bj][m][n], 0, 0, 0); } __builtin_amdgcn_s_setprio(0); } while (0)
#define G8_WAIT_V(n) asm volatile("s_waitcnt vmcnt(" #n ")" ::: "memory")
#define G8_WAIT_L(n) asm volatile("s_waitcnt lgkmcnt(" #n ")" ::: "memory")
#define G8_BAR __builtin_amdgcn_s_barrier()
#define G8_SCHED __builtin_amdgcn_sched_barrier(0)
    Unit cur, nxt; int ui = 0;
    if (!S.next(0, cur)) return;
    unsigned co[2][2], no[2][2];
    S.a_off(cur, R, C, co);
    const char* cA = nullptr; const char* nA = nullptr;
    if constexpr (!P::GATHER) { cA = S.a_tile(cur); nA = cA; }
    f32x4 acc[2][2][4][2];
#pragma unroll
    for (int a = 0; a < 2; ++a)
#pragma unroll
        for (int b = 0; b < 2; ++b)
#pragma unroll
            for (int m = 0; m < 4; ++m)
#pragma unroll
                for (int n = 0; n < 2; ++n) acc[a][b][m][n] = (f32x4){0.f, 0.f, 0.f, 0.f};
    bf16x8 At[4][2], B0[2][2], B1[2][2]; v8i At8[4], B08[2], B18[2];
    {
        const char* b0 = S.b_tile(cur, 0); const char* b1 = S.b_tile(cur, 1);
        G8_STAGE_B(G8_SB(0, 0), b0); G8_STAGE_B(G8_SB(0, 1), b0 + hstepB); G8_STAGE_A(G8_SA(0, 0), false, 0, 0); G8_STAGE_A(G8_SA(0, 1), false, 1, 0);
        if (wr == 1) G8_BAR;
        G8_WAIT_V(2); G8_BAR;
        G8_STAGE_B(G8_SB(1, 0), b1); G8_STAGE_A(G8_SA(1, 0), false, 0, 1); G8_STAGE_B(G8_SB(1, 1), b1 + hstepB);
        G8_WAIT_V(6); G8_BAR;
    }
    for (;;) {
        const bool has_next = S.next(ui + 1, nxt);
        if (!has_next) nxt = cur;
        S.a_off(nxt, R, C, no);
        if constexpr (!P::GATHER) nA = S.a_tile(nxt);
        for (int t = 0; t < nt; t += 2) {
            const bool last = (t == nt - 2);
            const int k2 = last ? 0 : t + 2, k3 = k2 + 1;
            const char* b2 = last ? S.b_tile(nxt, 0) : S.b_tile(cur, t + 2);
            const char* b3 = last ? S.b_tile(nxt, 1) : S.b_tile(cur, t + 3);
            G8_LDB(B0, 0, 0); G8_LDB(B1, 0, 1); G8_SCHED; G8_LDA(At, 0, 0); G8_STAGE_A(G8_SA(1, 1), false, 1, t + 1);
            G8_WAIT_V(8); G8_WAIT_L(0); G8_BAR; G8_MMA(0, 0, At, B0); G8_MMA(0, 1, At, B1); G8_BAR; G8_SCHED;
            G8_LDA(At, 0, 1); G8_STAGE_B(G8_SB(0, 0), b2); G8_STAGE_B(G8_SB(0, 1), b2 + hstepB); G8_STAGE_A(G8_SA(0, 0), last, 0, k2);
            G8_WAIT_V(8); G8_WAIT_L(0); G8_BAR; G8_MMA(1, 0, At, B0); G8_MMA(1, 1, At, B1); G8_BAR; G8_SCHED;
            G8_LDB(B0, 1, 0); G8_LDB(B1, 1, 1); G8_SCHED; G8_LDA(At, 1, 0); G8_STAGE_A(G8_SA(0, 1), last, 1, k2);
            G8_WAIT_V(8); G8_WAIT_L(0); G8_BAR; G8_MMA(0, 0, At, B0); G8_MMA(0, 1, At, B1); G8_BAR; G8_SCHED;
            G8_LDA(At, 1, 1); G8_STAGE_B(G8_SB(1, 0), b3); G8_STAGE_B(G8_SB(1, 1), b3 + hstepB); G8_STAGE_A(G8_SA(1, 0), last, 0, k3);
            G8_WAIT_V(8); G8_WAIT_L(0); G8_BAR; G8_MMA(1, 0, At, B0); G8_MMA(1, 1, At, B1); G8_BAR; G8_SCHED;
            if constexpr (HOOK) { if (!last) S.mid(acc, cur, t + 2, wr, wc, fr, fq); }
        }
        if constexpr (FP8) asm volatile("s_nop 15\n\ts_nop 15" ::: "memory");
        if (wr == 0) G8_BAR;
        S.epi(acc, cur, wr, wc, fr, fq);
        if (!has_next) break;
#pragma unroll
        for (int a = 0; a < 2; ++a)
#pragma unroll
            for (int b = 0; b < 2; ++b)
#pragma unroll
                for (int m = 0; m < 4; ++m)
#pragma unroll
                    for (int n = 0; n < 2; ++n) acc[a][b][m][n] = (f32x4){0.f, 0.f, 0.f, 0.f};
        cur = nxt; cA = nA;
#pragma unroll
        for (int h = 0; h < 2; ++h)
#pragma unroll
            for (int i = 0; i < 2; ++i) co[h][i] = no[h][i];
        ++ui;
        if (wr == 1) G8_BAR;
    }
    G8_WAIT_V(0);
    G8_BAR;
#undef G8_SA
#undef G8_SB
#undef G8_STAGE_A
#undef G8_STAGE_B
#undef G8_LDA
#undef G8_LDB
#undef G8_MMA
#undef G8_WAIT_V
#undef G8_WAIT_L
#undef G8_BAR
#undef G8_SCHED
}
}

__device__ __forceinline__ float rstd_from(const float* ss, int row, int fq) {
    const f32x4 v = *(const f32x4*)(ss + (size_t)row * 16 + fq * 4);
    float s = (v[0] + v[1]) + (v[2] + v[3]); s += __shfl_xor(s, 16); s += __shfl_xor(s, 32);
    return rsqrtf(s * (1.0f / D) + EPS);
}
__device__ __forceinline__ void rstd8(const float* ss, const int (&rows)[2][4], int fq, float (&rs)[2][4]) {
    f32x4 v[2][4];
#pragma unroll
    for (int ai = 0; ai < 2; ++ai)
#pragma unroll
        for (int m = 0; m < 4; ++m) v[ai][m] = *(const f32x4*)(ss + (size_t)rows[ai][m] * 16 + fq * 4);
#pragma unroll
    for (int ai = 0; ai < 2; ++ai)
#pragma unroll
        for (int m = 0; m < 4; ++m) { float s = (v[ai][m][0] + v[ai][m][1]) + (v[ai][m][2] + v[ai][m][3]); s += __shfl_xor(s, 16); s += __shfl_xor(s, 32); rs[ai][m] = rsqrtf(s * (1.0f / D) + EPS); }
}
__device__ __forceinline__ void rows8(int row0, int (&rows)[2][4]) {
#pragma unroll
    for (int ai = 0; ai < 2; ++ai)
#pragma unroll
        for (int m = 0; m < 4; ++m) rows[ai][m] = row0 + ai * 128 + m * 16;
}
__device__ __forceinline__ size_t gate_off(int pm, int k, int pn, int wid, int lane) { return ((((size_t)pm * 3 + k) * 4 + pn) * 8 + wid) * 8192 + (size_t)lane * 8; }
#define GATE_EL(ai, m, bj) ((((ai) * 4 + (m)) * 2 + (bj)) * 512)
__device__ __forceinline__ u32x2 pack8_u8(f32x4 a, f32x4 b) {
    unsigned lo = 0, hi = 0;
#pragma unroll
    for (int j = 0; j < 4; ++j) { lo = __builtin_amdgcn_cvt_pk_u8_f32(fmaxf(__builtin_rintf(a[j] * 255.0f), 1.0f), j, lo); hi = __builtin_amdgcn_cvt_pk_u8_f32(fmaxf(__builtin_rintf(b[j] * 255.0f), 1.0f), j, hi); }
    return (u32x2){lo, hi}; }
__device__ __forceinline__ void unpack8_u8(u32x2 w, f32x4& a, f32x4& b) {
    a = (f32x4){(float)(w.x & 255u), (float)((w.x >> 8) & 255u), (float)((w.x >> 16) & 255u), (float)(w.x >> 24)};
    b = (f32x4){(float)(w.y & 255u), (float)((w.y >> 8) & 255u), (float)((w.y >> 16) & 255u), (float)(w.y >> 24)}; }

typedef f32x4 Acc[2][2][4][2];
struct InGemm : g8::DenseBase {
    static constexpr bool PERM = true;
    int pn_off; float gsc;
    __device__ __forceinline__ bool next(int i, Unit& u) const {
        if (pn_off == 0 || ord.G != 256) return ord.next(i, u);
        if (i < 5) return ord.map((long)i * 256 + ord.c, u);
        if (ord.c >= 128 && i < 7) return ord.map(1280 + (long)(ord.c - 128) * 2 + (i - 5), u);
        return false;
    }
    __device__ __forceinline__ void epi(Acc& acc, const Unit& u, int wr, int wc, int fr, int fq) const {
        fr = opaque(fr); fq = opaque(fq);
        unsigned char* w_ = ws; unsigned char* d_ = dout; asm volatile("" : "+s"(w_), "+s"(d_));
        bf16_t* Z3 = (bf16_t*)(w_ + WS_ZA); bf16_t* QK = (bf16_t*)(d_ + DO_Q); bf16_t* V = (bf16_t*)(w_ + WS_V); bf16_t* G = (bf16_t*)(w_ + WS_G);
        float* ssv = (float*)(w_ + WS_SSV); const float* ssx = (const float*)(w_ + WS_SSX); const float* gqk = (const float*)(w_ + WS_MISC + MISC_GQK) + l * 128;
        inptr_t in_ = inq; asm volatile("" : "+s"(in_)); const float* gate_b = in_[12] + (size_t)l * 3072;
        const int row0 = opaque(u.pm * 256 + wr * 64 + fr), pn = u.pn + pn_off, cl = wc * 32 + fq * 8;
        int rows[2][4]; rows8(row0, rows); float rs[2][4]; rstd8(ssx, rows, fq, rs);
        if (pn_off) {
#pragma unroll
            for (int ai = 0; ai < 2; ++ai)
#pragma unroll
                for (int m = 0; m < 4; ++m) rs[ai][m] *= gsc;
        }
        if (pn <= 2) {
            bf16_t* O = Z3 + (size_t)pn * ((size_t)M * 256);
#pragma unroll
            for (int ai = 0; ai < 2; ++ai)
#pragma unroll
                for (int m = 0; m < 4; ++m) {
                    const int row = rows[ai][m]; const float r = rs[ai][m]; float sq = 0.f;
#pragma unroll
                    for (int bj = 0; bj < 2; ++bj) {
                        f32x4 a = acc[ai][bj][m][0] * r, b = acc[ai][bj][m][1] * r;
                        if (pn >= 1) {
#pragma unroll
                            for (int j = 0; j < 4; ++j) { a[j] = gelu_t(a[j]); b[j] = gelu_t(b[j]); }
                        }
                        const u32x4 w = pack8(a, b); sq += sqpk(w);
                        *(u32x4*)(O + (size_t)row * 256 + bj * 128 + cl) = w;
                    }
                    if (pn == 2) { sq += __shfl_xor(sq, 16); sq += __shfl_xor(sq, 32); if (fq == 0) ssv[(size_t)row * 4 + wc] = sq; }
                }
        } else if (pn <= 6) {
            const bool isq = pn <= 4; const float* gg = gqk + (isq ? 0 : 64); bf16_t* O = QK + (isq ? (size_t)0 : (size_t)M * 512);
            const int head = 4 * ((pn - 3) & 1) + wc;
            f32x4 gv[2][2];
#pragma unroll
            for (int bj = 0; bj < 2; ++bj)
#pragma unroll
                for (int n = 0; n < 2; ++n) gv[bj][n] = *(const f32x4*)(gg + bj * 32 + fq * 8 + n * 4);
#pragma unroll
            for (int ai = 0; ai < 2; ++ai)
#pragma unroll
                for (int m = 0; m < 4; ++m) {
                    const int row = rows[ai][m]; const float r = rs[ai][m];
                    f32x4 v[2][2]; float sq = 0.f;
#pragma unroll
                    for (int bj = 0; bj < 2; ++bj)
#pragma unroll
                        for (int n = 0; n < 2; ++n) { v[bj][n] = acc[ai][bj][m][n] * r; sq += sq4(v[bj][n]); }
                    sq += __shfl_xor(sq, 16); sq += __shfl_xor(sq, 32);
                    const float ri = rsqrtf(sq * (1.0f / 64.0f) + EPS) * (isq ? C2 : 1.0f);
#pragma unroll
                    for (int bj = 0; bj < 2; ++bj)
                        *(u32x4*)(O + (size_t)row * 512 + head * 64 + bj * 32 + fq * 8) = pack8(v[bj][0] * ri * gv[bj][0], v[bj][1] * ri * gv[bj][1]);
                }
        } else if (pn <= 8) {
#pragma unroll
            for (int ai = 0; ai < 2; ++ai)
#pragma unroll
                for (int m = 0; m < 4; ++m) {
                    const int row = rows[ai][m]; const float r = rs[ai][m];
#pragma unroll
                    for (int bj = 0; bj < 2; ++bj)
                        *(u32x4*)(V + (size_t)row * 512 + (pn - 7) * 256 + bj * 128 + cl) = pack8(acc[ai][bj][m][0] * r, acc[ai][bj][m][1] * r);
                }
        } else {
            const int gc = (pn - 9) * 256, k = (pn - 9) >> 2, pnn = (pn - 9) & 3;
            unsigned char* gp = (unsigned char*)G + gate_off(u.pm, k, pnn, wr * 4 + wc, fq * 16 + fr);
            f32x4 gb[2][2];
#pragma unroll
            for (int bj = 0; bj < 2; ++bj)
#pragma unroll
                for (int n = 0; n < 2; ++n) gb[bj][n] = *(const f32x4*)(gate_b + gc + bj * 128 + cl + n * 4);
#pragma unroll
            for (int ai = 0; ai < 2; ++ai)
#pragma unroll
                for (int m = 0; m < 4; ++m) {
                    const float r = rs[ai][m];
#pragma unroll
                    for (int bj = 0; bj < 2; ++bj) {
                        f32x4 a = acc[ai][bj][m][0] * r + gb[bj][0], b = acc[ai][bj][m][1] * r + gb[bj][1];
#pragma unroll
                        for (int j = 0; j < 4; ++j) { a[j] = sigmoid_f(a[j]); b[j] = sigmoid_f(b[j]); }
                        *(u32x2*)(gp + GATE_EL(ai, m, bj)) = pack8_u8(a, b);
                    }
                }
        }
    }
};
struct StoreGemm : g8::DenseBase {
    static constexpr bool PERM = true;
    int nfree, rank, nunits;
    __device__ __forceinline__ bool next(int i, Unit& u) const { if (rank < 0) return false; const int p = i * nfree + rank; if (p >= nunits) return false; u.pm = p >> 2; u.pn = p & 3; return true; }
    __device__ __forceinline__ void epi(Acc& acc, const Unit& u, int wr, int wc, int fr, int fq) const {
        fr = opaque(fr); fq = opaque(fq);
        unsigned char* w_ = ws; unsigned char* d_ = dout; asm volatile("" : "+s"(w_), "+s"(d_));
        bf16_t* O = (l == 0) ? (bf16_t*)(d_ + DO_PY) : (bf16_t*)(w_ + WS_XA); const int ldo = 1024;
        const int row0 = opaque(u.pm * 256 + wr * 64 + fr), cl = u.pn * 256 + wc * 32 + fq * 8;
#pragma unroll
        for (int ai = 0; ai < 2; ++ai)
#pragma unroll
            for (int m = 0; m < 4; ++m) {
                const int row = row0 + ai * 128 + m * 16;
#pragma unroll
                for (int bj = 0; bj < 2; ++bj) *(u32x4*)(O + (size_t)row * ldo + bj * 128 + cl) = pack8(acc[ai][bj][m][0], acc[ai][bj][m][1]);
            }
    }
};
struct BranchGemm : g8::DenseBase {
    static constexpr bool PERM = true;
    __device__ __forceinline__ void mid(Acc& acc, const Unit& u, int kdone, int wr, int wc, int fr, int fq) const {
        if (kdone != 4 && kdone != 8) return;
        fr = opaque(fr); fq = opaque(fq);
        const int k0 = (kdone == 4) ? 0 : 1;
        unsigned char* w_ = ws; unsigned char* d_ = dout; asm volatile("" : "+s"(w_), "+s"(d_));
        const bf16_t* G = (const bf16_t*)(w_ + WS_G);
        const int lane = opaque(fq * 16 + fr);
        const unsigned char* gn = (const unsigned char*)G + gate_off(u.pm, k0, u.pn, wr * 4 + wc, lane); const unsigned char* gd = (const unsigned char*)G + gate_off(u.pm, k0 + 1, u.pn, wr * 4 + wc, lane);
#pragma unroll
        for (int ai = 0; ai < 2; ++ai) {
            u32x2 nv[4][2], dv[4][2];
#pragma unroll
            for (int m = 0; m < 4; ++m)
#pragma unroll
                for (int bj = 0; bj < 2; ++bj) { nv[m][bj] = *(const u32x2*)(gn + GATE_EL(ai, m, bj)); dv[m][bj] = *(const u32x2*)(gd + GATE_EL(ai, m, bj)); }
#pragma unroll
            for (int m = 0; m < 4; ++m)
#pragma unroll
                for (int bj = 0; bj < 2; ++bj) { f32x4 na, nb, da, db; unpack8_u8(nv[m][bj], na, nb); unpack8_u8(dv[m][bj], da, db);
#pragma unroll
                    for (int j = 0; j < 4; ++j) { acc[ai][bj][m][0][j] *= na[j] * fast_rcp(da[j]); acc[ai][bj][m][1][j] *= nb[j] * fast_rcp(db[j]); } }
            asm volatile("" ::: "memory");
        }
    }
    __device__ __forceinline__ void epi(Acc& acc, const Unit& u, int wr, int wc, int fr, int fq) const {
        fr = opaque(fr); fq = opaque(fq);
        unsigned char* w_ = ws; unsigned char* d_ = dout; asm volatile("" : "+s"(w_), "+s"(d_));
        const bf16_t* G = (const bf16_t*)(w_ + WS_G); bf16_t* Mg = (bf16_t*)(w_ + WS_MERGED);
        const int row0 = opaque(u.pm * 256 + wr * 64 + fr), cl = u.pn * 256 + wc * 32 + fq * 8;
        const unsigned char* gc = (const unsigned char*)G + gate_off(u.pm, 2, u.pn, wr * 4 + wc, fq * 16 + fr);
        u32x2 gv[2][4][2];
#pragma unroll
        for (int ai = 0; ai < 2; ++ai)
#pragma unroll
            for (int m = 0; m < 4; ++m)
#pragma unroll
                for (int bj = 0; bj < 2; ++bj) gv[ai][m][bj] = *(const u32x2*)(gc + GATE_EL(ai, m, bj));
#pragma unroll
        for (int ai = 0; ai < 2; ++ai)
#pragma unroll
            for (int m = 0; m < 4; ++m) {
                const int row = row0 + ai * 128 + m * 16;
#pragma unroll
                for (int bj = 0; bj < 2; ++bj) { f32x4 ga, gb; unpack8_u8(gv[ai][m][bj], ga, gb);
                    *(u32x4*)(Mg + (size_t)row * 1024 + bj * 128 + cl) = pack8(acc[ai][bj][m][0] * (ga * (1.0f / 255.0f)), acc[ai][bj][m][1] * (gb * (1.0f / 255.0f))); }
            }
    }
};
struct OutGemm : g8::DenseBase {
    static constexpr bool PERM = true;
    float alpha;
    __device__ __forceinline__ void epi(Acc& acc, const Unit& u, int wr, int wc, int fr, int fq) const {
        fr = opaque(fr); fq = opaque(fq);
        unsigned char* w_ = ws; unsigned char* d_ = dout; asm volatile("" : "+s"(w_), "+s"(d_));
        bf16_t* X = (bf16_t*)(w_ + (l == 0 ? WS_XA : WS_XB)); float* ss = (float*)(w_ + WS_SS1);
        const int row0 = opaque(u.pm * 256 + wr * 64 + fr), cl = u.pn * 256 + wc * 32 + fq * 8;
#pragma unroll
        for (int ai = 0; ai < 2; ++ai) {
            u32x4 xv[4][2];
#pragma unroll
            for (int m = 0; m < 4; ++m)
#pragma unroll
                for (int bj = 0; bj < 2; ++bj) xv[m][bj] = *(const u32x4*)(X + (size_t)(row0 + ai * 128 + m * 16) * 1024 + bj * 128 + cl);
#pragma unroll
            for (int m = 0; m < 4; ++m) {
                const int row = row0 + ai * 128 + m * 16; float sq = 0.f;
#pragma unroll
                for (int bj = 0; bj < 2; ++bj) { f32x4 pa, pb; unpack8(xv[m][bj], pa, pb);
                    const f32x4 na = pa + acc[ai][bj][m][0] * alpha, nb = pb + acc[ai][bj][m][1] * alpha; const u32x4 w = pack8(na, nb); sq += sqpk(w);
                    *(u32x4*)(X + (size_t)row * 1024 + bj * 128 + cl) = w; *(u32x2*)(w_ + WS_X8 + (size_t)row * 1024 + bj * 128 + cl) = pack8_fp8(na, nb, SX8); }
                sq += __shfl_xor(sq, 16); sq += __shfl_xor(sq, 32);
                if (fq == 0) ss[(size_t)row * 16 + u.pn * 4 + wc] = sq;
            }
            asm volatile("" ::: "memory");
        }
    }
};
struct PleGemm : g8::DenseBase {
    static constexpr bool PERM = true;
    int lastl; float gsc;
    __device__ __forceinline__ void epi(Acc& acc, const Unit& u, int wr, int wc, int fr, int fq) const {
        fr = opaque(fr); fq = opaque(fq);
        unsigned char* w_ = ws; unsigned char* d_ = dout; asm volatile("" : "+s"(w_), "+s"(d_));
        const bf16_t* X = (const bf16_t*)(w_ + (l == 0 ? WS_XA : WS_XB)); bf16_t* Xn = (bf16_t*)(w_ + (l == 0 ? WS_XB : WS_XA)); const bf16_t* Pp = (l == 0) ? (const bf16_t*)(d_ + DO_PY) : (const bf16_t*)(w_ + WS_XA);
        const float* ss2 = (const float*)(w_ + WS_SS2); float* ssn = (float*)(w_ + WS_SSX); float* out = (float*)d_; unsigned char* X8n = w_ + WS_X8;
        const int row0 = opaque(u.pm * 256 + wr * 64 + fr), cl = u.pn * 256 + wc * 32 + fq * 8;
        int rows[2][4]; rows8(row0, rows); float rs[2][4]; rstd8(ss2, rows, fq, rs);
#pragma unroll
        for (int ai = 0; ai < 2; ++ai)
#pragma unroll
            for (int m = 0; m < 4; ++m) rs[ai][m] *= gsc;
#pragma unroll
        for (int ai = 0; ai < 2; ++ai)
#pragma unroll
            for (int mp = 0; mp < 2; ++mp) {
                u32x4 xv[2][2], pv[2][2];
#pragma unroll
                for (int mm = 0; mm < 2; ++mm)
#pragma unroll
                    for (int bj = 0; bj < 2; ++bj) { const size_t off = (size_t)rows[ai][mp * 2 + mm] * 1024 + bj * 128 + cl; xv[mm][bj] = *(const u32x4*)(X + off); pv[mm][bj] = *(const u32x4*)(Pp + off); }
#pragma unroll
                for (int mm = 0; mm < 2; ++mm) {
                    const int m = mp * 2 + mm; const int row = rows[ai][m]; const float r = rs[ai][m]; float sq = 0.f;
#pragma unroll
                    for (int bj = 0; bj < 2; ++bj) {
                        const size_t off = (size_t)row * 1024 + bj * 128 + cl;
                        f32x4 xa, xb, pa, pb; unpack8(xv[mm][bj], xa, xb); unpack8(pv[mm][bj], pa, pb);
                        f32x4 a = acc[ai][bj][m][0] * r, b = acc[ai][bj][m][1] * r;
#pragma unroll
                        for (int j = 0; j < 4; ++j) { a[j] = xa[j] + pa[j] * sigmoid_f(a[j]); b[j] = xb[j] + pb[j] * sigmoid_f(b[j]); }
                        if (lastl) { *(f32x4*)(out + off) = a; *(f32x4*)(out + off + 4) = b; }
                        else { const u32x4 w = pack8(a, b); sq += sqpk(w); *(u32x4*)(Xn + off) = w; *(u32x2*)(X8n + off) = pack8_fp8(a, b, SX8); }
                    }
                    if (!lastl) { sq += __shfl_xor(sq, 16); sq += __shfl_xor(sq, 32); if (fq == 0) ssn[(size_t)row * 16 + u.pn * 4 + wc] = sq; }
                }
                asm volatile("" ::: "memory");
            }
    }
};

#define XB_TMO      128
#define XB_XCNT(j)  (256  + 64 * (j))
#define XB_XSUB(j)  (1280 + 64 * (j))
#define XB_XGEN(j)  (2304 + 64 * (j))
#define XB_TOP      3328
#define XB_TOPGEN   3392
#define XCD_BAR_WORDS 3456
#define XB_SPIN_CAP (1u << 18)

__device__ __forceinline__ unsigned xb_ld(unsigned* p)              { return __hip_atomic_load(p, __ATOMIC_RELAXED, __HIP_MEMORY_SCOPE_AGENT); }
__device__ __forceinline__ unsigned xb_add(unsigned* p, unsigned v) { return __hip_atomic_fetch_add(p, v, __ATOMIC_RELAXED, __HIP_MEMORY_SCOPE_AGENT); }
__device__ __forceinline__ unsigned xb_xcc_id() { return (unsigned)__builtin_amdgcn_s_getreg((3 << 11) | 20) & 0xFu; }
#define XB_SPIN(cond, bar) do { unsigned _sp = 0; while (cond) { __builtin_amdgcn_s_sleep(1); \
    if ((++_sp & 255u) == 0u) { if (xb_ld(&(bar)[XB_TMO])) break; if (_sp > XB_SPIN_CAP) { atomicAdd(&(bar)[XB_TMO], 1u); break; } } } } while (0)

struct XcdBarrier {
    unsigned* bar; unsigned x;
    volatile LAS unsigned* st;
};

__device__ __forceinline__ XcdBarrier xcd_barrier_post(unsigned* bar, volatile LAS unsigned* st) {
    XcdBarrier b; b.bar = bar; b.x = xb_xcc_id(); b.st = st;
    if (threadIdx.x == 0) (void)xb_add(&bar[XB_XCNT(b.x)], 1u);
    return b;
}
__device__ __forceinline__ void xcd_barrier_complete(unsigned* bar, unsigned x, unsigned& nloc, unsigned& nx) {
    const unsigned G = gridDim.x * gridDim.y * gridDim.z;
    unsigned sum, cnt, mine, sp = 0u;
    for (;;) {
        sum = 0u; cnt = 0u; mine = 0u;
#pragma unroll
        for (unsigned j = 0; j < 16; ++j) { const unsigned c = xb_ld(&bar[XB_XCNT(j)]); sum += c; cnt += (c > 0u) ? 1u : 0u; mine = (j == x) ? c : mine; }
        if (sum == G) break;
        __builtin_amdgcn_s_sleep(1);
        if ((++sp & 255u) == 0u) { if (xb_ld(&bar[XB_TMO])) break; if (sp > XB_SPIN_CAP) { atomicAdd(&bar[XB_TMO], 1u); break; } }
    }
    nloc = mine > 0u ? mine : 1u; nx = cnt > 0u ? cnt : 1u;
}

__device__ __forceinline__ void xcd_barrier(const XcdBarrier& b) {
    asm volatile("s_waitcnt vmcnt(0)" ::: "memory");
    __syncthreads();
    if (threadIdx.x == 0) {
        unsigned* bar = b.bar; unsigned bx = b.x; asm volatile("" : "+s"(bar), "+s"(bx));
        __builtin_amdgcn_s_waitcnt(0);
        unsigned nloc = b.st[0], nx = b.st[1];
        if (nloc == 0u) { xcd_barrier_complete(bar, bx, nloc, nx); b.st[0] = nloc; b.st[1] = nx; }
        const unsigned old = xb_add(&bar[XB_XSUB(bx)], 1u);
        const unsigned gen = old / nloc;
        if (old + 1u == (gen + 1u) * nloc) {
            __builtin_amdgcn_fence(__ATOMIC_RELEASE, "agent");
            asm volatile("s_waitcnt vmcnt(0)" ::: "memory");
            const unsigned og = xb_add(&bar[XB_TOP], 1u);
            const unsigned tg = og / nx;
            if (og + 1u == (tg + 1u) * nx) xb_add(&bar[XB_TOPGEN], 1u);
            else XB_SPIN(xb_ld(&bar[XB_TOPGEN]) == tg, bar);
            __builtin_amdgcn_fence(__ATOMIC_ACQUIRE, "agent");
            xb_add(&bar[XB_XGEN(bx)], 1u);
            asm volatile("s_waitcnt vmcnt(0)" ::: "memory");
        } else {
            XB_SPIN(xb_ld(&bar[XB_XGEN(bx)]) == gen, bar);
            __builtin_amdgcn_fence(__ATOMIC_ACQUIRE, "agent");
            asm volatile("s_waitcnt vmcnt(0)" ::: "memory");
        }
    }
    __syncthreads();
}

struct Args { const float* in[27]; float* out; unsigned char* ws; int rep_n, pad; };
struct Frame {
    LAS unsigned char* lds; gu32* ctl; unsigned char* ws; unsigned char* dout;
    int tid, lane, wave, G, gw, NGW;
    inptr_t in;
};

__device__ __forceinline__ void transpose_item(const float* src, int src_ld, int k0, int src_col0, bf16_t* dst, int dst_ld, int dst_row0, int dst_k0, const float* kscale, LAS float* scr, int lane, float fp8s = 0.f) {
#pragma unroll 8
    for (int i = 0; i < 32; ++i) { const int kk = 2 * i + (lane >> 5); float v = src[(size_t)(k0 + kk) * src_ld + src_col0 + (lane & 31)]; if (kscale) v *= kscale[k0 + kk]; scr[kk * 33 + (lane & 31)] = v; }
    asm volatile("s_waitcnt lgkmcnt(0)" ::: "memory");
    const int c = lane & 7;
#pragma unroll
    for (int j = 0; j < 4; ++j) { const int n = (lane >> 3) + 8 * j; const LAS float* s = scr + (8 * c) * 33 + n;
        if (fp8s != 0.f) { const f32x4 a = {s[0 * 33], s[1 * 33], s[2 * 33], s[3 * 33]}, b = {s[4 * 33], s[5 * 33], s[6 * 33], s[7 * 33]};
            *(u32x2*)((unsigned char*)dst + (size_t)(dst_row0 + n) * dst_ld + dst_k0 + k0 + 8 * c) = pack8_fp8(a, b, fp8s); continue; }
        u32x4 o; o.x = cvt_pk_bf16(s[0 * 33], s[1 * 33]); o.y = cvt_pk_bf16(s[2 * 33], s[3 * 33]); o.z = cvt_pk_bf16(s[4 * 33], s[5 * 33]); o.w = cvt_pk_bf16(s[6 * 33], s[7 * 33]);
        *(u32x4*)(dst + (size_t)(dst_row0 + n) * dst_ld + dst_k0 + k0 + 8 * c) = o; }
    asm volatile("s_waitcnt lgkmcnt(0)" ::: "memory");
}
__device__ __forceinline__ void transpose_item64(const float* src, int src_ld, int k0, int col0a, int col0b, bf16_t* dst, int dst_ld, int dst_row0, int dst_k0, const float* kscale, LAS float* scr, int lane, float fp8s = 0.f) {
    const int cq = lane & 15, kr = lane >> 4; const int scol = (cq < 8) ? col0a + 4 * cq : col0b + 4 * (cq - 8);
    f32x4 v[16];
#pragma unroll
    for (int i = 0; i < 16; ++i) v[i] = *(const f32x4*)(src + (size_t)(k0 + kr + 4 * i) * src_ld + scol);
    if (kscale) {
#pragma unroll
        for (int i = 0; i < 16; ++i) v[i] = v[i] * kscale[k0 + kr + 4 * i];
    }
#pragma unroll
    for (int i = 0; i < 16; ++i) { LAS float* p = scr + (4 * cq) * 65 + kr + 4 * i; p[0] = v[i][0]; p[65] = v[i][1]; p[130] = v[i][2]; p[195] = v[i][3]; }
    asm volatile("s_waitcnt lgkmcnt(0)" ::: "memory");
    const int c = lane & 7;
#pragma unroll
    for (int j = 0; j < 8; ++j) { const int n = (lane >> 3) + 8 * j; const LAS float* q = scr + n * 65 + 8 * c;
        const f32x4 a = {q[0], q[1], q[2], q[3]}, b = {q[4], q[5], q[6], q[7]};
        if (fp8s != 0.f) *(u32x2*)((unsigned char*)dst + (size_t)(dst_row0 + n) * dst_ld + dst_k0 + k0 + 8 * c) = pack8_fp8(a, b, fp8s);
        else *(u32x4*)(dst + (size_t)(dst_row0 + n) * dst_ld + dst_k0 + k0 + 8 * c) = pack8(a, b); }
    asm volatile("s_waitcnt lgkmcnt(0)" ::: "memory");
}
__device__ __forceinline__ int win_src_col(int n) {
    const int pn = n >> 8, c = n & 255;
    if (pn >= 3 && pn <= 6) { const int bj = c >> 7, wcc = (c >> 5) & 3; const int base = (pn <= 4) ? 768 : 1280; return base + (4 * ((pn - 3) & 1) + wcc) * 64 + 32 * bj; }
    return n;
}
__device__ __forceinline__ void prep_layer(Frame& Fr, int l) {
    Frame F = Fr; F.lane = opaque(Fr.lane); F.gw = blockIdx.x * 8 + __builtin_amdgcn_readfirstlane(opaque(Fr.tid) >> 6);
    LAS float* scr = (LAS float*)(F.lds + F.wave * 16896);
    const float* mixg = F.in[2] + (size_t)l * D; const float* w_in = F.in[3] + (size_t)l * D * NIN;
    const float* pool_w = F.in[4] + (size_t)l * 4 * 64 * 64; const float* pool_s = F.in[5] + (size_t)l * 256;
    const float* wba = F.in[13] + (size_t)l * 256 * D; const float* wbb = F.in[14] + (size_t)l * 256 * D; const float* wbc = F.in[15] + (size_t)l * 512 * D;
    const float* wout = F.in[16] + (size_t)l * D * D; const float* ffng = F.in[17] + (size_t)l * D;
    const float* wein = F.in[22] + (size_t)l * NEXP * D * 256; const float* weout = F.in[23] + (size_t)l * NEXP * DEXP * D;
    bf16_t* Win_t = (bf16_t*)(F.ws + WS_WIN); bf16_t* Wbr_t = (bf16_t*)(F.ws + WS_WBR); bf16_t* Wout_t = (bf16_t*)(F.ws + WS_WOUT);
    bf16_t* Wein_t = (bf16_t*)(F.ws + WS_WEIN); bf16_t* Weout_t = (bf16_t*)(F.ws + WS_WEOUT);
    constexpr int I_IN = 16 * 80, I_POOL = 1024, I_BA = 4 * 16, I_BC = 8 * 16, I_OUT = 16 * 16, I_EIN = NEXP * 16 * 4, I_EOUT = NEXP * 2 * 16;
    constexpr int NITEMS = I_IN + I_POOL + 2 * I_BA + I_BC + I_OUT + I_EIN + I_EOUT;
    for (int it = F.gw; it < NITEMS; it += F.NGW) {
        int r = it;
        if (r < I_IN) { const int kb = r / 80, nb = r % 80 + 4;
            if (nb < 36) transpose_item64(w_in, NIN, 64 * kb, win_src_col(64 * nb), win_src_col(64 * nb + 32), Win_t, D, 64 * nb, 0, mixg, scr, F.lane);
            else transpose_item64(w_in, NIN, 64 * kb, 64 * nb, 64 * nb + 32, (bf16_t*)(F.ws + WS_WIN8), D, 64 * (nb - 36), 0, mixg, scr, F.lane, SW8);
            continue; } r -= I_IN;
        if (r < I_POOL) {
            const int nb = r & 7, kb = r >> 3, g = nb >> 1, d0 = (nb & 1) * 32, nn = F.lane & 31, kh = F.lane >> 5, kbase = kb * 8 + kh * 4;
            float a[4] = {0.f, 0.f, 0.f, 0.f};
#pragma unroll 8
            for (int c = 0; c < 64; ++c) { const float pw = pool_w[(size_t)g * 4096 + c * 64 + d0 + nn];
#pragma unroll
                for (int j = 0; j < 4; ++j) a[j] += w_in[(size_t)(kbase + j) * NIN + g * 64 + c] * pw; }
            const float sc = pool_s[g * 64 + d0 + nn];
            u32x2 o; o.x = cvt_pk_bf16(a[0] * sc * mixg[kbase], a[1] * sc * mixg[kbase + 1]); o.y = cvt_pk_bf16(a[2] * sc * mixg[kbase + 2], a[3] * sc * mixg[kbase + 3]);
            *(u32x2*)(Win_t + (size_t)(g * 64 + d0 + nn) * D + kbase) = o; continue; } r -= I_POOL;
        if (r < I_BA) { transpose_item64(wba, D, 64 * (r / 16), 64 * (r % 16), 64 * (r % 16) + 32, Wbr_t, D, 64 * (r % 16), 0, nullptr, scr, F.lane); continue; } r -= I_BA;
        if (r < I_BA) { transpose_item64(wbb, D, 64 * (r / 16), 64 * (r % 16), 64 * (r % 16) + 32, Wbr_t, D, 64 * (r % 16), 256, nullptr, scr, F.lane); continue; } r -= I_BA;
        if (r < I_BC) { transpose_item64(wbc, D, 64 * (r / 16), 64 * (r % 16), 64 * (r % 16) + 32, Wbr_t, D, 64 * (r % 16), 512, nullptr, scr, F.lane); continue; } r -= I_BC;
        if (r < I_OUT) { transpose_item64(wout, D, 64 * (r / 16), 64 * (r % 16), 64 * (r % 16) + 32, Wout_t, D, 64 * (r % 16), 0, nullptr, scr, F.lane); continue; } r -= I_OUT;
        if (r < I_EIN) { const int e = r / 64, q = r % 64; transpose_item64(wein + (size_t)e * D * 256, 256, 64 * (q / 4), 64 * (q % 4), 64 * (q % 4) + 32, (bf16_t*)((unsigned char*)Wein_t + (size_t)e * 256 * D), D, 64 * (q % 4), 0, ffng, scr, F.lane, SW8); continue; } r -= I_EIN;
        { const int e = r / 32, q = r % 32; transpose_item64(weout + (size_t)e * DEXP * D, D, 64 * (q / 16), 64 * (q % 16), 64 * (q % 16) + 32, Weout_t + (size_t)e * D * DEXP, DEXP, 64 * (q % 16), 0, nullptr, scr, F.lane); }
    }
    const float* p = F.in[1] + (size_t)l * M * PLE; bf16_t* pb = (bf16_t*)(F.ws + WS_PB);
#pragma unroll 4
    for (size_t i = (size_t)F.gw * 64 + F.lane; i < (size_t)M * PLE / 8; i += (size_t)F.NGW * 64) {
        const f32x4 a = *(const f32x4*)(p + i * 8), b = *(const f32x4*)(p + i * 8 + 4); *(u32x4*)(pb + i * 8) = pack8(a, b); }
}
__device__ __forceinline__ void prologue(Frame& Fr) {
    Frame F = Fr; F.lane = opaque(Fr.lane); F.gw = blockIdx.x * 8 + __builtin_amdgcn_readfirstlane(opaque(Fr.tid) >> 6);
    LAS float* scr = (LAS float*)(F.lds + F.wave * 16896);
    constexpr int I_G = 16 * 16, I_P = 4 * 16;
    for (int it = F.gw; it < DEPTH * (I_G + I_P); it += F.NGW) {
        const int l = it / (I_G + I_P); int r = it % (I_G + I_P);
        if (r < I_G) { transpose_item64(F.in[26] + (size_t)l * D * D, D, 64 * (r / 16), 64 * (r % 16), 64 * (r % 16) + 32, (bf16_t*)(F.ws + WS_WGATE + (size_t)l * 2 * MiB), D, 64 * (r % 16), 0, F.in[24] + (size_t)l * D, scr, F.lane, SW8); continue; } r -= I_G;
        transpose_item64(F.in[25] + (size_t)l * PLE * D, D, 64 * (r / 16), 64 * (r % 16), 64 * (r % 16) + 32, (bf16_t*)(F.ws + WS_WPLE) + (size_t)l * (512 * 1024), PLE, 64 * (r % 16), 0, nullptr, scr, F.lane);
    }
    for (int i = F.gw * 64 + F.lane; i < DEPTH * 96 * D; i += F.NGW * 64) {
        const int l = i / (96 * D), o = (i / D) % 96, k = i % D; bf16_t r = 0;
        if (o < 72) { const int oo = o < 36 ? o : o - 36;
            const float w = ((oo < 4) ? F.in[18][((size_t)l * D + k) * 4 + oo] : F.in[20][((size_t)l * D + k) * 32 + (oo - 4)]) * F.in[17][(size_t)l * D + k];
            const bf16_t h = f2bf(w); r = (o < 36) ? h : f2bf(w - bf2f(h)); }
        ((bf16_t*)(F.ws + WS_WR))[i] = r;
    }
    if (F.gw == 0) { for (int i = F.lane; i < DEPTH * 36; i += 64) { const int l = i / 36, o = i % 36; ((float*)(F.ws + WS_WR + WR_BIAS))[i] = (o < 4) ? F.in[19][l * 4 + o] : F.in[21][l * 32 + o - 4]; } }
    if (F.gw == 1) { for (int i = F.lane; i < DEPTH * 128; i += 64) { const int l = i >> 7, j = i & 127; ((float*)(F.ws + WS_MISC + MISC_GQK))[i] = (j < 64) ? F.in[9][l * 64 + j] : F.in[10][l * 64 + j - 64]; } }
    for (int i = F.gw * 64 + F.lane; i < DEPTH * 4 * 128 * 128; i += F.NGW * 64) { const int ii = (i >> 7) & 127, jj = i & 127; ((bf16_t*)(F.ws + WS_MISC + MISC_WM))[i] = ((jj >> 6) <= (ii >> 6)) ? f2bf(F.in[7][i]) : (bf16_t)0; }
    for (int i = F.gw * 64 + F.lane; i < DEPTH * 8 * 256; i += F.NGW * 64) { const int lh = i >> 8, ii = i & 255; const int idx = ii + 65 > 256 ? 256 : ii + 65; ((float*)(F.ws + WS_MISC + MISC_TB))[i] = F.in[11][(size_t)lh * 257 + idx] * LOG2E; }
    if (F.gw < DEPTH * 8) {
        const int l = F.gw >> 3; float mq = fabsf(F.in[9][l * 64 + F.lane]), mk = fabsf(F.in[10][l * 64 + F.lane]), mb = -1e30f;
        for (int i = F.lane; i < 257; i += 64) mb = fmaxf(mb, F.in[11][(size_t)F.gw * 257 + i]);
#pragma unroll
        for (int o = 1; o < 64; o <<= 1) { mq = fmaxf(mq, __shfl_xor(mq, o)); mk = fmaxf(mk, __shfl_xor(mk, o)); mb = fmaxf(mb, __shfl_xor(mb, o)); }
        if (F.lane == 0) ((float*)(F.ws + WS_MISC + MISC_ATTM))[F.gw] = (8.0f * mq * mk + mb) * LOG2E;
    }
    bf16_t* XA = (bf16_t*)(F.ws + WS_XA); float* ssx = (float*)(F.ws + WS_SSX);
    for (int m0 = F.gw * 4; m0 < M; m0 += F.NGW * 4) {
        f32x4 v[4][4];
#pragma unroll
        for (int q = 0; q < 4; ++q)
#pragma unroll
            for (int j = 0; j < 4; ++j) v[q][j] = ((const f32x4*)(F.in[0] + (size_t)(m0 + q) * D) + F.lane)[64 * j];
#pragma unroll
        for (int q = 0; q < 4; ++q) { const int m = m0 + q; float s = 0.f;
#pragma unroll
            for (int j = 0; j < 4; ++j) { const f32x4 x = v[q][j]; u32x2 w; w.x = cvt_pk_bf16(x[0], x[1]); w.y = cvt_pk_bf16(x[2], x[3]);
                const float a0 = bflo(w.x), a1 = bfhi(w.x), a2 = bflo(w.y), a3 = bfhi(w.y); s += (a0 * a0 + a1 * a1) + (a2 * a2 + a3 * a3);
                *(u32x2*)(XA + (size_t)m * D + 256 * j + 4 * F.lane) = w;
                { int p8 = __builtin_amdgcn_cvt_pk_fp8_f32(x[0] * SX8, x[1] * SX8, 0, false); p8 = __builtin_amdgcn_cvt_pk_fp8_f32(x[2] * SX8, x[3] * SX8, p8, true); *(int*)(F.ws + WS_X8 + (size_t)m * D + 256 * j + 4 * F.lane) = p8; } }
            s = wave_sum(s);
            if (F.lane < 16) ssx[(size_t)m * 16 + F.lane] = (F.lane == 0) ? s : 0.f; }
    }
}

__device__ __forceinline__ void router_phase(Frame& Fr, int l, const bf16_t* X, const float* ss1, bool dry) {
    typedef float f32x16 __attribute__((ext_vector_type(16)));
    Frame F = Fr; F.lane = opaque(Fr.lane); F.tid = opaque(Fr.tid); F.gw = blockIdx.x * 8 + __builtin_amdgcn_readfirstlane(F.tid >> 6);
    const int lane = F.lane, r16 = lane & 15, kq = lane >> 4;
    const bf16_t* Wt = (const bf16_t*)(F.ws + WS_WR) + (size_t)l * 96 * D; const float* br = (const float*)(F.ws + WS_WR + WR_BIAS) + l * 36;
    LAS float* lg;
    int* tok_e = (int*)(F.ws + WS_MISC + MISC_TOKE); float* tok_w = (float*)(F.ws + WS_MISC + MISC_TOKW);
    int* elist = (int*)(F.ws + WS_ELIST); int* plist = (int*)(F.ws + WS_PLIST);
    gu32* cnt = F.ctl + CW_CNT + (size_t)l * 160 * 64;
    LAS unsigned char* tb = F.lds; constexpr int TPITCH = 272, TBUF = 80 * TPITCH;
    lg = (LAS float*)(F.lds + 45056) + F.wave * (16 * 81);
    const int tid = F.tid;
    for (int wt = blockIdx.x; wt < M / 128; wt += F.G) {
        const int tok0 = wt * 128 + F.wave * 16;
        const bf16_t* xr = X + (size_t)(tok0 + r16) * D + kq * 8;
        u32x4 tr[3]; bf16x8 xc[4], xn[4];
#define RT_LOADT(c) do { _Pragma("unroll") for (int p_ = 0; p_ < 3; ++p_) { const int pc_ = tid + 512 * p_; if (pc_ < 1280) tr[p_] = *(const u32x4*)(Wt + (size_t)(pc_ >> 4) * D + (c) * 128 + (pc_ & 15) * 8); } } while (0)
#define RT_STORET(b) do { _Pragma("unroll") for (int p_ = 0; p_ < 3; ++p_) { const int pc_ = tid + 512 * p_; if (pc_ < 1280) *(LAS u32x4*)(tb + (b) * TBUF + (pc_ >> 4) * TPITCH + (pc_ & 15) * 16) = tr[p_]; } } while (0)
        RT_LOADT(0);
#pragma unroll
        for (int s4 = 0; s4 < 4; ++s4) xc[s4] = *(const bf16x8*)(xr + 32 * s4);
        asm volatile("s_waitcnt lgkmcnt(0)\n\ts_barrier" ::: "memory");
        RT_STORET(0);
        f32x4 a0 = {0.f, 0.f, 0.f, 0.f}, a1 = a0, a2 = a0, a3 = a0, a4 = a0;
#pragma unroll 1
        for (int c = 0; c < 8; ++c) {
            if (c + 1 < 8) { RT_LOADT(c + 1);
#pragma unroll
                for (int s4 = 0; s4 < 4; ++s4) xn[s4] = *(const bf16x8*)(xr + 128 * (c + 1) + 32 * s4); }
            asm volatile("s_waitcnt lgkmcnt(0)\n\ts_barrier" ::: "memory");
            const LAS unsigned char* bb = tb + (c & 1) * TBUF + r16 * TPITCH + kq * 16;
#pragma unroll
            for (int s4 = 0; s4 < 4; ++s4) {
                const bf16x8 b0 = *(const LAS bf16x8*)(bb + s4 * 64), b1 = *(const LAS bf16x8*)(bb + 16 * TPITCH + s4 * 64), b2 = *(const LAS bf16x8*)(bb + 32 * TPITCH + s4 * 64),
                             b3 = *(const LAS bf16x8*)(bb + 48 * TPITCH + s4 * 64), b4 = *(const LAS bf16x8*)(bb + 64 * TPITCH + s4 * 64);
                a0 = __builtin_amdgcn_mfma_f32_16x16x32_bf16(xc[s4], b0, a0, 0, 0, 0); a1 = __builtin_amdgcn_mfma_f32_16x16x32_bf16(xc[s4], b1, a1, 0, 0, 0); a2 = __builtin_amdgcn_mfma_f32_16x16x32_bf16(xc[s4], b2, a2, 0, 0, 0);
                a3 = __builtin_amdgcn_mfma_f32_16x16x32_bf16(xc[s4], b3, a3, 0, 0, 0); a4 = __builtin_amdgcn_mfma_f32_16x16x32_bf16(xc[s4], b4, a4, 0, 0, 0);
            }
            if (c + 1 < 8) { RT_STORET((c + 1) & 1);
#pragma unroll
                for (int s4 = 0; s4 < 4; ++s4) xc[s4] = xn[s4]; }
        }
#undef RT_LOADT
#undef RT_STORET
#pragma unroll
        for (int r = 0; r < 4; ++r) { LAS float* p = lg + (4 * kq + r) * 81 + r16; p[0] = a0[r]; p[16] = a1[r]; p[32] = a2[r]; p[48] = a3[r]; p[64] = a4[r]; }
        asm volatile("s_waitcnt lgkmcnt(0)" ::: "memory");
        if (lane < 16) {
            const int tok = tok0 + lane; const LAS float* q = lg + lane * 81;
            const f32x4* sp = (const f32x4*)(ss1 + (size_t)tok * 16); const f32x4 s0 = sp[0], s1 = sp[1], s2 = sp[2], s3 = sp[3];
            const float ssum = (((s0[0] + s0[1]) + (s0[2] + s0[3])) + ((s1[0] + s1[1]) + (s1[2] + s1[3]))) + (((s2[0] + s2[1]) + (s2[2] + s2[3])) + ((s3[0] + s3[1]) + (s3[2] + s3[3])));
            const float rstd = rsqrtf(ssum * (1.0f / D) + EPS);
#define RLOGIT(o) ((q[(o)] + q[36 + (o)]) * rstd + br[(o)])
            int g = 0; float gm = RLOGIT(0); float gl[4]; gl[0] = gm;
#pragma unroll
            for (int j = 1; j < 4; ++j) { gl[j] = RLOGIT(j); if (gl[j] > gm) { gm = gl[j]; g = j; } }
            float gs = 0.f;
#pragma unroll
            for (int j = 0; j < 4; ++j) gs += __expf(gl[j] - gm);
            const float gp = 1.0f / gs;
            int i1 = 0, i2 = -1; float m1 = -3.0e38f, m2 = -3.0e38f;
            for (int j = 0; j < 8; ++j) { const float v = RLOGIT(4 + 8 * g + j); if (v > m1) { m2 = m1; i2 = i1; m1 = v; i1 = j; } else if (v > m2) { m2 = v; i2 = j; } }
#undef RLOGIT
            const float e2 = __expf(m2 - m1), w1 = gp / (1.0f + e2), w2 = gp * e2 / (1.0f + e2);
            const int a = i1 < i2 ? i1 : i2, b = i1 < i2 ? i2 : i1; const float wlo = i1 < i2 ? w1 : w2, whi = i1 < i2 ? w2 : w1;
            const int lo = g * 8 + a, hh = g * 8 + b, pc = g * 28 + (a * 8 - (a * (a + 1)) / 2) + (b - a - 1);
            tok_e[tok] = lo | (hh << 8) | (pc << 16); tok_w[2 * tok] = wlo; tok_w[2 * tok + 1] = whi;
            if (!dry) {
            const unsigned p0 = __hip_atomic_fetch_add(cnt + 64 * lo, 1u, __ATOMIC_RELAXED, __HIP_MEMORY_SCOPE_AGENT); elist[(size_t)lo * CAP + p0] = tok * 2;
            const unsigned p1 = __hip_atomic_fetch_add(cnt + 64 * hh, 1u, __ATOMIC_RELAXED, __HIP_MEMORY_SCOPE_AGENT); elist[(size_t)hh * CAP + p1] = tok * 2 + 1;
            const unsigned p2 = __hip_atomic_fetch_add(cnt + 64 * (32 + pc), 1u, __ATOMIC_RELAXED, __HIP_MEMORY_SCOPE_AGENT); plist[(size_t)pc * CAP + p2] = tok; }
        }
    }
    __syncthreads();
}

constexpr int LT_PRE = LDSCTL_OFF + 64, LT_CNT = LT_PRE + 116 * 4;
__device__ __forceinline__ void build_class_tables(Frame& F, gu32* cnt, int ncls) {
    LAS int* tpre = (LAS int*)(F.lds + LT_PRE); LAS int* ccnt = (LAS int*)(F.lds + LT_CNT);
    __syncthreads();
    const int tid = opaque(F.tid);
    if (tid < ncls) ccnt[tid] = (int)__hip_atomic_load(cnt + 64 * tid, __ATOMIC_RELAXED, __HIP_MEMORY_SCOPE_AGENT);
    __syncthreads();
    if (tid == 0) { int a = 0; for (int c = 0; c < ncls; ++c) { tpre[c] = a; a += (ccnt[c] + 255) >> 8; } tpre[ncls] = a; }
    __syncthreads();
}
struct Moe1Gemm {
    struct Unit { int pm, pn, e, cnt; };
    static constexpr bool PERM = true, GATHER = true;
    const char* a_base; unsigned lda; const char* b_base; unsigned ldb; int nt; int G, c;
    unsigned char* ws; unsigned char* dout; const LAS int* tpre; const LAS int* ccnt;
    __device__ __forceinline__ bool next(int i, Unit& u) const {
        const int L = i * G + c; if (L >= tpre[NEXP]) return false;
        int e = 0;
#pragma unroll
        for (int st = 16; st >= 1; st >>= 1) { if (tpre[e + st] <= L) e += st; }
        u.e = e; u.pm = L - tpre[e]; u.pn = 0; u.cnt = ccnt[e]; return true;
    }
    __device__ __forceinline__ void a_off(const Unit& u, const int (&R)[2], const int (&C)[2], unsigned (&o)[2][2]) const {
        unsigned char* w_ = ws; unsigned char* d_ = dout; asm volatile("" : "+s"(w_), "+s"(d_));
        const int* elist = (const int*)(w_ + WS_ELIST);
#pragma unroll
        for (int h = 0; h < 2; ++h)
#pragma unroll
            for (int i = 0; i < 2; ++i) { const int r = u.pm * 256 + h * 128 + R[i]; const int ent = (r < u.cnt) ? elist[(size_t)u.e * CAP + r] : 0; o[h][i] = (unsigned)(ent >> 1) * lda + (unsigned)C[i] * 2u; }
    }
    __device__ __forceinline__ const char* a_tile(const Unit&) const { return a_base; }
    __device__ __forceinline__ const char* b_tile(const Unit& u, int kt) const { return b_base + (size_t)u.e * 256 * ldb + (size_t)kt * 128; }
    __device__ __forceinline__ void mid(Acc&, const Unit&, int, int, int, int, int) const {}
    __device__ __forceinline__ void epi(Acc& acc, const Unit& u, int wr, int wc, int fr, int fq) const {
        fr = opaque(fr); fq = opaque(fq);
        unsigned char* w_ = ws; unsigned char* d_ = dout; asm volatile("" : "+s"(w_), "+s"(d_));
        const int* elist = (const int*)(w_ + WS_ELIST); const float* tok_w = (const float*)(w_ + WS_MISC + MISC_TOKW); const float* ss1 = (const float*)(w_ + WS_SS1); bf16_t* H = (bf16_t*)(w_ + WS_H);
        const int r0 = opaque(u.pm * 256 + wr * 64 + fr);
        int ent[2][4], rows[2][4]; float rs[2][4], w[2][4];
#pragma unroll
        for (int ai = 0; ai < 2; ++ai)
#pragma unroll
            for (int m = 0; m < 4; ++m) { const int r = r0 + ai * 128 + m * 16; ent[ai][m] = (r < u.cnt) ? elist[(size_t)u.e * CAP + r] : -1; }
#pragma unroll
        for (int ai = 0; ai < 2; ++ai)
#pragma unroll
            for (int m = 0; m < 4; ++m) { const int e0 = ent[ai][m] < 0 ? 0 : ent[ai][m]; rows[ai][m] = e0 >> 1; w[ai][m] = tok_w[e0]; }
        rstd8(ss1, rows, fq, rs);
#pragma unroll
        for (int ai = 0; ai < 2; ++ai)
#pragma unroll
            for (int m = 0; m < 4; ++m) {
                const float r = rs[ai][m] * INV_S8, ww = w[ai][m]; f32x4 a, b;
#pragma unroll
                for (int j = 0; j < 4; ++j) { a[j] = silu_f(acc[ai][0][m][0][j] * r) * (acc[ai][1][m][0][j] * r) * ww; b[j] = silu_f(acc[ai][0][m][1][j] * r) * (acc[ai][1][m][1][j] * r) * ww; }
                if (ent[ai][m] >= 0) *(u32x4*)(H + (size_t)rows[ai][m] * 256 + (ent[ai][m] & 1) * 128 + wc * 32 + fq * 8) = pack8(a, b);
            }
    }
};
struct Moe2Gemm {
    struct Unit { int pm, pn, lo, hi, cnt, pc; };
    static constexpr bool PERM = true, GATHER = true;
    const char* a_base; unsigned lda; const char* b_base; unsigned ldb; int nt; int G, c;
    unsigned char* ws; unsigned char* dout; int l; const LAS int* tpre; const LAS int* ccnt; float alpha;
    __device__ __forceinline__ bool next(int i, Unit& u) const {
        const int L = i * G + c, T = L >> 2; if (T >= tpre[NPAIR]) return false;
        int pc = 0;
#pragma unroll
        for (int st = 64; st >= 1; st >>= 1) { if (pc + st <= NPAIR && tpre[pc + st] <= T) pc += st; }
        u.pc = pc; u.pm = T - tpre[pc]; u.pn = L & 3; u.cnt = ccnt[pc];
        const int g = pc / 28; int pi = pc - g * 28, a = 0; while (pi >= 7 - a) { pi -= 7 - a; ++a; }
        u.lo = g * 8 + a; u.hi = g * 8 + a + 1 + pi; return true;
    }
    __device__ __forceinline__ void a_off(const Unit& u, const int (&R)[2], const int (&C)[2], unsigned (&o)[2][2]) const {
        unsigned char* w_ = ws; unsigned char* d_ = dout; asm volatile("" : "+s"(w_), "+s"(d_));
        const int* plist = (const int*)(w_ + WS_PLIST);
#pragma unroll
        for (int h = 0; h < 2; ++h)
#pragma unroll
            for (int i = 0; i < 2; ++i) { const int r = u.pm * 256 + h * 128 + R[i]; const int tok = (r < u.cnt) ? plist[(size_t)u.pc * CAP + r] : 0; o[h][i] = (unsigned)tok * lda + (unsigned)C[i] * 2u; }
    }
    __device__ __forceinline__ const char* a_tile(const Unit&) const { return a_base; }
    __device__ __forceinline__ const char* b_tile(const Unit& u, int kt) const { return b_base + (size_t)(kt < 2 ? u.lo : u.hi) * D * ldb + (size_t)u.pn * 256 * ldb + (size_t)(kt & 1) * 128; }
    __device__ __forceinline__ void mid(Acc&, const Unit&, int, int, int, int, int) const {}
    __device__ __forceinline__ void epi(Acc& acc, const Unit& u, int wr, int wc, int fr, int fq) const {
        fr = opaque(fr); fq = opaque(fq);
        unsigned char* w_ = ws; unsigned char* d_ = dout; asm volatile("" : "+s"(w_), "+s"(d_));
        const int* plist = (const int*)(w_ + WS_PLIST); bf16_t* X = (bf16_t*)(w_ + (l == 0 ? WS_XA : WS_XB)); float* ss = (float*)(w_ + WS_SS2); unsigned char* X8p = w_ + WS_X8P;
        const int r0 = opaque(u.pm * 256 + wr * 64 + fr), cl = u.pn * 256 + wc * 32 + fq * 8;
        int tok[2][4];
#pragma unroll
        for (int ai = 0; ai < 2; ++ai)
#pragma unroll
            for (int m = 0; m < 4; ++m) { const int r = r0 + ai * 128 + m * 16; tok[ai][m] = (r < u.cnt) ? plist[(size_t)u.pc * CAP + r] : -1; }
#pragma unroll
        for (int ai = 0; ai < 2; ++ai) {
            u32x4 xv[4][2];
#pragma unroll
            for (int m = 0; m < 4; ++m)
#pragma unroll
                for (int bj = 0; bj < 2; ++bj) xv[m][bj] = *(const u32x4*)(X + (size_t)(tok[ai][m] < 0 ? 0 : tok[ai][m]) * 1024 + bj * 128 + cl);
#pragma unroll
            for (int m = 0; m < 4; ++m) {
                const bool ok = tok[ai][m] >= 0; const size_t t = ok ? tok[ai][m] : 0; float sq = 0.f;
#pragma unroll
                for (int bj = 0; bj < 2; ++bj) { f32x4 pa, pb; unpack8(xv[m][bj], pa, pb);
                    const f32x4 na = pa + acc[ai][bj][m][0] * alpha, nb = pb + acc[ai][bj][m][1] * alpha; const u32x4 w = pack8(na, nb); sq += sqpk(w);
                    if (ok) { *(u32x4*)(X + t * 1024 + bj * 128 + cl) = w; *(u32x2*)(X8p + t * 1024 + bj * 128 + cl) = pack8_fp8(na, nb, SX8); } }
                sq += __shfl_xor(sq, 16); sq += __shfl_xor(sq, 32);
                if (ok && fq == 0) ss[t * 16 + u.pn * 4 + wc] = sq;
            }
            asm volatile("" ::: "memory");
        }
    }
};

__device__ __forceinline__ void naive_pool_phase(Frame& F, const bf16_t* Za, bf16_t* Y) {
    for (int i = blockIdx.x * 512 + opaque(F.tid); i < M * 256; i += F.G * 512) {
        const int t = i >> 8, c = i & 255, g = c >> 6, w = 2 << g, s = t & (SEQ - 1);
        const int cnt = (s + 1 < w) ? s + 1 : w; float sum = 0.f;
        for (int j = 0; j < cnt; ++j) sum += bf2f(Za[(size_t)(t - j) * 256 + c]);
        Y[(size_t)t * 1024 + c] = f2bf(sum / (float)cnt - bf2f(Za[(size_t)t * 256 + c]));
    }
}
__device__ __forceinline__ void naive_sgu_phase(Frame& F, int l, bf16_t* Y) {
    const bf16_t* Zu = (const bf16_t*)(F.ws + WS_ZU); const bf16_t* Zv = (const bf16_t*)(F.ws + WS_ZV); const float* ssv = (const float*)(F.ws + WS_SSV);
    const float* gn = F.in[6] + l * 256; const float* w_s = F.in[7] + (size_t)l * 4 * 128 * 128; const float* b_s = F.in[8] + l * 4 * 128;
    for (int idx = blockIdx.x * 512 + opaque(F.tid); idx < M * 256; idx += F.G * 512) {
        const int t = idx >> 8, c = idx & 255, g = c >> 6, i = t & 127, t0 = t - i;
        const int jmax = (i < 64) ? 64 : 128; float sum = 0.f;
        for (int j = 0; j < jmax; ++j) { const float* sp = ssv + (size_t)(t0 + j) * 4; const float r = rsqrtf(((sp[0] + sp[1]) + (sp[2] + sp[3])) * (1.0f / 256.0f) + EPS);
            sum += w_s[(size_t)g * 16384 + i * 128 + j] * (bf2f(Zv[(size_t)(t0 + j) * 256 + c]) * r * gn[c]); }
        const float mixed = sum + b_s[g * 128 + i];
        Y[(size_t)t * 1024 + 256 + c] = f2bf(bf2f(Zu[(size_t)t * 256 + c]) * mixed);
    }
}
__device__ __forceinline__ void naive_attn_phase(Frame& F, int layer, bf16_t* Y) {
    const bf16_t* Q = (const bf16_t*)(F.dout + DO_Q); const bf16_t* K = (const bf16_t*)(F.dout + DO_K); const bf16_t* V = (const bf16_t*)(F.ws + WS_V);
    const float* rb = F.in[11] + (size_t)layer * 8 * 257;
    for (int idx = blockIdx.x * 512 + opaque(F.tid); idx < M * 8; idx += F.G * 512) {
        const int h = idx & 7, row = idx >> 3; const int b = row / SEQ, s = row % SEQ, c = s >> 6;
        float q[64], o[64];
#pragma unroll
        for (int d = 0; d < 64; ++d) { q[d] = bf2f(Q[(size_t)row * 512 + h * 64 + d]); o[d] = 0.f; }
        float mx = -1e30f, l = 0.f;
        const int k0 = (c - 8 < 0 ? 0 : c - 8) * 64, k1 = c * 64 + 64;
        for (int kp = k0; kp < k1; ++kp) {
            const bf16_t* kr = K + ((size_t)b * SEQ + kp) * 512 + h * 64; float dot = 0.f;
#pragma unroll
            for (int d = 0; d < 64; ++d) dot += q[d] * bf2f(kr[d]);
            int dd = s - kp; dd = dd < -128 ? -128 : (dd > 128 ? 128 : dd);
            const float sc = dot + rb[h * 257 + dd + 128] * LOG2E;
            const float mn = fmaxf(mx, sc), f = exp2f(mx - mn), p = exp2f(sc - mn);
            l = l * f + p; mx = mn;
            const bf16_t* vr = V + ((size_t)b * SEQ + kp) * 512 + h * 64;
#pragma unroll
            for (int d = 0; d < 64; ++d) o[d] = o[d] * f + p * bf2f(vr[d]);
        }
        const float il = 1.0f / l;
#pragma unroll
        for (int d = 0; d < 64; ++d) Y[(size_t)row * 1024 + 512 + h * 64 + d] = f2bf(o[d] * il);
    }
}
__device__ __forceinline__ void naive_moe_phase(Frame& F, bf16_t* X) {
    const float* ss1 = (const float*)(F.ws + WS_SS1); const int* tok_e = (const int*)(F.ws + WS_MISC + MISC_TOKE); const float* tok_w = (const float*)(F.ws + WS_MISC + MISC_TOKW);
    const bf16_t* Wein_t = (const bf16_t*)(F.ws + WS_WEIN); const bf16_t* Weout_t = (const bf16_t*)(F.ws + WS_WEOUT); float* ss2 = (float*)(F.ws + WS_SS2);
    LAS float* xs = (LAS float*)F.lds; LAS float* hu = xs + 1024; LAS float* act = hu + 512; LAS float* red = act + 256;
    const int tid = opaque(F.tid);
    for (int tok = blockIdx.x; tok < M; tok += F.G) {
        float s = 0.f; for (int j = 0; j < 16; ++j) s += ss1[(size_t)tok * 16 + j];
        const float rstd = rsqrtf(s * (1.0f / D) + EPS);
        for (int k = tid; k < 1024; k += 512) xs[k] = bf2f(X[(size_t)tok * D + k]);
        __syncthreads();
        const int te = tok_e[tok]; const int which = tid >> 8, jj = tid & 255;
        { const int e = which == 0 ? (te & 255) : ((te >> 8) & 255);
          const bf16_t* wr = Wein_t + ((size_t)e * 256 + jj) * D; float a = 0.f;
          for (int k = 0; k < 1024; ++k) a += xs[k] * bf2f(wr[k]);
          hu[tid] = a * rstd; }
        __syncthreads();
        if (jj < 128) act[which * 128 + jj] = bf2f(f2bf(silu_f(hu[which * 256 + jj]) * hu[which * 256 + 128 + jj] * tok_w[2 * tok + which]));
        __syncthreads();
        const int elo = te & 255, ehi = (te >> 8) & 255; float sq = 0.f;
        for (int c = tid; c < 1024; c += 512) {
            const bf16_t* w0 = Weout_t + ((size_t)elo * D + c) * DEXP; const bf16_t* w1 = Weout_t + ((size_t)ehi * D + c) * DEXP; float a = 0.f;
            for (int j = 0; j < 128; ++j) a += act[j] * bf2f(w0[j]) + act[128 + j] * bf2f(w1[j]);
            const bf16_t o = f2bf(xs[c] + a); X[(size_t)tok * D + c] = o; const float of = bf2f(o); sq += of * of;
        }
        sq = wave_sum(sq); if ((tid & 63) == 0) red[tid >> 6] = sq;
        __syncthreads();
        if (tid < 16) { float t = 0.f; for (int j = 0; j < 8; ++j) t += red[j]; ss2[(size_t)tok * 16 + tid] = (tid == 0) ? t : 0.f; }
        __syncthreads();
    }
}

namespace att {
typedef float f32x16 __attribute__((ext_vector_type(16)));
typedef short s16x4 __attribute__((ext_vector_type(4)));
constexpr int LK = 0, LV = 24576, LWS = 49152, LOST = 51200, LTB = 83968, LDS_NEED = 84992;
__device__ __forceinline__ int crow(int r, int hi) { return (r & 3) + 8 * (r >> 2) + 4 * hi; }
__device__ __forceinline__ void glds16(const void* gsrc, unsigned lds_dst) { unsigned keep;
    asm volatile("s_mov_b32 %0, m0\n\ts_mov_b32 m0, %2\n\ts_nop 0\n\tglobal_load_lds_dwordx4 %1, off\n\ts_mov_b32 m0, %0" : "=&s"(keep) : "v"(gsrc), "s"(lds_dst) : "memory"); }
__device__ __forceinline__ void attn_unit(int b, int cq, int h, const bf16_t* Q, const bf16_t* K, const bf16_t* V, bf16_t* Y, LAS unsigned char* lds, const float* tbg, float negM) {
    const int tid = opaque(threadIdx.x), lane = tid & 63, r32 = lane & 31, hi = lane >> 5; const int wid = __builtin_amdgcn_readfirstlane(tid >> 6);
    const long rowbase = (long)b * SEQ; const int q0 = cq * 256;
    const bf16_t* Qw = Q + (rowbase + q0 + wid * 32) * 512 + h * 64;
    const bf16_t* Kh = K + rowbase * 512 + h * 64; const bf16_t* Vh = V + rowbase * 512 + h * 64;
    const unsigned lds0 = (unsigned)(uintptr_t)lds;
    LAS float* wsf = (LAS float*)(lds + LWS) + wid * 64; LAS float* tbl = (LAS float*)(lds + LTB);
    if (tid < 256) tbl[tid] = tbg[tid];
    const float negMfar = negM + tbg[255];
    const bf16_t* ksrc = Kh + (long)lane * 512 + wid * 8;
    const bf16_t* vsrc = Vh + (long)(16 * (wid & 3) + (lane >> 2)) * 512 + (wid >> 2) * 32 + (lane & 3) * 8;
    const unsigned kdst = lds0 + LK + wid * 1024, vdst = lds0 + LV + wid * 1024;
    bf16x8 qr[4];
#pragma unroll
    for (int d0 = 0; d0 < 4; ++d0) qr[d0] = *(const bf16x8*)(Qw + (long)r32 * 512 + d0 * 16 + hi * 8);
    f32x16 o0 = {}, o1 = {}; float lsum = 0.f;
    const int ci = wid >> 1, jfirst = (cq >= 2) ? 0 : 8 - 4 * cq;
#define ATT_DMA(j, sl) do { const long ko_ = (long)(4 * cq - 8 + (j)) * 64 * 512; glds16(ksrc + ko_, (unsigned)__builtin_amdgcn_readfirstlane(kdst + (sl) * 8192)); glds16(vsrc + ko_, (unsigned)__builtin_amdgcn_readfirstlane(vdst + (sl) * 8192)); } while (0)
    ATT_DMA(jfirst, 0);
    if (jfirst + 1 < 12) ATT_DMA(jfirst + 1, 1);
    int slot = 0;
    for (int j = jfirst; j < 12; ++j) {
        if (j + 1 < 12) asm volatile("s_waitcnt vmcnt(2) lgkmcnt(0)\n\ts_barrier" ::: "memory"); else asm volatile("s_waitcnt vmcnt(0) lgkmcnt(0)\n\ts_barrier" ::: "memory");
        if (j + 2 < 12) ATT_DMA(j + 2, (slot + 2) % 3);
        if (j >= ci && j <= ci + 8) {
            const int delta = ci + 8 - j;
            const float cv = delta >= 3 ? negMfar : negM;
            f32x16 cin;
#pragma unroll
            for (int r = 0; r < 16; ++r) cin[r] = cv;
            f32x16 p0, p1;
            const LAS unsigned char* kb = lds + LK + slot * 8192 + hi * 1024 + r32 * 16;
#pragma unroll
            for (int d0 = 0; d0 < 4; ++d0) {
                const bf16x8 b0 = *(const LAS bf16x8*)(kb + d0 * 2048), b1 = *(const LAS bf16x8*)(kb + d0 * 2048 + 512);
                if (d0 == 0) { p0 = __builtin_amdgcn_mfma_f32_32x32x16_bf16(b0, qr[0], cin, 0, 0, 0); p1 = __builtin_amdgcn_mfma_f32_32x32x16_bf16(b1, qr[0], cin, 0, 0, 0); }
                else { p0 = __builtin_amdgcn_mfma_f32_32x32x16_bf16(b0, qr[d0], p0, 0, 0, 0); p1 = __builtin_amdgcn_mfma_f32_32x32x16_bf16(b1, qr[d0], p1, 0, 0, 0); }
            }
            if (delta < 3) {
                const LAS float* tb = tbl + (32 * (wid & 1) + r32 + 64 * delta + 63 - 4 * hi);
#pragma unroll
                for (int r = 0; r < 16; ++r) { const int cr = (r & 3) + 8 * (r >> 2); p0[r] += tb[-cr]; p1[r] += tb[-cr - 32]; }
            }
            float sacc = 0.f;
#pragma unroll
            for (int r = 0; r < 16; ++r) { p0[r] = fast_exp2(p0[r]); p1[r] = fast_exp2(p1[r]); sacc += p0[r] + p1[r]; }
            lsum += sacc;
            u32x4 pw0, pw1, pw2, pw3;
            pw0 = (u32x4){cvt_pk_bf16(p0[0], p0[1]), cvt_pk_bf16(p0[2], p0[3]), cvt_pk_bf16(p0[4], p0[5]), cvt_pk_bf16(p0[6], p0[7])};
            pw1 = (u32x4){cvt_pk_bf16(p0[8], p0[9]), cvt_pk_bf16(p0[10], p0[11]), cvt_pk_bf16(p0[12], p0[13]), cvt_pk_bf16(p0[14], p0[15])};
            pw2 = (u32x4){cvt_pk_bf16(p1[0], p1[1]), cvt_pk_bf16(p1[2], p1[3]), cvt_pk_bf16(p1[4], p1[5]), cvt_pk_bf16(p1[6], p1[7])};
            pw3 = (u32x4){cvt_pk_bf16(p1[8], p1[9]), cvt_pk_bf16(p1[10], p1[11]), cvt_pk_bf16(p1[12], p1[13]), cvt_pk_bf16(p1[14], p1[15])};
            const int vb = (int)(lds0 + LV + slot * 8192) + ((lane >> 4) & 1) * 32 + (lane & 3) * 8 + (4 * hi + ((lane & 15) >> 2)) * 64;
#pragma unroll
            for (int d0 = 0; d0 < 2; ++d0) { s16x4 vlo[4], vhi[4];
#pragma unroll
                for (int ks = 0; ks < 4; ++ks) {
                    asm volatile("ds_read_b64_tr_b16 %0,%1 offset:%c2" : "=&v"(vlo[ks]) : "v"(vb), "i"(d0 * 4096 + ks * 1024) : "memory");
                    asm volatile("ds_read_b64_tr_b16 %0,%1 offset:%c2" : "=&v"(vhi[ks]) : "v"(vb), "i"(d0 * 4096 + ks * 1024 + 512) : "memory"); }
                asm volatile("s_waitcnt lgkmcnt(0)" ::: "memory"); __builtin_amdgcn_sched_barrier(0);
#define ATT_PK(k) (bf16x8){vlo[k][0], vlo[k][1], vlo[k][2], vlo[k][3], vhi[k][0], vhi[k][1], vhi[k][2], vhi[k][3]}
                f32x16 oo = d0 == 0 ? o0 : o1;
                oo = __builtin_amdgcn_mfma_f32_32x32x16_bf16(__builtin_bit_cast(bf16x8, pw0), ATT_PK(0), oo, 0, 0, 0);
                oo = __builtin_amdgcn_mfma_f32_32x32x16_bf16(__builtin_bit_cast(bf16x8, pw1), ATT_PK(1), oo, 0, 0, 0);
                oo = __builtin_amdgcn_mfma_f32_32x32x16_bf16(__builtin_bit_cast(bf16x8, pw2), ATT_PK(2), oo, 0, 0, 0);
                oo = __builtin_amdgcn_mfma_f32_32x32x16_bf16(__builtin_bit_cast(bf16x8, pw3), ATT_PK(3), oo, 0, 0, 0);
#undef ATT_PK
                if (d0 == 0) o0 = oo; else o1 = oo;
            }
        }
        slot = (slot + 1) % 3;
    }
#undef ATT_DMA
    { auto rr = __builtin_amdgcn_permlane32_swap(__float_as_uint(lsum), __float_as_uint(lsum), false, false); lsum = __uint_as_float(rr[0]) + __uint_as_float(rr[1]); }
    if (hi == 0) wsf[32 + r32] = lsum;
    asm volatile("s_waitcnt lgkmcnt(0)" ::: "memory");
    bf16_t* Ow = Y + (rowbase + q0 + wid * 32) * 1024 + 512 + h * 64;
    LAS bf16_t* stg = (LAS bf16_t*)(lds + LOST) + wid * 2048;
#pragma unroll
    for (int r = 0; r < 16; ++r) { const int orow = crow(r, hi); const float rl = fast_rcp(wsf[32 + orow]);
        stg[orow * 64 + r32] = f2bf(o0[r] * rl); stg[orow * 64 + 32 + r32] = f2bf(o1[r] * rl); }
    asm volatile("s_waitcnt lgkmcnt(0)" ::: "memory");
#pragma unroll
    for (int i = 0; i < 4; ++i) { const int row = i * 8 + (lane >> 3), ch = lane & 7; const u32x4 v = *(const LAS u32x4*)(stg + row * 64 + ch * 8); *(u32x4*)(Ow + (long)row * 1024 + ch * 8) = v; }
    asm volatile("s_waitcnt lgkmcnt(0)\n\ts_barrier" ::: "memory");
}
__device__ __forceinline__ void attn_phase(Frame& F, int l, bf16_t* Y) {
    const bf16_t* Q = (const bf16_t*)(F.dout + DO_Q); const bf16_t* K = (const bf16_t*)(F.dout + DO_K); const bf16_t* V = (const bf16_t*)(F.ws + WS_V);
    const float* tb = (const float*)(F.ws + WS_MISC + MISC_TB) + (size_t)l * 8 * 256; const float* am = (const float*)(F.ws + WS_MISC + MISC_ATTM) + l * 8;
    for (int u = blockIdx.x; u < 4 * 32 * 8; u += F.G) {
        const int h = u & 7, cq = (u >> 3) & 31, b = u >> 8;
        const float negM = -__hip_atomic_load(am + h, __ATOMIC_RELAXED, __HIP_MEMORY_SCOPE_AGENT);
        attn_unit(b, cq, h, Q, K, V, Y, F.lds, tb + h * 256, negM);
    }
}
}

__device__ __forceinline__ void sgu_unit(Frame& F, int l, int blk, int gp, bf16_t* Y) {
    using namespace att;
    const int tid = opaque(threadIdx.x), lane = tid & 63, r32 = lane & 31, hi = lane >> 5; const int wid = __builtin_amdgcn_readfirstlane(tid >> 6);
    LAS unsigned char* lds = F.lds; const unsigned lds0 = (unsigned)(uintptr_t)lds;
    const bf16_t* Zu = (const bf16_t*)(F.ws + WS_ZU); const bf16_t* Zv = (const bf16_t*)(F.ws + WS_ZV); const float* ssv = (const float*)(F.ws + WS_SSV);
    const bf16_t* Wm = (const bf16_t*)(F.ws + WS_MISC + MISC_WM) + (size_t)l * 4 * 16384;
    const float* gn = F.in[6] + l * 256; const float* b_s = F.in[8] + l * 512;
    const long t0 = (long)blk * 128; const int rb = wid & 3, gi = wid >> 2, g = 2 * gp + gi;
    LAS float* rst = (LAS float*)(lds + 32768); LAS float* stg = (LAS float*)(lds + 34816) + wid * 2048;
#pragma unroll
    for (int sl = 0; sl < 4; ++sl) { const int jt = sl & 1, gg = 2 * gp + (sl >> 1);
        const bf16_t* vsrc = Zv + (t0 + 64 * jt + 16 * (wid & 3) + (lane >> 2)) * 256 + gg * 64 + (wid >> 2) * 32 + (lane & 3) * 8;
        glds16(vsrc, (unsigned)__builtin_amdgcn_readfirstlane(lds0 + sl * 8192 + wid * 1024)); }
    if (tid < 128) { const f32x4 v = *(const f32x4*)(ssv + (t0 + tid) * 4); rst[tid] = rsqrtf(((v[0] + v[1]) + (v[2] + v[3])) * (1.0f / 256.0f) + EPS); }
    asm volatile("s_waitcnt vmcnt(0) lgkmcnt(0)\n\ts_barrier" ::: "memory");
    f32x16 o0 = {}, o1 = {};
    const int njt = rb < 2 ? 1 : 2;
    for (int jt = 0; jt < njt; ++jt) {
        const bf16_t* wrow = Wm + (size_t)g * 16384 + (size_t)(32 * rb + r32) * 128 + 64 * jt + 4 * hi;
        float p0[16], p1[16];
#pragma unroll
        for (int rg = 0; rg < 4; ++rg) {
            const u32x2 w0 = *(const u32x2*)(wrow + 8 * rg), w1 = *(const u32x2*)(wrow + 8 * rg + 32);
            const f32x4 r0 = *(const LAS f32x4*)(rst + 64 * jt + 8 * rg + 4 * hi), r1 = *(const LAS f32x4*)(rst + 64 * jt + 8 * rg + 4 * hi + 32);
            p0[4 * rg] = bflo(w0.x) * r0[0]; p0[4 * rg + 1] = bfhi(w0.x) * r0[1]; p0[4 * rg + 2] = bflo(w0.y) * r0[2]; p0[4 * rg + 3] = bfhi(w0.y) * r0[3];
            p1[4 * rg] = bflo(w1.x) * r1[0]; p1[4 * rg + 1] = bfhi(w1.x) * r1[1]; p1[4 * rg + 2] = bflo(w1.y) * r1[2]; p1[4 * rg + 3] = bfhi(w1.y) * r1[3];
        }
        u32x4 pw0, pw1, pw2, pw3;
        pw0 = (u32x4){cvt_pk_bf16(p0[0], p0[1]), cvt_pk_bf16(p0[2], p0[3]), cvt_pk_bf16(p0[4], p0[5]), cvt_pk_bf16(p0[6], p0[7])};
        pw1 = (u32x4){cvt_pk_bf16(p0[8], p0[9]), cvt_pk_bf16(p0[10], p0[11]), cvt_pk_bf16(p0[12], p0[13]), cvt_pk_bf16(p0[14], p0[15])};
        pw2 = (u32x4){cvt_pk_bf16(p1[0], p1[1]), cvt_pk_bf16(p1[2], p1[3]), cvt_pk_bf16(p1[4], p1[5]), cvt_pk_bf16(p1[6], p1[7])};
        pw3 = (u32x4){cvt_pk_bf16(p1[8], p1[9]), cvt_pk_bf16(p1[10], p1[11]), cvt_pk_bf16(p1[12], p1[13]), cvt_pk_bf16(p1[14], p1[15])};
        const int vb = (int)(lds0 + (gi * 2 + jt) * 8192) + ((lane >> 4) & 1) * 32 + (lane & 3) * 8 + (4 * hi + ((lane & 15) >> 2)) * 64;
#pragma unroll
        for (int d0 = 0; d0 < 2; ++d0) { s16x4 vlo[4], vhi[4];
#pragma unroll
            for (int ks = 0; ks < 4; ++ks) {
                asm volatile("ds_read_b64_tr_b16 %0,%1 offset:%c2" : "=&v"(vlo[ks]) : "v"(vb), "i"(d0 * 4096 + ks * 1024) : "memory");
                asm volatile("ds_read_b64_tr_b16 %0,%1 offset:%c2" : "=&v"(vhi[ks]) : "v"(vb), "i"(d0 * 4096 + ks * 1024 + 512) : "memory"); }
            asm volatile("s_waitcnt lgkmcnt(0)" ::: "memory"); __builtin_amdgcn_sched_barrier(0);
#define SGU_PK(k) (bf16x8){vlo[k][0], vlo[k][1], vlo[k][2], vlo[k][3], vhi[k][0], vhi[k][1], vhi[k][2], vhi[k][3]}
            f32x16 oo = d0 == 0 ? o0 : o1;
            oo = __builtin_amdgcn_mfma_f32_32x32x16_bf16(__builtin_bit_cast(bf16x8, pw0), SGU_PK(0), oo, 0, 0, 0);
            oo = __builtin_amdgcn_mfma_f32_32x32x16_bf16(__builtin_bit_cast(bf16x8, pw1), SGU_PK(1), oo, 0, 0, 0);
            oo = __builtin_amdgcn_mfma_f32_32x32x16_bf16(__builtin_bit_cast(bf16x8, pw2), SGU_PK(2), oo, 0, 0, 0);
            oo = __builtin_amdgcn_mfma_f32_32x32x16_bf16(__builtin_bit_cast(bf16x8, pw3), SGU_PK(3), oo, 0, 0, 0);
#undef SGU_PK
            if (d0 == 0) o0 = oo; else o1 = oo;
        }
    }
    const float g0 = gn[g * 64 + r32], g1 = gn[g * 64 + 32 + r32];
#pragma unroll
    for (int r = 0; r < 16; ++r) { const int orow = crow(r, hi); const float bb = b_s[g * 128 + 32 * rb + orow];
        stg[orow * 64 + r32] = o0[r] * g0 + bb; stg[orow * 64 + 32 + r32] = o1[r] * g1 + bb; }
    asm volatile("s_waitcnt lgkmcnt(0)" ::: "memory");
#pragma unroll
    for (int i = 0; i < 4; ++i) { const int row = i * 8 + (lane >> 3), ch = lane & 7; const long t = t0 + 32 * rb + row;
        const f32x4 m0 = *(const LAS f32x4*)(stg + row * 64 + ch * 8), m1 = *(const LAS f32x4*)(stg + row * 64 + ch * 8 + 4);
        f32x4 ua, ub; unpack8(*(const u32x4*)(Zu + t * 256 + g * 64 + ch * 8), ua, ub);
        *(u32x4*)(Y + t * 1024 + 256 + g * 64 + ch * 8) = pack8(ua * m0, ub * m1); }
    asm volatile("s_waitcnt lgkmcnt(0)\n\ts_barrier" ::: "memory");
}
__device__ __forceinline__ void sgu_pool_phase(Frame& F, int l, bf16_t* Y) {
    for (int u = blockIdx.x; u < 4 * 64 * 2; u += F.G) sgu_unit(F, l, u >> 1, u & 1, Y);
    const bf16_t* Za = (const bf16_t*)(F.ws + WS_ZA);
    for (int it = blockIdx.x * 512 + opaque(F.tid); it < (M / 16) * 32; it += F.G * 512) {
        const int ch = it & 31, t0 = (it >> 5) * 16, w = 2 << (ch >> 3), s0 = t0 & (SEQ - 1);
        const bf16_t* zp = Za + (size_t)t0 * 256 + ch * 8;
        f32x4 sa = {0.f, 0.f, 0.f, 0.f}, sb = sa;
#pragma unroll
        for (int j = 1; j < 16; ++j) { if (j < w && j <= s0) { f32x4 a, b; unpack8(*(const u32x4*)(zp - (size_t)j * 256), a, b); sa += a; sb += b; } }
#pragma unroll
        for (int i = 0; i < 16; ++i) {
            f32x4 a, b; unpack8(*(const u32x4*)(zp + (size_t)i * 256), a, b); sa += a; sb += b;
            const int s = s0 + i; const int cnt = (s + 1 < w) ? s + 1 : w; const float ic = 1.0f / (float)cnt;
            *(u32x4*)(Y + (size_t)(t0 + i) * 1024 + ch * 8) = pack8(sa * ic - a, sb * ic - b);
            if (s + 1 >= w) { f32x4 oa, ob; unpack8(*(const u32x4*)(zp + ((ptrdiff_t)i + 1 - w) * 256), oa, ob); sa -= oa; sb -= ob; }
        }
    }
}

constexpr int NPH = 1 + 8 * DEPTH;
#ifndef PROBE_PHASE
#define PROBE_PHASE 0
#define PROBE_N 1
#endif
#ifndef PHMASK
#define PHMASK 0xFFFF
#endif
#define EN(b) ((PHMASK >> (b)) & 1)
__global__ void __launch_bounds__(512, 2) fwd(Args args) {
    extern __shared__ __attribute__((aligned(16))) unsigned char lds_raw[];
    Frame F;
    F.lds = (LAS unsigned char*)lds_raw; F.ws = args.ws; F.dout = (unsigned char*)args.out; F.ctl = (gu32*)(args.ws + WS_CTL); F.in = (inptr_t)__builtin_amdgcn_kernarg_segment_ptr();
    F.tid = threadIdx.x; F.lane = F.tid & 63; F.wave = __builtin_amdgcn_readfirstlane(F.tid >> 6); F.G = gridDim.x;
    F.gw = blockIdx.x * 8 + F.wave; F.NGW = F.G * 8;
    for (int u = F.tid; u < (LDS_BYTES - LDSCTL_OFF) / 4; u += 512) ((LAS unsigned*)(F.lds + LDSCTL_OFF))[u] = 0u;
    __syncthreads();
    XcdBarrier bar = xcd_barrier_post((unsigned*)(F.ctl + CW_BAR), (volatile LAS unsigned*)(F.lds + LDSCTL_OFF));
#define IN(k) true
#define SEAM(k) xcd_barrier(bar)
    for (int rp_ = 0, nr_ = (PROBE_PHASE == 9 ? args.rep_n : 1); rp_ < nr_; ++rp_) { if (rp_) xcd_barrier(bar);
    if (EN(0) && IN(0)) { prologue(F); prep_layer(F, 0); } }
    SEAM(0);
    unsigned char* const ws0 = F.ws; unsigned char* const do0 = F.dout; const inptr_t in0 = (inptr_t)__builtin_amdgcn_kernarg_segment_ptr();
    for (int l = 0; l < DEPTH; ++l) {
        const int pb = 1 + 8 * l;
#define OPQ() unsigned char* ws = ws0; unsigned char* dout = do0; inptr_t inq = in0; asm volatile("" : "+s"(ws), "+s"(dout), "+s"(inq)); F.ws = ws; F.dout = dout; F.in = inq; \
        bf16_t* Xc = (bf16_t*)(ws + (l == 0 ? WS_XA : WS_XB)); bf16_t* Xo = (bf16_t*)(ws + (l == 0 ? WS_XB : WS_XA)); \
        bf16_t* Y = (l == 0) ? Xo : (bf16_t*)(dout + DO_PY); float* ss1 = (float*)(ws + WS_SS1); \
        (void)Xc; (void)Xo; (void)Y; (void)ss1;
#define SETB(S) do { (S).ws = ws; (S).dout = dout; (S).l = l; } while (0)
        for (int rp_ = 0, nr_ = (PROBE_PHASE == 1 ? args.rep_n : 1); rp_ < nr_; ++rp_) { if (rp_) xcd_barrier(bar);
        if (EN(1) && IN(pb + 0)) { OPQ();
            InGemm S; SETB(S); S.inq = inq; S.a_base = (const char*)Xc; S.lda = 2048; S.b_base = (const char*)(ws + WS_WIN); S.ldb = 2048; S.nt = 16; S.ord.init(M, 2304, F.G, blockIdx.x); S.pn_off = 0; S.gsc = 1.f;
            g8::gemm_phase(F.lds, S);
            S.a_base = (const char*)(ws + WS_X8); S.lda = 1024; S.b_base = (const char*)(ws + WS_WIN8); S.ldb = 1024; S.nt = 8; S.ord.init(M, 3072, F.G, blockIdx.x); S.pn_off = 9; S.gsc = INV_S8;
            g8::gemm_phase<InGemm, false, true>(F.lds, S);
        }
        }
        SEAM(pb + 0);
        for (int rp_ = 0, nr_ = (PROBE_PHASE == 2 ? args.rep_n : 1); rp_ < nr_; ++rp_) { if (rp_) xcd_barrier(bar);
        if (EN(2) && IN(pb + 1)) { OPQ(); att::attn_phase(F, l, Y); sgu_pool_phase(F, l, Y); }
        }
        SEAM(pb + 1);
        for (int rp_ = 0, nr_ = (PROBE_PHASE == 3 ? args.rep_n : 1); rp_ < nr_; ++rp_) { if (rp_) xcd_barrier(bar);
        if (EN(3) && IN(pb + 2)) { OPQ();
            BranchGemm S; SETB(S); S.a_base = (const char*)Y; S.lda = 2048; S.b_base = (const char*)(ws + WS_WBR); S.ldb = 2048; S.nt = 16; S.ord.init(M, D, F.G, blockIdx.x);
            g8::gemm_phase<BranchGemm, true>(F.lds, S);
        }
        }
        SEAM(pb + 2);
        for (int rp_ = 0, nr_ = (PROBE_PHASE == 4 ? args.rep_n : 1); rp_ < nr_; ++rp_) { if (rp_) xcd_barrier(bar);
        if (EN(4) && IN(pb + 3)) { OPQ();
            OutGemm S; SETB(S); S.a_base = (const char*)(ws + WS_MERGED); S.lda = 2048; S.b_base = (const char*)(ws + WS_WOUT); S.ldb = 2048; S.nt = 16; S.ord.init(M, D, F.G, blockIdx.x);
            S.alpha = rp_ ? 0.f : 1.f; g8::gemm_phase(F.lds, S);
        }
        }
        SEAM(pb + 3);
        for (int rp_ = 0, nr_ = (PROBE_PHASE == 5 ? args.rep_n : 1); rp_ < nr_; ++rp_) { if (rp_) xcd_barrier(bar);
        if (EN(5) && IN(pb + 4)) { OPQ(); router_phase(F, l, Xc, ss1, rp_ > 0); }
        }
        SEAM(pb + 4);
        for (int rp_ = 0, nr_ = (PROBE_PHASE == 6 ? args.rep_n : 1); rp_ < nr_; ++rp_) { if (rp_) xcd_barrier(bar);
        if (EN(6) && IN(pb + 5)) { OPQ();
            gu32* cnt = (gu32*)(ws + WS_CTL) + CW_CNT + (size_t)l * 160 * 64;
            build_class_tables(F, cnt, NEXP);
            Moe1Gemm S; S.ws = ws; S.dout = dout; S.a_base = (const char*)(ws + WS_X8); S.lda = 1024; S.b_base = (const char*)(ws + WS_WEIN); S.ldb = 1024; S.nt = 8; S.G = F.G; S.c = blockIdx.x;
            S.tpre = (const LAS int*)(F.lds + LT_PRE); S.ccnt = (const LAS int*)(F.lds + LT_CNT);
            const int tot1 = S.tpre[NEXP];
            g8::gemm_phase<Moe1Gemm, false, true>(F.lds, S);
            StoreGemm P; SETB(P); P.a_base = (const char*)(ws + WS_PB); P.lda = 512; P.b_base = (const char*)(ws + WS_WPLE + (size_t)l * MiB); P.ldb = 512; P.nt = 4;
            { const int extra = (tot1 > F.G && tot1 < 2 * F.G) ? tot1 - F.G : 0; P.nfree = F.G - extra; P.rank = (int)blockIdx.x - extra; P.nunits = (M / 256) * 4; }
            g8::gemm_phase(F.lds, P);
        }
        }
        SEAM(pb + 5);
        for (int rp_ = 0, nr_ = (PROBE_PHASE == 7 ? args.rep_n : 1); rp_ < nr_; ++rp_) { if (rp_) xcd_barrier(bar);
        if (EN(7) && IN(pb + 6)) { OPQ();
            gu32* cnt = (gu32*)(ws + WS_CTL) + CW_CNT + (size_t)l * 160 * 64 + 32 * 64;
            build_class_tables(F, cnt, NPAIR);
            Moe2Gemm S; S.ws = ws; S.dout = dout; S.l = l; S.a_base = (const char*)(ws + WS_H); S.lda = 512; S.b_base = (const char*)(ws + WS_WEOUT); S.ldb = 256; S.nt = 4; S.G = F.G; S.c = blockIdx.x;
            S.alpha = rp_ ? 0.f : 1.f;
            S.tpre = (const LAS int*)(F.lds + LT_PRE); S.ccnt = (const LAS int*)(F.lds + LT_CNT);
            g8::gemm_phase(F.lds, S);
        }
        }
        SEAM(pb + 6);
        for (int rp_ = 0, nr_ = (PROBE_PHASE == 8 ? args.rep_n : 1); rp_ < nr_; ++rp_) { if (rp_) xcd_barrier(bar);
        if (EN(8) && IN(pb + 7)) { OPQ();
            if (l + 1 < DEPTH) { prep_layer(F, l + 1); __syncthreads(); }
            PleGemm S; SETB(S); S.a_base = (const char*)(ws + WS_X8P); S.lda = 1024; S.b_base = (const char*)(ws + WS_WGATE + (size_t)l * 2 * MiB); S.ldb = 1024; S.nt = 8; S.ord.init(M, D, F.G, blockIdx.x);
            S.lastl = (l == DEPTH - 1); S.gsc = INV_S8;
            g8::gemm_phase<PleGemm, false, true>(F.lds, S);
        }
        }
        if (l + 1 < DEPTH) SEAM(pb + 7);
    }
#undef SETB
#undef OPQ
#undef IN
#undef SEAM
}

#ifndef N_LAUNCHES
#define N_LAUNCHES 1
#endif
extern "C" void kernel_launch(void* const* d_in, const int* in_sizes, int n_in, void* d_out, int out_size, void* d_ws, size_t ws_size, hipStream_t stream) {
    static int grid = 0;
    if (grid == 0) {
        if (n_in != 27 || out_size != M * D || ws_size < WS_END) { fprintf(stderr, "kernel_launch: unexpected shapes (n_in %d out %d ws %zu)\n", n_in, out_size, ws_size); grid = -1; return; }
        int dev = 0, cus = 0;
        if (hipGetDevice(&dev) != hipSuccess || hipDeviceGetAttribute(&cus, hipDeviceAttributeMultiprocessorCount, dev) != hipSuccess) { grid = -1; return; }
        if (hipFuncSetAttribute((const void*)fwd, hipFuncAttributeMaxDynamicSharedMemorySize, LDS_BYTES) != hipSuccess) { fprintf(stderr, "kernel_launch: hipFuncSetAttribute failed\n"); grid = -1; return; }
        int per_cu = 0;
        if (hipOccupancyMaxActiveBlocksPerMultiprocessor(&per_cu, (const void*)fwd, 512, LDS_BYTES) != hipSuccess || per_cu < 1) fprintf(stderr, "kernel_launch: occupancy query says %d\n", per_cu);
        (void)hipGetLastError();
        grid = cus;
    }
    if (grid < 0) return;
    (void)hipMemsetAsync((char*)d_ws + WS_CTL, 0, CTL_ZERO_BYTES, stream);
    Args a{};
    for (int i = 0; i < 27; ++i) a.in[i] = (const float*)d_in[i];
    a.out = (float*)d_out; a.ws = (unsigned char*)d_ws; a.rep_n = PROBE_N;
    hipLaunchKernelGGL(fwd, dim3(grid), dim3(512), LDS_BYTES, stream, a);
}
```

```cpp
#include <hip/hip_runtime.h>
#include <cstdio>
#include <cstdint>

#define LAS __attribute__((address_space(3)))
#define GAS __attribute__((address_space(1)))
typedef unsigned short bf16_t;
typedef short bf16x8 __attribute__((ext_vector_type(8)));
typedef float f32x4 __attribute__((ext_vector_type(4)));
typedef float f32x2 __attribute__((ext_vector_type(2)));
typedef unsigned u32x4 __attribute__((ext_vector_type(4)));
typedef unsigned u32x2 __attribute__((ext_vector_type(2)));
typedef GAS unsigned gu32;
typedef const float* const __attribute__((address_space(4)))* inptr_t;

constexpr int M = 32768, D = 1024, SEQ = 8192, NIN = 5376, DEPTH = 2, PLE = 256;
constexpr int NEXP = 32, DEXP = 128, NPAIR = 112, CAP = 32768;
constexpr float EPS = 1e-6f;
constexpr float LOG2E = 1.4426950408889634f;
constexpr float C2 = 0.125f * LOG2E;

constexpr size_t MiB = 1u << 20;
constexpr size_t WS_CTL = 0, CTL_ZERO_BYTES = 1 * MiB;
constexpr size_t WS_MISC = 1 * MiB;
constexpr size_t MISC_ATTM = 0, MISC_GQK = 1024, MISC_TB = 4096, MISC_TOKE = 32768, MISC_TOKW = 196608, MISC_WM = 524288;
constexpr size_t WS_WR = 2 * MiB, WR_BIAS = 896 * 1024;
constexpr size_t WS_SSX = 3 * MiB, WS_SS1 = 5 * MiB, WS_SS2 = 7 * MiB, WS_SSV = 9 * MiB;
constexpr size_t WS_WGATE = 10 * MiB, WS_WPLE = 14 * MiB;
constexpr size_t WS_WIN = 16 * MiB, WS_WBR = 27 * MiB, WS_WOUT = 29 * MiB, WS_WEIN = 31 * MiB, WS_WEOUT = 47 * MiB;
constexpr size_t WS_PB = 58 * MiB;
constexpr size_t WS_XA = 74 * MiB, WS_XB = 138 * MiB;
constexpr size_t WS_ZA = 202 * MiB, WS_ZU = 218 * MiB, WS_ZV = 234 * MiB, WS_V = 250 * MiB, WS_G = 282 * MiB;
constexpr size_t WS_MERGED = 202 * MiB, WS_H = 202 * MiB, WS_ELIST = 218 * MiB, WS_PLIST = 222 * MiB;
constexpr size_t WS_WIN8 = 21 * MiB;
constexpr size_t WS_X8 = 474 * MiB, WS_X8P = 236 * MiB;
constexpr size_t WS_END = 506 * MiB;
constexpr float SX8 = 8.0f, SW8 = 64.0f, INV_S8 = 1.0f / (8.0f * 64.0f);
constexpr size_t DO_PY = 0, DO_Q = 64 * MiB, DO_K = 96 * MiB;
constexpr int CW_TMO = 0, CW_BAR = 4096, CW_CNT = 16384;

constexpr int LDS_BYTES = 152576;
constexpr int LDSCTL_OFF = 152576 - 2048;

__device__ __forceinline__ float bflo(unsigned w) { return __uint_as_float(w << 16); }
__device__ __forceinline__ float bfhi(unsigned w) { return __uint_as_float(w & 0xffff0000u); }
__device__ __forceinline__ float bf2f(bf16_t h) { return __uint_as_float((unsigned)h << 16); }
typedef __bf16 bf16x2_t __attribute__((ext_vector_type(2)));
__device__ __forceinline__ unsigned cvt_pk_bf16(float lo, float hi) { const f32x2 v = {lo, hi}; const bf16x2_t b = __builtin_convertvector(v, bf16x2_t); return __builtin_bit_cast(unsigned, b); }
__device__ __forceinline__ bf16_t f2bf(float f) { return (bf16_t)(cvt_pk_bf16(f, 0.f) & 0xffffu); }
__device__ __forceinline__ u32x2 pack8_fp8(f32x4 a, f32x4 b, float sc) {
    int lo = __builtin_amdgcn_cvt_pk_fp8_f32(a[0] * sc, a[1] * sc, 0, false); lo = __builtin_amdgcn_cvt_pk_fp8_f32(a[2] * sc, a[3] * sc, lo, true);
    int hi = __builtin_amdgcn_cvt_pk_fp8_f32(b[0] * sc, b[1] * sc, 0, false); hi = __builtin_amdgcn_cvt_pk_fp8_f32(b[2] * sc, b[3] * sc, hi, true);
    return (u32x2){(unsigned)lo, (unsigned)hi}; }
__device__ __forceinline__ float fast_rcp(float x) { return __builtin_amdgcn_rcpf(x); }
__device__ __forceinline__ float fast_exp2(float x) { return __builtin_amdgcn_exp2f(x); }
__device__ __forceinline__ float gelu_t(float x) { const float u = x + 0.044715f * x * x * x; return x * fast_rcp(1.f + fast_exp2(-2.302208198f * u)); }
__device__ __forceinline__ float sigmoid_f(float x) { return fast_rcp(1.f + fast_exp2(-LOG2E * x)); }
__device__ __forceinline__ float silu_f(float x) { return x * sigmoid_f(x); }
__device__ __forceinline__ int opaque(int v) { asm volatile("" : "+v"(v)); return v; }
__device__ __forceinline__ float wave_sum(float v) {
#pragma unroll
    for (int o = 1; o < 64; o <<= 1) v += __shfl_xor(v, o);
    return v;
}
__device__ __forceinline__ u32x4 pack8(f32x4 a, f32x4 b) { u32x4 w; w.x = cvt_pk_bf16(a[0], a[1]); w.y = cvt_pk_bf16(a[2], a[3]); w.z = cvt_pk_bf16(b[0], b[1]); w.w = cvt_pk_bf16(b[2], b[3]); return w; }
__device__ __forceinline__ void unpack8(u32x4 w, f32x4& a, f32x4& b) { a = (f32x4){bflo(w.x), bfhi(w.x), bflo(w.y), bfhi(w.y)}; b = (f32x4){bflo(w.z), bfhi(w.z), bflo(w.w), bfhi(w.w)}; }
__device__ __forceinline__ float sq4(f32x4 a) { return (a[0] * a[0] + a[1] * a[1]) + (a[2] * a[2] + a[3] * a[3]); }
__device__ __forceinline__ float sqpk(u32x4 w) { f32x4 a, b; unpack8(w, a, b); return sq4(a) + sq4(b); }

namespace g8 {
constexpr int BM = 256, BK = 64, HALF = 128, HTB = HALF * BK * 2, STAGE_BYTES = 8 * HTB, NXCD = 8, WGM = 8;
__host__ __device__ __forceinline__ int lds_byte(int r, int c) { const int st = (r >> 4) * 2 + (c >> 5), rr = r & 15, cc = c & 31, ob = rr * 64 + cc * 2; return st * 1024 + (ob ^ (((ob >> 9) & 1) << 5)); }
__host__ __device__ __forceinline__ void stage_rc(int b, int& R, int& C) { const int st = b / 1024, sb = b % 1024, swz = sb ^ (((sb >> 9) & 1) << 5); R = (st >> 1) * 16 + swz / 64; C = (st & 1) * 32 + (swz % 64) / 2; }
__host__ __device__ __forceinline__ int perm32(int rho) { const int n = rho >> 4, i = rho & 15; return 8 * (i >> 2) + 4 * n + (i & 3); }

struct Unit { int pm, pn; };
struct StaticOrder {
    int nM, nN, nwg, G, c;
    __device__ void init(int Mr, int N, int G_, int c_) { nM = Mr / BM; nN = N / BM; nwg = nM * nN; G = G_; c = c_; }
    __device__ bool next(int i, Unit& u) const { return map((long)i * G + c, u); }
    __device__ bool map(long L, Unit& u) const {
        if (L >= nwg) return false;
        int wgid = (int)L; { const int q = nwg / NXCD, r = nwg % NXCD, xcd = wgid % NXCD, off = wgid / NXCD; wgid = (xcd < r ? xcd * (q + 1) : r * (q + 1) + (xcd - r) * q) + off; }
        const int nig = WGM * nN, gid = wgid / nig, fm = gid * WGM, gsz = (nM - fm) < WGM ? (nM - fm) : WGM;
        u.pm = fm + ((wgid % nig) % gsz); u.pn = (wgid % nig) / gsz; return true;
    }
};
struct DenseBase {
    typedef g8::Unit Unit;
    const char* a_base; unsigned lda; const char* b_base; unsigned ldb; int nt; StaticOrder ord;
    unsigned char* ws; unsigned char* dout; inptr_t inq; int l;
    __device__ __forceinline__ bool next(int i, Unit& u) const { return ord.next(i, u); }
    static constexpr bool GATHER = false;
    __device__ __forceinline__ void a_off(const Unit&, const int (&)[2], const int (&)[2], unsigned (&)[2][2]) const {}
    __device__ __forceinline__ const char* a_tile(const Unit& u) const { return a_base + (size_t)u.pm * BM * lda; }
    __device__ __forceinline__ const char* b_tile(const Unit& u, int kt) const { return b_base + (size_t)u.pn * BM * ldb + (size_t)kt * (BK * 2); }
    __device__ __forceinline__ void mid(f32x4 (&)[2][2][4][2], const Unit&, int, int, int, int, int) const {}
};

template <class P, bool HOOK = false, bool FP8 = false>
__device__ __forceinline__ void gemm_phase(LAS unsigned char* lds, const P& S) {
    typedef int v8i __attribute__((ext_vector_type(8))); typedef int v4i __attribute__((ext_vector_type(4)));
    typedef typename P::Unit Unit;
    const int tid = opaque(threadIdx.x), wid = __builtin_amdgcn_readfirstlane(tid >> 6), lane = tid & 63, wr = wid >> 2, wc = wid & 3, fr = lane & 15, fq = lane >> 4;
    const int nt = S.nt;
    int R[2], C[2]; unsigned voffB[2];
#pragma unroll
    for (int i = 0; i < 2; ++i) { stage_rc(tid * 16 + i * 8192, R[i], C[i]); const int Rb = P::PERM ? ((R[i] & ~31) + perm32(R[i] & 31)) : R[i]; voffB[i] = (unsigned)Rb * S.ldb + (unsigned)C[i] * 2u; }
    const size_t hstepB = (size_t)HALF * S.ldb;
    unsigned voffA[2] = {0u, 0u}; size_t hstepA = 0;
    if constexpr (!P::GATHER) { hstepA = (size_t)HALF * S.lda;
#pragma unroll
        for (int i = 0; i < 2; ++i) voffA[i] = (unsigned)R[i] * S.lda + (unsigned)C[i] * 2u; }
    const unsigned ldsw = (unsigned)wid * 1024u;
    const int aoff = lds_byte(wr * 64 + fr, fq * 8), boff = lds_byte(wc * 32 + fr, fq * 8);
    const char* const Ab = S.a_base;
#define G8_SA(b, h) (((b) * 2 + (h)) * HTB)
#define G8_SB(b, h) ((4 + (b) * 2 + (h)) * HTB)
#define G8_STAGE_A(bufoff, sel, h, kt) do { if constexpr (P::GATHER) { _Pragma("unroll") for (int _i = 0; _i < 2; ++_i) \
        __builtin_amdgcn_global_load_lds((const unsigned*)(Ab + (size_t)((sel) ? no[h][_i] : co[h][_i]) + (size_t)(kt) * (BK * 2)), (LAS unsigned*)(lds + (bufoff) + ldsw + _i * 8192), 16, 0, 0); } \
      else { const char* _g = ((sel) ? nA : cA) + (size_t)(h) * hstepA + (size_t)(kt) * (BK * 2); _Pragma("unroll") for (int _i = 0; _i < 2; ++_i) \
        __builtin_amdgcn_global_load_lds((const unsigned*)(_g + voffA[_i]), (LAS unsigned*)(lds + (bufoff) + ldsw + _i * 8192), 16, 0, 0); } } while (0)
#define G8_STAGE_B(bufoff, gbase) do { _Pragma("unroll") for (int _i = 0; _i < 2; ++_i) \
        __builtin_amdgcn_global_load_lds((const unsigned*)((const char*)(gbase) + voffB[_i]), (LAS unsigned*)(lds + (bufoff) + ldsw + _i * 8192), 16, 0, 0); } while (0)
#define G8_LDA(dst, b, h) do { if constexpr (FP8) { _Pragma("unroll") for (int m = 0; m < 4; ++m) { dst##8[m].lo = *(const LAS v4i*)(lds + G8_SA(b, h) + aoff + m * 2048); dst##8[m].hi = *(const LAS v4i*)(lds + G8_SA(b, h) + aoff + m * 2048 + 1024); } } \
      else { _Pragma("unroll") for (int m = 0; m < 4; ++m) _Pragma("unroll") for (int k = 0; k < 2; ++k) dst[m][k] = *(const LAS bf16x8*)(lds + G8_SA(b, h) + aoff + m * 2048 + k * 1024); } } while (0)
#define G8_LDB(dst, b, h) do { if constexpr (FP8) { _Pragma("unroll") for (int n = 0; n < 2; ++n) { dst##8[n].lo = *(const LAS v4i*)(lds + G8_SB(b, h) + boff + n * 2048); dst##8[n].hi = *(const LAS v4i*)(lds + G8_SB(b, h) + boff + n * 2048 + 1024); } } \
      else { _Pragma("unroll") for (int n = 0; n < 2; ++n) _Pragma("unroll") for (int k = 0; k < 2; ++k) dst[n][k] = *(const LAS bf16x8*)(lds + G8_SB(b, h) + boff + n * 2048 + k * 1024); } } while (0)
#define G8_MMA(ai, bj, At, Bt) do { __builtin_amdgcn_s_setprio(1); if constexpr (FP8) { _Pragma("unroll") for (int m = 0; m < 4; ++m) _Pragma("unroll") for (int n = 0; n < 2; ++n) \
        asm volatile("v_mfma_f32_16x16x128_f8f6f4 %0, %1, %2, %0" : "+v"(acc[ai][bj][m][n]) : "v"(Bt##8[n]), "v"(At##8[m])); } \
      else { _Pragma("unroll") for (int m = 0; m < 4; ++m) _Pragma("unroll") for (int n = 0; n < 2; ++n) _Pragma("unroll") for (int k = 0; k < 2; ++k) \
        acc[ai][bj][m][n] = __builtin_amdgcn_mfma_f32_16x16x32_bf16(Bt[n][k], At[m][k], acc[ai][bj][m][n], 0, 0, 0); } __builtin_amdgcn_s_setprio(0); } while (0)
#define G8_WAIT_V(n) asm volatile("s_waitcnt vmcnt(" #n ")" ::: "memory")
#define G8_WAIT_L(n) asm volatile("s_waitcnt lgkmcnt(" #n ")" ::: "memory")
#define G8_BAR __builtin_amdgcn_s_barrier()
#define G8_SCHED __builtin_amdgcn_sched_barrier(0)
    Unit cur, nxt; int ui = 0;
    if (!S.next(0, cur)) return;
    unsigned co[2][2], no[2][2];
    S.a_off(cur, R, C, co);
    const char* cA = nullptr; const char* nA = nullptr;
    if constexpr (!P::GATHER) { cA = S.a_tile(cur); nA = cA; }
    f32x4 acc[2][2][4][2];
#pragma unroll
    for (int a = 0; a < 2; ++a)
#pragma unroll
        for (int b = 0; b < 2; ++b)
#pragma unroll
            for (int m = 0; m < 4; ++m)
#pragma unroll
                for (int n = 0; n < 2; ++n) acc[a][b][m][n] = (f32x4){0.f, 0.f, 0.f, 0.f};
    bf16x8 At[4][2], B0[2][2], B1[2][2]; v8i At8[4], B08[2], B18[2];
    {
        const char* b0 = S.b_tile(cur, 0); const char* b1 = S.b_tile(cur, 1);
        G8_STAGE_B(G8_SB(0, 0), b0); G8_STAGE_B(G8_SB(0, 1), b0 + hstepB); G8_STAGE_A(G8_SA(0, 0), false, 0, 0); G8_STAGE_A(G8_SA(0, 1), false, 1, 0);
        if (wr == 1) G8_BAR;
        G8_WAIT_V(2); G8_BAR;
        G8_STAGE_B(G8_SB(1, 0), b1); G8_STAGE_A(G8_SA(1, 0), false, 0, 1); G8_STAGE_B(G8_SB(1, 1), b1 + hstepB);
        G8_WAIT_V(6); G8_BAR;
    }
    for (;;) {
        const bool has_next = S.next(ui + 1, nxt);
        if (!has_next) nxt = cur;
        S.a_off(nxt, R, C, no);
        if constexpr (!P::GATHER) nA = S.a_tile(nxt);
        for (int t = 0; t < nt; t += 2) {
            const bool last = (t == nt - 2);
            const int k2 = last ? 0 : t + 2, k3 = k2 + 1;
            const char* b2 = last ? S.b_tile(nxt, 0) : S.b_tile(cur, t + 2);
            const char* b3 = last ? S.b_tile(nxt, 1) : S.b_tile(cur, t + 3);
            G8_LDB(B0, 0, 0); G8_LDB(B1, 0, 1); G8_SCHED; G8_LDA(At, 0, 0); G8_STAGE_A(G8_SA(1, 1), false, 1, t + 1);
            G8_WAIT_V(8); G8_WAIT_L(0); G8_BAR; G8_MMA(0, 0, At, B0); G8_MMA(0, 1, At, B1); G8_BAR; G8_SCHED;
            G8_LDA(At, 0, 1); G8_STAGE_B(G8_SB(0, 0), b2); G8_STAGE_B(G8_SB(0, 1), b2 + hstepB); G8_STAGE_A(G8_SA(0, 0), last, 0, k2);
            G8_WAIT_V(8); G8_WAIT_L(0); G8_BAR; G8_MMA(1, 0, At, B0); G8_MMA(1, 1, At, B1); G8_BAR; G8_SCHED;
            G8_LDB(B0, 1, 0); G8_LDB(B1, 1, 1); G8_SCHED; G8_LDA(At, 1, 0); G8_STAGE_A(G8_SA(0, 1), last, 1, k2);
            G8_WAIT_V(8); G8_WAIT_L(0); G8_BAR; G8_MMA(0, 0, At, B0); G8_MMA(0, 1, At, B1); G8_BAR; G8_SCHED;
            G8_LDA(At, 1, 1); G8_STAGE_B(G8_SB(1, 0), b3); G8_STAGE_B(G8_SB(1, 1), b3 + hstepB); G8_STAGE_A(G8_SA(1, 0), last, 0, k3);
            G8_WAIT_V(8); G8_WAIT_L(0); G8_BAR; G8_MMA(1, 0, At, B0); G8_MMA(1, 1, At, B1); G8_BAR; G8_SCHED;
            if constexpr (HOOK) { if (!last) S.mid(acc, cur, t + 2, wr, wc, fr, fq); }
        }
        if constexpr (FP8) asm volatile("s_nop 15\n\ts_nop 15" ::: "memory");
        if (wr == 0) G8_BAR;
        S.epi(acc, cur, wr, wc, fr, fq);
        if (!has_next) break;
#pragma unroll
        for (int a = 0; a < 2; ++a)
#pragma unroll
            for (int b = 0; b < 2; ++b)
#pragma unroll
                for (int m = 0; m < 4; ++m)
#pragma unroll
                    for (int n = 0; n < 2; ++n) acc[a][b][m][n] = (f32x4){0.f, 0.f, 0.f, 0.f};
        cur = nxt; cA = nA;
#pragma unroll
        for (int h = 0; h < 2; ++h)
#pragma unroll
            for (int i = 0; i < 2; ++i) co[h][i] = no[h][i];
        ++ui;
        if (wr == 1) G8_BAR;
    }
    G8_WAIT_V(0);
    G8_BAR;
#undef G8_SA
#undef G8_SB
#undef G8_STAGE_A
#undef G8_STAGE_B
#undef G8_LDA
#undef G8_LDB
#undef G8_MMA
#undef G8_WAIT_V
#undef G8_WAIT_L
#undef G8_BAR
#undef G8_SCHED
}
}

__device__ __forceinline__ float rstd_from(const float* ss, int row, int fq) {
    const f32x4 v = *(const f32x4*)(ss + (size_t)row * 16 + fq * 4);
    float s = (v[0] + v[1]) + (v[2] + v[3]); s += __shfl_xor(s, 16); s += __shfl_xor(s, 32);
    return rsqrtf(s * (1.0f / D) + EPS);
}
__device__ __forceinline__ void rstd8(const float* ss, const int (&rows)[2][4], int fq, float (&rs)[2][4]) {
    f32x4 v[2][4];
#pragma unroll
    for (int ai = 0; ai < 2; ++ai)
#pragma unroll
        for (int m = 0; m < 4; ++m) v[ai][m] = *(const f32x4*)(ss + (size_t)rows[ai][m] * 16 + fq * 4);
#pragma unroll
    for (int ai = 0; ai < 2; ++ai)
#pragma unroll
        for (int m = 0; m < 4; ++m) { float s = (v[ai][m][0] + v[ai][m][1]) + (v[ai][m][2] + v[ai][m][3]); s += __shfl_xor(s, 16); s += __shfl_xor(s, 32); rs[ai][m] = rsqrtf(s * (1.0f / D) + EPS); }
}
__device__ __forceinline__ void rows8(int row0, int (&rows)[2][4]) {
#pragma unroll
    for (int ai = 0; ai < 2; ++ai)
#pragma unroll
        for (int m = 0; m < 4; ++m) rows[ai][m] = row0 + ai * 128 + m * 16;
}
__device__ __forceinline__ size_t gate_off(int pm, int k, int pn, int wid, int lane) { return ((((size_t)pm * 3 + k) * 4 + pn) * 8 + wid) * 8192 + (size_t)lane * 8; }
#define GATE_EL(ai, m, bj) ((((ai) * 4 + (m)) * 2 + (bj)) * 512)
__device__ __forceinline__ u32x2 pack8_u8(f32x4 a, f32x4 b) {
    unsigned lo = 0, hi = 0;
#pragma unroll
    for (int j = 0; j < 4; ++j) { lo = __builtin_amdgcn_cvt_pk_u8_f32(fmaxf(__builtin_rintf(a[j] * 255.0f), 1.0f), j, lo); hi = __builtin_amdgcn_cvt_pk_u8_f32(fmaxf(__builtin_rintf(b[j] * 255.0f), 1.0f), j, hi); }
    return (u32x2){lo, hi}; }
__device__ __forceinline__ void unpack8_u8(u32x2 w, f32x4& a, f32x4& b) {
    a = (f32x4){(float)(w.x & 255u), (float)((w.x >> 8) & 255u), (float)((w.x >> 16) & 255u), (float)(w.x >> 24)};
    b = (f32x4){(float)(w.y & 255u), (float)((w.y >> 8) & 255u), (float)((w.y >> 16) & 255u), (float)(w.y >> 24)}; }

typedef f32x4 Acc[2][2][4][2];
struct InGemm : g8::DenseBase {
    static constexpr bool PERM = true;
    int pn_off; float gsc;
    __device__ __forceinline__ bool next(int i, Unit& u) const {
        if (pn_off == 0 || ord.G != 256) return ord.next(i, u);
        if (i < 5) return ord.map((long)i * 256 + ord.c, u);
        if (ord.c >= 128 && i < 7) return ord.map(1280 + (long)(ord.c - 128) * 2 + (i - 5), u);
        return false;
    }
    __device__ __forceinline__ void epi(Acc& acc, const Unit& u, int wr, int wc, int fr, int fq) const {
        fr = opaque(fr); fq = opaque(fq);
        unsigned char* w_ = ws; unsigned char* d_ = dout; asm volatile("" : "+s"(w_), "+s"(d_));
        bf16_t* Z3 = (bf16_t*)(w_ + WS_ZA); bf16_t* QK = (bf16_t*)(d_ + DO_Q); bf16_t* V = (bf16_t*)(w_ + WS_V); bf16_t* G = (bf16_t*)(w_ + WS_G);
        float* ssv = (float*)(w_ + WS_SSV); const float* ssx = (const float*)(w_ + WS_SSX); const float* gqk = (const float*)(w_ + WS_MISC + MISC_GQK) + l * 128;
        inptr_t in_ = inq; asm volatile("" : "+s"(in_)); const float* gate_b = in_[12] + (size_t)l * 3072;
        const int row0 = opaque(u.pm * 256 + wr * 64 + fr), pn = u.pn + pn_off, cl = wc * 32 + fq * 8;
        int rows[2][4]; rows8(row0, rows); float rs[2][4]; rstd8(ssx, rows, fq, rs);
        if (pn_off) {
#pragma unroll
            for (int ai = 0; ai < 2; ++ai)
#pragma unroll
                for (int m = 0; m < 4; ++m) rs[ai][m] *= gsc;
        }
        if (pn <= 2) {
            bf16_t* O = Z3 + (size_t)pn * ((size_t)M * 256);
#pragma unroll
            for (int ai = 0; ai < 2; ++ai)
#pragma unroll
                for (int m = 0; m < 4; ++m) {
                    const int row = rows[ai][m]; const float r = rs[ai][m]; float sq = 0.f;
#pragma unroll
                    for (int bj = 0; bj < 2; ++bj) {
                        f32x4 a = acc[ai][bj][m][0] * r, b = acc[ai][bj][m][1] * r;
                        if (pn >= 1) {
#pragma unroll
                            for (int j = 0; j < 4; ++j) { a[j] = gelu_t(a[j]); b[j] = gelu_t(b[j]); }
                        }
                        const u32x4 w = pack8(a, b); sq += sqpk(w);
                        *(u32x4*)(O + (size_t)row * 256 + bj * 128 + cl) = w;
                    }
                    if (pn == 2) { sq += __shfl_xor(sq, 16); sq += __shfl_xor(sq, 32); if (fq == 0) ssv[(size_t)row * 4 + wc] = sq; }
                }
        } else if (pn <= 6) {
            const bool isq = pn <= 4; const float* gg = gqk + (isq ? 0 : 64); bf16_t* O = QK + (isq ? (size_t)0 : (size_t)M * 512);
            const int head = 4 * ((pn - 3) & 1) + wc;
            f32x4 gv[2][2];
#pragma unroll
            for (int bj = 0; bj < 2; ++bj)
#pragma unroll
                for (int n = 0; n < 2; ++n) gv[bj][n] = *(const f32x4*)(gg + bj * 32 + fq * 8 + n * 4);
#pragma unroll
            for (int ai = 0; ai < 2; ++ai)
#pragma unroll
                for (int m = 0; m < 4; ++m) {
                    const int row = rows[ai][m]; const float r = rs[ai][m];
                    f32x4 v[2][2]; float sq = 0.f;
#pragma unroll
                    for (int bj = 0; bj < 2; ++bj)
#pragma unroll
                        for (int n = 0; n < 2; ++n) { v[bj][n] = acc[ai][bj][m][n] * r; sq += sq4(v[bj][n]); }
                    sq += __shfl_xor(sq, 16); sq += __shfl_xor(sq, 32);
                    const float ri = rsqrtf(sq * (1.0f / 64.0f) + EPS) * (isq ? C2 : 1.0f);
#pragma unroll
                    for (int bj = 0; bj < 2; ++bj)
                        *(u32x4*)(O + (size_t)row * 512 + head * 64 + bj * 32 + fq * 8) = pack8(v[bj][0] * ri * gv[bj][0], v[bj][1] * ri * gv[bj][1]);
                }
        } else if (pn <= 8) {
#pragma unroll
            for (int ai = 0; ai < 2; ++ai)
#pragma unroll
                for (int m = 0; m < 4; ++m) {
                    const int row = rows[ai][m]; const float r = rs[ai][m];
#pragma unroll
                    for (int bj = 0; bj < 2; ++bj)
                        *(u32x4*)(V + (size_t)row * 512 + (pn - 7) * 256 + bj * 128 + cl) = pack8(acc[ai][bj][m][0] * r, acc[ai][bj][m][1] * r);
                }
        } else {
            const int gc = (pn - 9) * 256, k = (pn - 9) >> 2, pnn = (pn - 9) & 3;
            unsigned char* gp = (unsigned char*)G + gate_off(u.pm, k, pnn, wr * 4 + wc, fq * 16 + fr);
            f32x4 gb[2][2];
#pragma unroll
            for (int bj = 0; bj < 2; ++bj)
#pragma unroll
                for (int n = 0; n < 2; ++n) gb[bj][n] = *(const f32x4*)(gate_b + gc + bj * 128 + cl + n * 4);
#pragma unroll
            for (int ai = 0; ai < 2; ++ai)
#pragma unroll
                for (int m = 0; m < 4; ++m) {
                    const float r = rs[ai][m];
#pragma unroll
                    for (int bj = 0; bj < 2; ++bj) {
                        f32x4 a = acc[ai][bj][m][0] * r + gb[bj][0], b = acc[ai][bj][m][1] * r + gb[bj][1];
#pragma unroll
                        for (int j = 0; j < 4; ++j) { a[j] = sigmoid_f(a[j]); b[j] = sigmoid_f(b[j]); }
                        *(u32x2*)(gp + GATE_EL(ai, m, bj)) = pack8_u8(a, b);
                    }
                }
        }
    }
};
struct StoreGemm : g8::DenseBase {
    static constexpr bool PERM = true;
    int nfree, rank, nunits;
    __device__ __forceinline__ bool next(int i, Unit& u) const { if (rank < 0) return false; const int p = i * nfree + rank; if (p >= nunits) return false; u.pm = p >> 2; u.pn = p & 3; return true; }
    __device__ __forceinline__ void epi(Acc& acc, const Unit& u, int wr, int wc, int fr, int fq) const {
        fr = opaque(fr); fq = opaque(fq);
        unsigned char* w_ = ws; unsigned char* d_ = dout; asm volatile("" : "+s"(w_), "+s"(d_));
        bf16_t* O = (l == 0) ? (bf16_t*)(d_ + DO_PY) : (bf16_t*)(w_ + WS_XA); const int ldo = 1024;
        const int row0 = opaque(u.pm * 256 + wr * 64 + fr), cl = u.pn * 256 + wc * 32 + fq * 8;
#pragma unroll
        for (int ai = 0; ai < 2; ++ai)
#pragma unroll
            for (int m = 0; m < 4; ++m) {
                const int row = row0 + ai * 128 + m * 16;
#pragma unroll
                for (int bj = 0; bj < 2; ++bj) *(u32x4*)(O + (size_t)row * ldo + bj * 128 + cl) = pack8(acc[ai][bj][m][0], acc[ai][bj][m][1]);
            }
    }
};
struct BranchGemm : g8::DenseBase {
    static constexpr bool PERM = true;
    __device__ __forceinline__ void mid(Acc& acc, const Unit& u, int kdone, int wr, int wc, int fr, int fq) const {
        if (kdone != 4 && kdone != 8) return;
        fr = opaque(fr); fq = opaque(fq);
        const int k0 = (kdone == 4) ? 0 : 1;
        unsigned char* w_ = ws; unsigned char* d_ = dout; asm volatile("" : "+s"(w_), "+s"(d_));
        const bf16_t* G = (const bf16_t*)(w_ + WS_G);
        const int lane = opaque(fq * 16 + fr);
        const unsigned char* gn = (const unsigned char*)G + gate_off(u.pm, k0, u.pn, wr * 4 + wc, lane); const unsigned char* gd = (const unsigned char*)G + gate_off(u.pm, k0 + 1, u.pn, wr * 4 + wc, lane);
#pragma unroll
        for (int ai = 0; ai < 2; ++ai) {
            u32x2 nv[4][2], dv[4][2];
#pragma unroll
            for (int m = 0; m < 4; ++m)
#pragma unroll
                for (int bj = 0; bj < 2; ++bj) { nv[m][bj] = *(const u32x2*)(gn + GATE_EL(ai, m, bj)); dv[m][bj] = *(const u32x2*)(gd + GATE_EL(ai, m, bj)); }
#pragma unroll
            for (int m = 0; m < 4; ++m)
#pragma unroll
                for (int bj = 0; bj < 2; ++bj) { f32x4 na, nb, da, db; unpack8_u8(nv[m][bj], na, nb); unpack8_u8(dv[m][bj], da, db);
#pragma unroll
                    for (int j = 0; j < 4; ++j) { acc[ai][bj][m][0][j] *= na[j] * fast_rcp(da[j]); acc[ai][bj][m][1][j] *= nb[j] * fast_rcp(db[j]); } }
            asm volatile("" ::: "memory");
        }
    }
    __device__ __forceinline__ void epi(Acc& acc, const Unit& u, int wr, int wc, int fr, int fq) const {
        fr = opaque(fr); fq = opaque(fq);
        unsigned char* w_ = ws; unsigned char* d_ = dout; asm volatile("" : "+s"(w_), "+s"(d_));
        const bf16_t* G = (const bf16_t*)(w_ + WS_G); bf16_t* Mg = (bf16_t*)(w_ + WS_MERGED);
        const int row0 = opaque(u.pm * 256 + wr * 64 + fr), cl = u.pn * 256 + wc * 32 + fq * 8;
        const unsigned char* gc = (const unsigned char*)G + gate_off(u.pm, 2, u.pn, wr * 4 + wc, fq * 16 + fr);
        u32x2 gv[2][4][2];
#pragma unroll
        for (int ai = 0; ai < 2; ++ai)
#pragma unroll
            for (int m = 0; m < 4; ++m)
#pragma unroll
                for (int bj = 0; bj < 2; ++bj) gv[ai][m][bj] = *(const u32x2*)(gc + GATE_EL(ai, m, bj));
#pragma unroll
        for (int ai = 0; ai < 2; ++ai)
#pragma unroll
            for (int m = 0; m < 4; ++m) {
                const int row = row0 + ai * 128 + m * 16;
#pragma unroll
                for (int bj = 0; bj < 2; ++bj) { f32x4 ga, gb; unpack8_u8(gv[ai][m][bj], ga, gb);
                    *(u32x4*)(Mg + (size_t)row * 1024 + bj * 128 + cl) = pack8(acc[ai][bj][m][0] * (ga * (1.0f / 255.0f)), acc[ai][bj][m][1] * (gb * (1.0f / 255.0f))); }
            }
    }
};
struct OutGemm : g8::DenseBase {
    static constexpr bool PERM = true;
    float alpha;
    __device__ __forceinline__ void epi(Acc& acc, const Unit& u, int wr, int wc, int fr, int fq) const {
        fr = opaque(fr); fq = opaque(fq);
        unsigned char* w_ = ws; unsigned char* d_ = dout; asm volatile("" : "+s"(w_), "+s"(d_));
        bf16_t* X = (bf16_t*)(w_ + (l == 0 ? WS_XA : WS_XB)); float* ss = (float*)(w_ + WS_SS1);
        const int row0 = opaque(u.pm * 256 + wr * 64 + fr), cl = u.pn * 256 + wc * 32 + fq * 8;
#pragma unroll
        for (int ai = 0; ai < 2; ++ai) {
            u32x4 xv[4][2];
#pragma unroll
            for (int m = 0; m < 4; ++m)
#pragma unroll
                for (int bj = 0; bj < 2; ++bj) xv[m][bj] = *(const u32x4*)(X + (size_t)(row0 + ai * 128 + m * 16) * 1024 + bj * 128 + cl);
#pragma unroll
            for (int m = 0; m < 4; ++m) {
                const int row = row0 + ai * 128 + m * 16; float sq = 0.f;
#pragma unroll
                for (int bj = 0; bj < 2; ++bj) { f32x4 pa, pb; unpack8(xv[m][bj], pa, pb);
                    const f32x4 na = pa + acc[ai][bj][m][0] * alpha, nb = pb + acc[ai][bj][m][1] * alpha; const u32x4 w = pack8(na, nb); sq += sqpk(w);
                    *(u32x4*)(X + (size_t)row * 1024 + bj * 128 + cl) = w; *(u32x2*)(w_ + WS_X8 + (size_t)row * 1024 + bj * 128 + cl) = pack8_fp8(na, nb, SX8); }
                sq += __shfl_xor(sq, 16); sq += __shfl_xor(sq, 32);
                if (fq == 0) ss[(size_t)row * 16 + u.pn * 4 + wc] = sq;
            }
            asm volatile("" ::: "memory");
        }
    }
};
struct PleGemm : g8::DenseBase {
    static constexpr bool PERM = true;
    int lastl; float gsc;
    __device__ __forceinline__ void epi(Acc& acc, const Unit& u, int wr, int wc, int fr, int fq) const {
        fr = opaque(fr); fq = opaque(fq);
        unsigned char* w_ = ws; unsigned char* d_ = dout; asm volatile("" : "+s"(w_), "+s"(d_));
        const bf16_t* X = (const bf16_t*)(w_ + (l == 0 ? WS_XA : WS_XB)); bf16_t* Xn = (bf16_t*)(w_ + (l == 0 ? WS_XB : WS_XA)); const bf16_t* Pp = (l == 0) ? (const bf16_t*)(d_ + DO_PY) : (const bf16_t*)(w_ + WS_XA);
        const float* ss2 = (const float*)(w_ + WS_SS2); float* ssn = (float*)(w_ + WS_SSX); float* out = (float*)d_; unsigned char* X8n = w_ + WS_X8;
        const int row0 = opaque(u.pm * 256 + wr * 64 + fr), cl = u.pn * 256 + wc * 32 + fq * 8;
        int rows[2][4]; rows8(row0, rows); float rs[2][4]; rstd8(ss2, rows, fq, rs);
#pragma unroll
        for (int ai = 0; ai < 2; ++ai)
#pragma unroll
            for (int m = 0; m < 4; ++m) rs[ai][m] *= gsc;
#pragma unroll
        for (int ai = 0; ai < 2; ++ai)
#pragma unroll
            for (int mp = 0; mp < 2; ++mp) {
                u32x4 xv[2][2], pv[2][2];
#pragma unroll
                for (int mm = 0; mm < 2; ++mm)
#pragma unroll
                    for (int bj = 0; bj < 2; ++bj) { const size_t off = (size_t)rows[ai][mp * 2 + mm] * 1024 + bj * 128 + cl; xv[mm][bj] = *(const u32x4*)(X + off); pv[mm][bj] = *(const u32x4*)(Pp + off); }
#pragma unroll
                for (int mm = 0; mm < 2; ++mm) {
                    const int m = mp * 2 + mm; const int row = rows[ai][m]; const float r = rs[ai][m]; float sq = 0.f;
#pragma unroll
                    for (int bj = 0; bj < 2; ++bj) {
                        const size_t off = (size_t)row * 1024 + bj * 128 + cl;
                        f32x4 xa, xb, pa, pb; unpack8(xv[mm][bj], xa, xb); unpack8(pv[mm][bj], pa, pb);
                        f32x4 a = acc[ai][bj][m][0] * r, b = acc[ai][bj][m][1] * r;
#pragma unroll
                        for (int j = 0; j < 4; ++j) { a[j] = xa[j] + pa[j] * sigmoid_f(a[j]); b[j] = xb[j] + pb[j] * sigmoid_f(b[j]); }
                        if (lastl) { *(f32x4*)(out + off) = a; *(f32x4*)(out + off + 4) = b; }
                        else { const u32x4 w = pack8(a, b); sq += sqpk(w); *(u32x4*)(Xn + off) = w; *(u32x2*)(X8n + off) = pack8_fp8(a, b, SX8); }
                    }
                    if (!lastl) { sq += __shfl_xor(sq, 16); sq += __shfl_xor(sq, 32); if (fq == 0) ssn[(size_t)row * 16 + u.pn * 4 + wc] = sq; }
                }
                asm volatile("" ::: "memory");
            }
    }
};

#define XB_TMO      128
#define XB_XCNT(j)  (256  + 64 * (j))
#define XB_XSUB(j)  (1280 + 64 * (j))
#define XB_XGEN(j)  (2304 + 64 * (j))
#define XB_TOP      3328
#define XB_TOPGEN   3392
#define XCD_BAR_WORDS 3456
#define XB_SPIN_CAP (1u << 18)

__device__ __forceinline__ unsigned xb_ld(unsigned* p)              { return __hip_atomic_load(p, __ATOMIC_RELAXED, __HIP_MEMORY_SCOPE_AGENT); }
__device__ __forceinline__ unsigned xb_add(unsigned* p, unsigned v) { return __hip_atomic_fetch_add(p, v, __ATOMIC_RELAXED, __HIP_MEMORY_SCOPE_AGENT); }
__device__ __forceinline__ unsigned xb_xcc_id() { return (unsigned)__builtin_amdgcn_s_getreg((3 << 11) | 20) & 0xFu; }
#define XB_SPIN(cond, bar) do { unsigned _sp = 0; while (cond) { __builtin_amdgcn_s_sleep(1); \
    if ((++_sp & 255u) == 0u) { if (xb_ld(&(bar)[XB_TMO])) break; if (_sp > XB_SPIN_CAP) { atomicAdd(&(bar)[XB_TMO], 1u); break; } } } } while (0)

struct XcdBarrier {
    unsigned* bar; unsigned x;
    volatile LAS unsigned* st;
};

__device__ __forceinline__ XcdBarrier xcd_barrier_post(unsigned* bar, volatile LAS unsigned* st) {
    XcdBarrier b; b.bar = bar; b.x = xb_xcc_id(); b.st = st;
    if (threadIdx.x == 0) (void)xb_add(&bar[XB_XCNT(b.x)], 1u);
    return b;
}
__device__ __forceinline__ void xcd_barrier_complete(unsigned* bar, unsigned x, unsigned& nloc, unsigned& nx) {
    const unsigned G = gridDim.x * gridDim.y * gridDim.z;
    unsigned sum, cnt, mine, sp = 0u;
    for (;;) {
        sum = 0u; cnt = 0u; mine = 0u;
#pragma unroll
        for (unsigned j = 0; j < 16; ++j) { const unsigned c = xb_ld(&bar[XB_XCNT(j)]); sum += c; cnt += (c > 0u) ? 1u : 0u; mine = (j == x) ? c : mine; }
        if (sum == G) break;
        __builtin_amdgcn_s_sleep(1);
        if ((++sp & 255u) == 0u) { if (xb_ld(&bar[XB_TMO])) break; if (sp > XB_SPIN_CAP) { atomicAdd(&bar[XB_TMO], 1u); break; } }
    }
    nloc = mine > 0u ? mine : 1u; nx = cnt > 0u ? cnt : 1u;
}

__device__ __forceinline__ void xcd_barrier(const XcdBarrier& b) {
    asm volatile("s_waitcnt vmcnt(0)" ::: "memory");
    __syncthreads();
    if (threadIdx.x == 0) {
        unsigned* bar = b.bar; unsigned bx = b.x; asm volatile("" : "+s"(bar), "+s"(bx));
        __builtin_amdgcn_s_waitcnt(0);
        unsigned nloc = b.st[0], nx = b.st[1];
        if (nloc == 0u) { xcd_barrier_complete(bar, bx, nloc, nx); b.st[0] = nloc; b.st[1] = nx; }
        const unsigned old = xb_add(&bar[XB_XSUB(bx)], 1u);
        const unsigned gen = old / nloc;
        if (old + 1u == (gen + 1u) * nloc) {
            __builtin_amdgcn_fence(__ATOMIC_RELEASE, "agent");
            asm volatile("s_waitcnt vmcnt(0)" ::: "memory");
            const unsigned og = xb_add(&bar[XB_TOP], 1u);
            const unsigned tg = og / nx;
            if (og + 1u == (tg + 1u) * nx) xb_add(&bar[XB_TOPGEN], 1u);
            else XB_SPIN(xb_ld(&bar[XB_TOPGEN]) == tg, bar);
            __builtin_amdgcn_fence(__ATOMIC_ACQUIRE, "agent");
            xb_add(&bar[XB_XGEN(bx)], 1u);
            asm volatile("s_waitcnt vmcnt(0)" ::: "memory");
        } else {
            XB_SPIN(xb_ld(&bar[XB_XGEN(bx)]) == gen, bar);
            __builtin_amdgcn_fence(__ATOMIC_ACQUIRE, "agent");
            asm volatile("s_waitcnt vmcnt(0)" ::: "memory");
        }
    }
    __syncthreads();
}

struct Args { const float* in[27]; float* out; unsigned char* ws; int rep_n, pad; };
struct Frame {
    LAS unsigned char* lds; gu32* ctl; unsigned char* ws; unsigned char* dout;
    int tid, lane, wave, G, gw, NGW;
    inptr_t in;
};

__device__ __forceinline__ void transpose_item(const float* src, int src_ld, int k0, int src_col0, bf16_t* dst, int dst_ld, int dst_row0, int dst_k0, const float* kscale, LAS float* scr, int lane, float fp8s = 0.f) {
#pragma unroll 8
    for (int i = 0; i < 32; ++i) { const int kk = 2 * i + (lane >> 5); float v = src[(size_t)(k0 + kk) * src_ld + src_col0 + (lane & 31)]; if (kscale) v *= kscale[k0 + kk]; scr[kk * 33 + (lane & 31)] = v; }
    asm volatile("s_waitcnt lgkmcnt(0)" ::: "memory");
    const int c = lane & 7;
#pragma unroll
    for (int j = 0; j < 4; ++j) { const int n = (lane >> 3) + 8 * j; const LAS float* s = scr + (8 * c) * 33 + n;
        if (fp8s != 0.f) { const f32x4 a = {s[0 * 33], s[1 * 33], s[2 * 33], s[3 * 33]}, b = {s[4 * 33], s[5 * 33], s[6 * 33], s[7 * 33]};
            *(u32x2*)((unsigned char*)dst + (size_t)(dst_row0 + n) * dst_ld + dst_k0 + k0 + 8 * c) = pack8_fp8(a, b, fp8s); continue; }
        u32x4 o; o.x = cvt_pk_bf16(s[0 * 33], s[1 * 33]); o.y = cvt_pk_bf16(s[2 * 33], s[3 * 33]); o.z = cvt_pk_bf16(s[4 * 33], s[5 * 33]); o.w = cvt_pk_bf16(s[6 * 33], s[7 * 33]);
        *(u32x4*)(dst + (size_t)(dst_row0 + n) * dst_ld + dst_k0 + k0 + 8 * c) = o; }
    asm volatile("s_waitcnt lgkmcnt(0)" ::: "memory");
}
__device__ __forceinline__ void transpose_item64(const float* src, int src_ld, int k0, int col0a, int col0b, bf16_t* dst, int dst_ld, int dst_row0, int dst_k0, const float* kscale, LAS float* scr, int lane, float fp8s = 0.f) {
    const int cq = lane & 15, kr = lane >> 4; const int scol = (cq < 8) ? col0a + 4 * cq : col0b + 4 * (cq - 8);
    f32x4 v[16];
#pragma unroll
    for (int i = 0; i < 16; ++i) v[i] = *(const f32x4*)(src + (size_t)(k0 + kr + 4 * i) * src_ld + scol);
    if (kscale) {
#pragma unroll
        for (int i = 0; i < 16; ++i) v[i] = v[i] * kscale[k0 + kr + 4 * i];
    }
#pragma unroll
    for (int i = 0; i < 16; ++i) { LAS float* p = scr + (4 * cq) * 65 + kr + 4 * i; p[0] = v[i][0]; p[65] = v[i][1]; p[130] = v[i][2]; p[195] = v[i][3]; }
    asm volatile("s_waitcnt lgkmcnt(0)" ::: "memory");
    const int c = lane & 7;
#pragma unroll
    for (int j = 0; j < 8; ++j) { const int n = (lane >> 3) + 8 * j; const LAS float* q = scr + n * 65 + 8 * c;
        const f32x4 a = {q[0], q[1], q[2], q[3]}, b = {q[4], q[5], q[6], q[7]};
        if (fp8s != 0.f) *(u32x2*)((unsigned char*)dst + (size_t)(dst_row0 + n) * dst_ld + dst_k0 + k0 + 8 * c) = pack8_fp8(a, b, fp8s);
        else *(u32x4*)(dst + (size_t)(dst_row0 + n) * dst_ld + dst_k0 + k0 + 8 * c) = pack8(a, b); }
    asm volatile("s_waitcnt lgkmcnt(0)" ::: "memory");
}
__device__ __forceinline__ int win_src_col(int n) {
    const int pn = n >> 8, c = n & 255;
    if (pn >= 3 && pn <= 6) { const int bj = c >> 7, wcc = (c >> 5) & 3; const int base = (pn <= 4) ? 768 : 1280; return base + (4 * ((pn - 3) & 1) + wcc) * 64 + 32 * bj; }
    return n;
}
__device__ __forceinline__ void prep_layer(Frame& Fr, int l) {
    Frame F = Fr; F.lane = opaque(Fr.lane); F.gw = blockIdx.x * 8 + __builtin_amdgcn_readfirstlane(opaque(Fr.tid) >> 6);
    LAS float* scr = (LAS float*)(F.lds + F.wave * 16896);
    const float* mixg = F.in[2] + (size_t)l * D; const float* w_in = F.in[3] + (size_t)l * D * NIN;
    const float* pool_w = F.in[4] + (size_t)l * 4 * 64 * 64; const float* pool_s = F.in[5] + (size_t)l * 256;
    const float* wba = F.in[13] + (size_t)l * 256 * D; const float* wbb = F.in[14] + (size_t)l * 256 * D; const float* wbc = F.in[15] + (size_t)l * 512 * D;
    const float* wout = F.in[16] + (size_t)l * D * D; const float* ffng = F.in[17] + (size_t)l * D;
    const float* wein = F.in[22] + (size_t)l * NEXP * D * 256; const float* weout = F.in[23] + (size_t)l * NEXP * DEXP * D;
    bf16_t* Win_t = (bf16_t*)(F.ws + WS_WIN); bf16_t* Wbr_t = (bf16_t*)(F.ws + WS_WBR); bf16_t* Wout_t = (bf16_t*)(F.ws + WS_WOUT);
    bf16_t* Wein_t = (bf16_t*)(F.ws + WS_WEIN); bf16_t* Weout_t = (bf16_t*)(F.ws + WS_WEOUT);
    constexpr int I_IN = 16 * 80, I_POOL = 1024, I_BA = 4 * 16, I_BC = 8 * 16, I_OUT = 16 * 16, I_EIN = NEXP * 16 * 4, I_EOUT = NEXP * 2 * 16;
    constexpr int NITEMS = I_IN + I_POOL + 2 * I_BA + I_BC + I_OUT + I_EIN + I_EOUT;
    for (int it = F.gw; it < NITEMS; it += F.NGW) {
        int r = it;
        if (r < I_IN) { const int kb = r / 80, nb = r % 80 + 4;
            if (nb < 36) transpose_item64(w_in, NIN, 64 * kb, win_src_col(64 * nb), win_src_col(64 * nb + 32), Win_t, D, 64 * nb, 0, mixg, scr, F.lane);
            else transpose_item64(w_in, NIN, 64 * kb, 64 * nb, 64 * nb + 32, (bf16_t*)(F.ws + WS_WIN8), D, 64 * (nb - 36), 0, mixg, scr, F.lane, SW8);
            continue; } r -= I_IN;
        if (r < I_POOL) {
            const int nb = r & 7, kb = r >> 3, g = nb >> 1, d0 = (nb & 1) * 32, nn = F.lane & 31, kh = F.lane >> 5, kbase = kb * 8 + kh * 4;
            float a[4] = {0.f, 0.f, 0.f, 0.f};
#pragma unroll 8
            for (int c = 0; c < 64; ++c) { const float pw = pool_w[(size_t)g * 4096 + c * 64 + d0 + nn];
#pragma unroll
                for (int j = 0; j < 4; ++j) a[j] += w_in[(size_t)(kbase + j) * NIN + g * 64 + c] * pw; }
            const float sc = pool_s[g * 64 + d0 + nn];
            u32x2 o; o.x = cvt_pk_bf16(a[0] * sc * mixg[kbase], a[1] * sc * mixg[kbase + 1]); o.y = cvt_pk_bf16(a[2] * sc * mixg[kbase + 2], a[3] * sc * mixg[kbase + 3]);
            *(u32x2*)(Win_t + (size_t)(g * 64 + d0 + nn) * D + kbase) = o; continue; } r -= I_POOL;
        if (r < I_BA) { transpose_item64(wba, D, 64 * (r / 16), 64 * (r % 16), 64 * (r % 16) + 32, Wbr_t, D, 64 * (r % 16), 0, nullptr, scr, F.lane); continue; } r -= I_BA;
        if (r < I_BA) { transpose_item64(wbb, D, 64 * (r / 16), 64 * (r % 16), 64 * (r % 16) + 32, Wbr_t, D, 64 * (r % 16), 256, nullptr, scr, F.lane); continue; } r -= I_BA;
        if (r < I_BC) { transpose_item64(wbc, D, 64 * (r / 16), 64 * (r % 16), 64 * (r % 16) + 32, Wbr_t, D, 64 * (r % 16), 512, nullptr, scr, F.lane); continue; } r -= I_BC;
        if (r < I_OUT) { transpose_item64(wout, D, 64 * (r / 16), 64 * (r % 16), 64 * (r % 16) + 32, Wout_t, D, 64 * (r % 16), 0, nullptr, scr, F.lane); continue; } r -= I_OUT;
        if (r < I_EIN) { const int e = r / 64, q = r % 64; transpose_item64(wein + (size_t)e * D * 256, 256, 64 * (q / 4), 64 * (q % 4), 64 * (q % 4) + 32, (bf16_t*)((unsigned char*)Wein_t + (size_t)e * 256 * D), D, 64 * (q % 4), 0, ffng, scr, F.lane, SW8); continue; } r -= I_EIN;
        { const int e = r / 32, q = r % 32; transpose_item64(weout + (size_t)e * DEXP * D, D, 64 * (q / 16), 64 * (q % 16), 64 * (q % 16) + 32, Weout_t + (size_t)e * D * DEXP, DEXP, 64 * (q % 16), 0, nullptr, scr, F.lane); }
    }
    const float* p = F.in[1] + (size_t)l * M * PLE; bf16_t* pb = (bf16_t*)(F.ws + WS_PB);
#pragma unroll 4
    for (size_t i = (size_t)F.gw * 64 + F.lane; i < (size_t)M * PLE / 8; i += (size_t)F.NGW * 64) {
        const f32x4 a = *(const f32x4*)(p + i * 8), b = *(const f32x4*)(p + i * 8 + 4); *(u32x4*)(pb + i * 8) = pack8(a, b); }
}
__device__ __forceinline__ void prologue(Frame& Fr) {
    Frame F = Fr; F.lane = opaque(Fr.lane); F.gw = blockIdx.x * 8 + __builtin_amdgcn_readfirstlane(opaque(Fr.tid) >> 6);
    LAS float* scr = (LAS float*)(F.lds + F.wave * 16896);
    constexpr int I_G = 16 * 16, I_P = 4 * 16;
    for (int it = F.gw; it < DEPTH * (I_G + I_P); it += F.NGW) {
        const int l = it / (I_G + I_P); int r = it % (I_G + I_P);
        if (r < I_G) { transpose_item64(F.in[26] + (size_t)l * D * D, D, 64 * (r / 16), 64 * (r % 16), 64 * (r % 16) + 32, (bf16_t*)(F.ws + WS_WGATE + (size_t)l * 2 * MiB), D, 64 * (r % 16), 0, F.in[24] + (size_t)l * D, scr, F.lane, SW8); continue; } r -= I_G;
        transpose_item64(F.in[25] + (size_t)l * PLE * D, D, 64 * (r / 16), 64 * (r % 16), 64 * (r % 16) + 32, (bf16_t*)(F.ws + WS_WPLE) + (size_t)l * (512 * 1024), PLE, 64 * (r % 16), 0, nullptr, scr, F.lane);
    }
    for (int i = F.gw * 64 + F.lane; i < DEPTH * 96 * D; i += F.NGW * 64) {
        const int l = i / (96 * D), o = (i / D) % 96, k = i % D; bf16_t r = 0;
        if (o < 72) { const int oo = o < 36 ? o : o - 36;
            const float w = ((oo < 4) ? F.in[18][((size_t)l * D + k) * 4 + oo] : F.in[20][((size_t)l * D + k) * 32 + (oo - 4)]) * F.in[17][(size_t)l * D + k];
            const bf16_t h = f2bf(w); r = (o < 36) ? h : f2bf(w - bf2f(h)); }
        ((bf16_t*)(F.ws + WS_WR))[i] = r;
    }
    if (F.gw == 0) { for (int i = F.lane; i < DEPTH * 36; i += 64) { const int l = i / 36, o = i % 36; ((float*)(F.ws + WS_WR + WR_BIAS))[i] = (o < 4) ? F.in[19][l * 4 + o] : F.in[21][l * 32 + o - 4]; } }
    if (F.gw == 1) { for (int i = F.lane; i < DEPTH * 128; i += 64) { const int l = i >> 7, j = i & 127; ((float*)(F.ws + WS_MISC + MISC_GQK))[i] = (j < 64) ? F.in[9][l * 64 + j] : F.in[10][l * 64 + j - 64]; } }
    for (int i = F.gw * 64 + F.lane; i < DEPTH * 4 * 128 * 128; i += F.NGW * 64) { const int ii = (i >> 7) & 127, jj = i & 127; ((bf16_t*)(F.ws + WS_MISC + MISC_WM))[i] = ((jj >> 6) <= (ii >> 6)) ? f2bf(F.in[7][i]) : (bf16_t)0; }
    for (int i = F.gw * 64 + F.lane; i < DEPTH * 8 * 256; i += F.NGW * 64) { const int lh = i >> 8, ii = i & 255; const int idx = ii + 65 > 256 ? 256 : ii + 65; ((float*)(F.ws + WS_MISC + MISC_TB))[i] = F.in[11][(size_t)lh * 257 + idx] * LOG2E; }
    if (F.gw < DEPTH * 8) {
        const int l = F.gw >> 3; float mq = fabsf(F.in[9][l * 64 + F.lane]), mk = fabsf(F.in[10][l * 64 + F.lane]), mb = -1e30f;
        for (int i = F.lane; i < 257; i += 64) mb = fmaxf(mb, F.in[11][(size_t)F.gw * 257 + i]);
#pragma unroll
        for (int o = 1; o < 64; o <<= 1) { mq = fmaxf(mq, __shfl_xor(mq, o)); mk = fmaxf(mk, __shfl_xor(mk, o)); mb = fmaxf(mb, __shfl_xor(mb, o)); }
        if (F.lane == 0) ((float*)(F.ws + WS_MISC + MISC_ATTM))[F.gw] = (8.0f * mq * mk + mb) * LOG2E;
    }
    bf16_t* XA = (bf16_t*)(F.ws + WS_XA); float* ssx = (float*)(F.ws + WS_SSX);
    for (int m0 = F.gw * 4; m0 < M; m0 += F.NGW * 4) {
        f32x4 v[4][4];
#pragma unroll
        for (int q = 0; q < 4; ++q)
#pragma unroll
            for (int j = 0; j < 4; ++j) v[q][j] = ((const f32x4*)(F.in[0] + (size_t)(m0 + q) * D) + F.lane)[64 * j];
#pragma unroll
        for (int q = 0; q < 4; ++q) { const int m = m0 + q; float s = 0.f;
#pragma unroll
            for (int j = 0; j < 4; ++j) { const f32x4 x = v[q][j]; u32x2 w; w.x = cvt_pk_bf16(x[0], x[1]); w.y = cvt_pk_bf16(x[2], x[3]);
                const float a0 = bflo(w.x), a1 = bfhi(w.x), a2 = bflo(w.y), a3 = bfhi(w.y); s += (a0 * a0 + a1 * a1) + (a2 * a2 + a3 * a3);
                *(u32x2*)(XA + (size_t)m * D + 256 * j + 4 * F.lane) = w;
                { int p8 = __builtin_amdgcn_cvt_pk_fp8_f32(x[0] * SX8, x[1] * SX8, 0, false); p8 = __builtin_amdgcn_cvt_pk_fp8_f32(x[2] * SX8, x[3] * SX8, p8, true); *(int*)(F.ws + WS_X8 + (size_t)m * D + 256 * j + 4 * F.lane) = p8; } }
            s = wave_sum(s);
            if (F.lane < 16) ssx[(size_t)m * 16 + F.lane] = (F.lane == 0) ? s : 0.f; }
    }
}

__device__ __forceinline__ void router_phase(Frame& Fr, int l, const bf16_t* X, const float* ss1, bool dry) {
    typedef float f32x16 __attribute__((ext_vector_type(16)));
    Frame F = Fr; F.lane = opaque(Fr.lane); F.tid = opaque(Fr.tid); F.gw = blockIdx.x * 8 + __builtin_amdgcn_readfirstlane(F.tid >> 6);
    const int lane = F.lane, r16 = lane & 15, kq = lane >> 4;
    const bf16_t* Wt = (const bf16_t*)(F.ws + WS_WR) + (size_t)l * 96 * D; const float* br = (const float*)(F.ws + WS_WR + WR_BIAS) + l * 36;
    LAS float* lg;
    int* tok_e = (int*)(F.ws + WS_MISC + MISC_TOKE); float* tok_w = (float*)(F.ws + WS_MISC + MISC_TOKW);
    int* elist = (int*)(F.ws + WS_ELIST); int* plist = (int*)(F.ws + WS_PLIST);
    gu32* cnt = F.ctl + CW_CNT + (size_t)l * 160 * 64;
    LAS unsigned char* tb = F.lds; constexpr int TPITCH = 272, TBUF = 80 * TPITCH;
    lg = (LAS float*)(F.lds + 45056) + F.wave * (16 * 81);
    const int tid = F.tid;
    for (int wt = blockIdx.x; wt < M / 128; wt += F.G) {
        const int tok0 = wt * 128 + F.wave * 16;
        const bf16_t* xr = X + (size_t)(tok0 + r16) * D + kq * 8;
        u32x4 tr[3]; bf16x8 xc[4], xn[4];
#define RT_LOADT(c) do { _Pragma("unroll") for (int p_ = 0; p_ < 3; ++p_) { const int pc_ = tid + 512 * p_; if (pc_ < 1280) tr[p_] = *(const u32x4*)(Wt + (size_t)(pc_ >> 4) * D + (c) * 128 + (pc_ & 15) * 8); } } while (0)
#define RT_STORET(b) do { _Pragma("unroll") for (int p_ = 0; p_ < 3; ++p_) { const int pc_ = tid + 512 * p_; if (pc_ < 1280) *(LAS u32x4*)(tb + (b) * TBUF + (pc_ >> 4) * TPITCH + (pc_ & 15) * 16) = tr[p_]; } } while (0)
        RT_LOADT(0);
#pragma unroll
        for (int s4 = 0; s4 < 4; ++s4) xc[s4] = *(const bf16x8*)(xr + 32 * s4);
        asm volatile("s_waitcnt lgkmcnt(0)\n\ts_barrier" ::: "memory");
        RT_STORET(0);
        f32x4 a0 = {0.f, 0.f, 0.f, 0.f}, a1 = a0, a2 = a0, a3 = a0, a4 = a0;
#pragma unroll 1
        for (int c = 0; c < 8; ++c) {
            if (c + 1 < 8) { RT_LOADT(c + 1);
#pragma unroll
                for (int s4 = 0; s4 < 4; ++s4) xn[s4] = *(const bf16x8*)(xr + 128 * (c + 1) + 32 * s4); }
            asm volatile("s_waitcnt lgkmcnt(0)\n\ts_barrier" ::: "memory");
            const LAS unsigned char* bb = tb + (c & 1) * TBUF + r16 * TPITCH + kq * 16;
#pragma unroll
            for (int s4 = 0; s4 < 4; ++s4) {
                const bf16x8 b0 = *(const LAS bf16x8*)(bb + s4 * 64), b1 = *(const LAS bf16x8*)(bb + 16 * TPITCH + s4 * 64), b2 = *(const LAS bf16x8*)(bb + 32 * TPITCH + s4 * 64),
                             b3 = *(const LAS bf16x8*)(bb + 48 * TPITCH + s4 * 64), b4 = *(const LAS bf16x8*)(bb + 64 * TPITCH + s4 * 64);
                a0 = __builtin_amdgcn_mfma_f32_16x16x32_bf16(xc[s4], b0, a0, 0, 0, 0); a1 = __builtin_amdgcn_mfma_f32_16x16x32_bf16(xc[s4], b1, a1, 0, 0, 0); a2 = __builtin_amdgcn_mfma_f32_16x16x32_bf16(xc[s4], b2, a2, 0, 0, 0);
                a3 = __builtin_amdgcn_mfma_f32_16x16x32_bf16(xc[s4], b3, a3, 0, 0, 0); a4 = __builtin_amdgcn_mfma_f32_16x16x32_bf16(xc[s4], b4, a4, 0, 0, 0);
            }
            if (c + 1 < 8) { RT_STORET((c + 1) & 1);
#pragma unroll
                for (int s4 = 0; s4 < 4; ++s4) xc[s4] = xn[s4]; }
        }
#undef RT_LOADT
#undef RT_STORET
#pragma unroll
        for (int r = 0; r < 4; ++r) { LAS float* p = lg + (4 * kq + r) * 81 + r16; p[0] = a0[r]; p[16] = a1[r]; p[32] = a2[r]; p[48] = a3[r]; p[64] = a4[r]; }
        asm volatile("s_waitcnt lgkmcnt(0)" ::: "memory");
        if (lane < 16) {
            const int tok = tok0 + lane; const LAS float* q = lg + lane * 81;
            const f32x4* sp = (const f32x4*)(ss1 + (size_t)tok * 16); const f32x4 s0 = sp[0], s1 = sp[1], s2 = sp[2], s3 = sp[3];
            const float ssum = (((s0[0] + s0[1]) + (s0[2] + s0[3])) + ((s1[0] + s1[1]) + (s1[2] + s1[3]))) + (((s2[0] + s2[1]) + (s2[2] + s2[3])) + ((s3[0] + s3[1]) + (s3[2] + s3[3])));
            const float rstd = rsqrtf(ssum * (1.0f / D) + EPS);
#define RLOGIT(o) ((q[(o)] + q[36 + (o)]) * rstd + br[(o)])
            int g = 0; float gm = RLOGIT(0); float gl[4]; gl[0] = gm;
#pragma unroll
            for (int j = 1; j < 4; ++j) { gl[j] = RLOGIT(j); if (gl[j] > gm) { gm = gl[j]; g = j; } }
            float gs = 0.f;
#pragma unroll
            for (int j = 0; j < 4; ++j) gs += __expf(gl[j] - gm);
            const float gp = 1.0f / gs;
            int i1 = 0, i2 = -1; float m1 = -3.0e38f, m2 = -3.0e38f;
            for (int j = 0; j < 8; ++j) { const float v = RLOGIT(4 + 8 * g + j); if (v > m1) { m2 = m1; i2 = i1; m1 = v; i1 = j; } else if (v > m2) { m2 = v; i2 = j; } }
#undef RLOGIT
            const float e2 = __expf(m2 - m1), w1 = gp / (1.0f + e2), w2 = gp * e2 / (1.0f + e2);
            const int a = i1 < i2 ? i1 : i2, b = i1 < i2 ? i2 : i1; const float wlo = i1 < i2 ? w1 : w2, whi = i1 < i2 ? w2 : w1;
            const int lo = g * 8 + a, hh = g * 8 + b, pc = g * 28 + (a * 8 - (a * (a + 1)) / 2) + (b - a - 1);
            tok_e[tok] = lo | (hh << 8) | (pc << 16); tok_w[2 * tok] = wlo; tok_w[2 * tok + 1] = whi;
            if (!dry) {
            const unsigned p0 = __hip_atomic_fetch_add(cnt + 64 * lo, 1u, __ATOMIC_RELAXED, __HIP_MEMORY_SCOPE_AGENT); elist[(size_t)lo * CAP + p0] = tok * 2;
            const unsigned p1 = __hip_atomic_fetch_add(cnt + 64 * hh, 1u, __ATOMIC_RELAXED, __HIP_MEMORY_SCOPE_AGENT); elist[(size_t)hh * CAP + p1] = tok * 2 + 1;
            const unsigned p2 = __hip_atomic_fetch_add(cnt + 64 * (32 + pc), 1u, __ATOMIC_RELAXED, __HIP_MEMORY_SCOPE_AGENT); plist[(size_t)pc * CAP + p2] = tok; }
        }
    }
    __syncthreads();
}

constexpr int LT_PRE = LDSCTL_OFF + 64, LT_CNT = LT_PRE + 116 * 4;
__device__ __forceinline__ void build_class_tables(Frame& F, gu32* cnt, int ncls) {
    LAS int* tpre = (LAS int*)(F.lds + LT_PRE); LAS int* ccnt = (LAS int*)(F.lds + LT_CNT);
    __syncthreads();
    const int tid = opaque(F.tid);
    if (tid < ncls) ccnt[tid] = (int)__hip_atomic_load(cnt + 64 * tid, __ATOMIC_RELAXED, __HIP_MEMORY_SCOPE_AGENT);
    __syncthreads();
    if (tid <= ncls) { int a = 0;
#pragma unroll 8
        for (int c = 0; c < tid; ++c) a += (ccnt[c] + 255) >> 8;
        tpre[tid] = a; }
    __syncthreads();
}
struct Moe1Gemm {
    struct Unit { int pm, pn, e, cnt; };
    static constexpr bool PERM = true, GATHER = true;
    const char* a_base; unsigned lda; const char* b_base; unsigned ldb; int nt; int G, c;
    unsigned char* ws; unsigned char* dout; const LAS int* tpre; const LAS int* ccnt;
    __device__ __forceinline__ bool next(int i, Unit& u) const {
        const int L = i * G + c; if (L >= tpre[NEXP]) return false;
        int e = 0;
#pragma unroll
        for (int st = 16; st >= 1; st >>= 1) { if (tpre[e + st] <= L) e += st; }
        u.e = e; u.pm = L - tpre[e]; u.pn = 0; u.cnt = ccnt[e]; return true;
    }
    __device__ __forceinline__ void a_off(const Unit& u, const int (&R)[2], const int (&C)[2], unsigned (&o)[2][2]) const {
        unsigned char* w_ = ws; unsigned char* d_ = dout; asm volatile("" : "+s"(w_), "+s"(d_));
        const int* elist = (const int*)(w_ + WS_ELIST);
#pragma unroll
        for (int h = 0; h < 2; ++h)
#pragma unroll
            for (int i = 0; i < 2; ++i) { const int r = u.pm * 256 + h * 128 + R[i]; const int ent = (r < u.cnt) ? elist[(size_t)u.e * CAP + r] : 0; o[h][i] = (unsigned)(ent >> 1) * lda + (unsigned)C[i] * 2u; }
    }
    __device__ __forceinline__ const char* a_tile(const Unit&) const { return a_base; }
    __device__ __forceinline__ const char* b_tile(const Unit& u, int kt) const { return b_base + (size_t)u.e * 256 * ldb + (size_t)kt * 128; }
    __device__ __forceinline__ void mid(Acc&, const Unit&, int, int, int, int, int) const {}
    __device__ __forceinline__ void epi(Acc& acc, const Unit& u, int wr, int wc, int fr, int fq) const {
        fr = opaque(fr); fq = opaque(fq);
        unsigned char* w_ = ws; unsigned char* d_ = dout; asm volatile("" : "+s"(w_), "+s"(d_));
        const int* elist = (const int*)(w_ + WS_ELIST); const float* tok_w = (const float*)(w_ + WS_MISC + MISC_TOKW); const float* ss1 = (const float*)(w_ + WS_SS1); bf16_t* H = (bf16_t*)(w_ + WS_H);
        const int r0 = opaque(u.pm * 256 + wr * 64 + fr);
        int ent[2][4], rows[2][4]; float rs[2][4], w[2][4];
#pragma unroll
        for (int ai = 0; ai < 2; ++ai)
#pragma unroll
            for (int m = 0; m < 4; ++m) { const int r = r0 + ai * 128 + m * 16; ent[ai][m] = (r < u.cnt) ? elist[(size_t)u.e * CAP + r] : -1; }
#pragma unroll
        for (int ai = 0; ai < 2; ++ai)
#pragma unroll
            for (int m = 0; m < 4; ++m) { const int e0 = ent[ai][m] < 0 ? 0 : ent[ai][m]; rows[ai][m] = e0 >> 1; w[ai][m] = tok_w[e0]; }
        rstd8(ss1, rows, fq, rs);
#pragma unroll
        for (int ai = 0; ai < 2; ++ai)
#pragma unroll
            for (int m = 0; m < 4; ++m) {
                const float r = rs[ai][m] * INV_S8, ww = w[ai][m]; f32x4 a, b;
#pragma unroll
                for (int j = 0; j < 4; ++j) { a[j] = silu_f(acc[ai][0][m][0][j] * r) * (acc[ai][1][m][0][j] * r) * ww; b[j] = silu_f(acc[ai][0][m][1][j] * r) * (acc[ai][1][m][1][j] * r) * ww; }
                if (ent[ai][m] >= 0) *(u32x4*)(H + (size_t)rows[ai][m] * 256 + (ent[ai][m] & 1) * 128 + wc * 32 + fq * 8) = pack8(a, b);
            }
    }
};
struct Moe2Gemm {
    struct Unit { int pm, pn, lo, hi, cnt, pc; };
    static constexpr bool PERM = true, GATHER = true;
    const char* a_base; unsigned lda; const char* b_base; unsigned ldb; int nt; int G, c;
    unsigned char* ws; unsigned char* dout; int l; const LAS int* tpre; const LAS int* ccnt; float alpha;
    __device__ __forceinline__ bool next(int i, Unit& u) const {
        const int L = i * G + c, T = L >> 2; if (T >= tpre[NPAIR]) return false;
        int pc = 0;
#pragma unroll
        for (int st = 64; st >= 1; st >>= 1) { if (pc + st <= NPAIR && tpre[pc + st] <= T) pc += st; }
        u.pc = pc; u.pm = T - tpre[pc]; u.pn = L & 3; u.cnt = ccnt[pc];
        const int g = pc / 28; int pi = pc - g * 28, a = 0; while (pi >= 7 - a) { pi -= 7 - a; ++a; }
        u.lo = g * 8 + a; u.hi = g * 8 + a + 1 + pi; return true;
    }
    __device__ __forceinline__ void a_off(const Unit& u, const int (&R)[2], const int (&C)[2], unsigned (&o)[2][2]) const {
        unsigned char* w_ = ws; unsigned char* d_ = dout; asm volatile("" : "+s"(w_), "+s"(d_));
        const int* plist = (const int*)(w_ + WS_PLIST);
#pragma unroll
        for (int h = 0; h < 2; ++h)
#pragma unroll
            for (int i = 0; i < 2; ++i) { const int r = u.pm * 256 + h * 128 + R[i]; const int tok = (r < u.cnt) ? plist[(size_t)u.pc * CAP + r] : 0; o[h][i] = (unsigned)tok * lda + (unsigned)C[i] * 2u; }
    }
    __device__ __forceinline__ const char* a_tile(const Unit&) const { return a_base; }
    __device__ __forceinline__ const char* b_tile(const Unit& u, int kt) const { return b_base + (size_t)(kt < 2 ? u.lo : u.hi) * D * ldb + (size_t)u.pn * 256 * ldb + (size_t)(kt & 1) * 128; }
    __device__ __forceinline__ void mid(Acc&, const Unit&, int, int, int, int, int) const {}
    __device__ __forceinline__ void epi(Acc& acc, const Unit& u, int wr, int wc, int fr, int fq) const {
        fr = opaque(fr); fq = opaque(fq);
        unsigned char* w_ = ws; unsigned char* d_ = dout; asm volatile("" : "+s"(w_), "+s"(d_));
        const int* plist = (const int*)(w_ + WS_PLIST); bf16_t* X = (bf16_t*)(w_ + (l == 0 ? WS_XA : WS_XB)); float* ss = (float*)(w_ + WS_SS2); unsigned char* X8p = w_ + WS_X8P;
        const int r0 = opaque(u.pm * 256 + wr * 64 + fr), cl = u.pn * 256 + wc * 32 + fq * 8;
        int tok[2][4];
#pragma unroll
        for (int ai = 0; ai < 2; ++ai)
#pragma unroll
            for (int m = 0; m < 4; ++m) { const int r = r0 + ai * 128 + m * 16; tok[ai][m] = (r < u.cnt) ? plist[(size_t)u.pc * CAP + r] : -1; }
#pragma unroll
        for (int ai = 0; ai < 2; ++ai) {
            u32x4 xv[4][2];
#pragma unroll
            for (int m = 0; m < 4; ++m)
#pragma unroll
                for (int bj = 0; bj < 2; ++bj) xv[m][bj] = *(const u32x4*)(X + (size_t)(tok[ai][m] < 0 ? 0 : tok[ai][m]) * 1024 + bj * 128 + cl);
#pragma unroll
            for (int m = 0; m < 4; ++m) {
                const bool ok = tok[ai][m] >= 0; const size_t t = ok ? tok[ai][m] : 0; float sq = 0.f;
#pragma unroll
                for (int bj = 0; bj < 2; ++bj) { f32x4 pa, pb; unpack8(xv[m][bj], pa, pb);
                    const f32x4 na = pa + acc[ai][bj][m][0] * alpha, nb = pb + acc[ai][bj][m][1] * alpha; const u32x4 w = pack8(na, nb); sq += sqpk(w);
                    if (ok) { *(u32x4*)(X + t * 1024 + bj * 128 + cl) = w; *(u32x2*)(X8p + t * 1024 + bj * 128 + cl) = pack8_fp8(na, nb, SX8); } }
                sq += __shfl_xor(sq, 16); sq += __shfl_xor(sq, 32);
                if (ok && fq == 0) ss[t * 16 + u.pn * 4 + wc] = sq;
            }
            asm volatile("" ::: "memory");
        }
    }
};

namespace att {
typedef float f32x16 __attribute__((ext_vector_type(16)));
typedef short s16x4 __attribute__((ext_vector_type(4)));
constexpr int LK = 0, LV = 24576, LWS = 49152, LOST = 51200, LTB = 83968, LDS_NEED = 84992;
__device__ __forceinline__ int crow(int r, int hi) { return (r & 3) + 8 * (r >> 2) + 4 * hi; }
__device__ __forceinline__ void glds16(const void* gsrc, unsigned lds_dst) { unsigned keep;
    asm volatile("s_mov_b32 %0, m0\n\ts_mov_b32 m0, %2\n\ts_nop 0\n\tglobal_load_lds_dwordx4 %1, off\n\ts_mov_b32 m0, %0" : "=&s"(keep) : "v"(gsrc), "s"(lds_dst) : "memory"); }
__device__ __forceinline__ void attn_unit(int b, int cq, int h, const bf16_t* Q, const bf16_t* K, const bf16_t* V, bf16_t* Y, LAS unsigned char* lds, const float* tbg, float negM) {
    const int tid = opaque(threadIdx.x), lane = tid & 63, r32 = lane & 31, hi = lane >> 5; const int wid = __builtin_amdgcn_readfirstlane(tid >> 6);
    const long rowbase = (long)b * SEQ; const int q0 = cq * 256;
    const bf16_t* Qw = Q + (rowbase + q0 + wid * 32) * 512 + h * 64;
    const bf16_t* Kh = K + rowbase * 512 + h * 64; const bf16_t* Vh = V + rowbase * 512 + h * 64;
    const unsigned lds0 = (unsigned)(uintptr_t)lds;
    LAS float* wsf = (LAS float*)(lds + LWS) + wid * 64; LAS float* tbl = (LAS float*)(lds + LTB);
    if (tid < 256) tbl[tid] = tbg[tid];
    const float negMfar = negM + tbg[255];
    const bf16_t* ksrc = Kh + (long)lane * 512 + wid * 8;
    const bf16_t* vsrc = Vh + (long)(16 * (wid & 3) + (lane >> 2)) * 512 + (wid >> 2) * 32 + (lane & 3) * 8;
    const unsigned kdst = lds0 + LK + wid * 1024, vdst = lds0 + LV + wid * 1024;
    bf16x8 qr[4];
#pragma unroll
    for (int d0 = 0; d0 < 4; ++d0) qr[d0] = *(const bf16x8*)(Qw + (long)r32 * 512 + d0 * 16 + hi * 8);
    f32x16 o0 = {}, o1 = {}; float lsum = 0.f;
    const int ci = wid >> 1, jfirst = (cq >= 2) ? 0 : 8 - 4 * cq;
#define ATT_DMA(j, sl) do { const long ko_ = (long)(4 * cq - 8 + (j)) * 64 * 512; glds16(ksrc + ko_, (unsigned)__builtin_amdgcn_readfirstlane(kdst + (sl) * 8192)); glds16(vsrc + ko_, (unsigned)__builtin_amdgcn_readfirstlane(vdst + (sl) * 8192)); } while (0)
    ATT_DMA(jfirst, 0);
    if (jfirst + 1 < 12) ATT_DMA(jfirst + 1, 1);
    int slot = 0;
    for (int j = jfirst; j < 12; ++j) {
        if (j + 1 < 12) asm volatile("s_waitcnt vmcnt(2) lgkmcnt(0)\n\ts_barrier" ::: "memory"); else asm volatile("s_waitcnt vmcnt(0) lgkmcnt(0)\n\ts_barrier" ::: "memory");
        if (j + 2 < 12) ATT_DMA(j + 2, (slot + 2) % 3);
        if (j >= ci && j <= ci + 8) {
            const int delta = ci + 8 - j;
            const float cv = delta >= 3 ? negMfar : negM;
            f32x16 cin;
#pragma unroll
            for (int r = 0; r < 16; ++r) cin[r] = cv;
            f32x16 p0, p1;
            const LAS unsigned char* kb = lds + LK + slot * 8192 + hi * 1024 + r32 * 16;
#pragma unroll
            for (int d0 = 0; d0 < 4; ++d0) {
                const bf16x8 b0 = *(const LAS bf16x8*)(kb + d0 * 2048), b1 = *(const LAS bf16x8*)(kb + d0 * 2048 + 512);
                if (d0 == 0) { p0 = __builtin_amdgcn_mfma_f32_32x32x16_bf16(b0, qr[0], cin, 0, 0, 0); p1 = __builtin_amdgcn_mfma_f32_32x32x16_bf16(b1, qr[0], cin, 0, 0, 0); }
                else { p0 = __builtin_amdgcn_mfma_f32_32x32x16_bf16(b0, qr[d0], p0, 0, 0, 0); p1 = __builtin_amdgcn_mfma_f32_32x32x16_bf16(b1, qr[d0], p1, 0, 0, 0); }
            }
            if (delta < 3) {
                const LAS float* tb = tbl + (32 * (wid & 1) + r32 + 64 * delta + 63 - 4 * hi);
#pragma unroll
                for (int r = 0; r < 16; ++r) { const int cr = (r & 3) + 8 * (r >> 2); p0[r] += tb[-cr]; p1[r] += tb[-cr - 32]; }
            }
            float sacc = 0.f;
#pragma unroll
            for (int r = 0; r < 16; ++r) { p0[r] = fast_exp2(p0[r]); p1[r] = fast_exp2(p1[r]); sacc += p0[r] + p1[r]; }
            lsum += sacc;
            u32x4 pw0, pw1, pw2, pw3;
            pw0 = (u32x4){cvt_pk_bf16(p0[0], p0[1]), cvt_pk_bf16(p0[2], p0[3]), cvt_pk_bf16(p0[4], p0[5]), cvt_pk_bf16(p0[6], p0[7])};
            pw1 = (u32x4){cvt_pk_bf16(p0[8], p0[9]), cvt_pk_bf16(p0[10], p0[11]), cvt_pk_bf16(p0[12], p0[13]), cvt_pk_bf16(p0[14], p0[15])};
            pw2 = (u32x4){cvt_pk_bf16(p1[0], p1[1]), cvt_pk_bf16(p1[2], p1[3]), cvt_pk_bf16(p1[4], p1[5]), cvt_pk_bf16(p1[6], p1[7])};
            pw3 = (u32x4){cvt_pk_bf16(p1[8], p1[9]), cvt_pk_bf16(p1[10], p1[11]), cvt_pk_bf16(p1[12], p1[13]), cvt_pk_bf16(p1[14], p1[15])};
            const int vb = (int)(lds0 + LV + slot * 8192) + ((lane >> 4) & 1) * 32 + (lane & 3) * 8 + (4 * hi + ((lane & 15) >> 2)) * 64;
#pragma unroll
            for (int d0 = 0; d0 < 2; ++d0) { s16x4 vlo[4], vhi[4];
#pragma unroll
                for (int ks = 0; ks < 4; ++ks) {
                    asm volatile("ds_read_b64_tr_b16 %0,%1 offset:%c2" : "=&v"(vlo[ks]) : "v"(vb), "i"(d0 * 4096 + ks * 1024) : "memory");
                    asm volatile("ds_read_b64_tr_b16 %0,%1 offset:%c2" : "=&v"(vhi[ks]) : "v"(vb), "i"(d0 * 4096 + ks * 1024 + 512) : "memory"); }
                asm volatile("s_waitcnt lgkmcnt(0)" ::: "memory"); __builtin_amdgcn_sched_barrier(0);
#define ATT_PK(k) (bf16x8){vlo[k][0], vlo[k][1], vlo[k][2], vlo[k][3], vhi[k][0], vhi[k][1], vhi[k][2], vhi[k][3]}
                f32x16 oo = d0 == 0 ? o0 : o1;
                oo = __builtin_amdgcn_mfma_f32_32x32x16_bf16(__builtin_bit_cast(bf16x8, pw0), ATT_PK(0), oo, 0, 0, 0);
                oo = __builtin_amdgcn_mfma_f32_32x32x16_bf16(__builtin_bit_cast(bf16x8, pw1), ATT_PK(1), oo, 0, 0, 0);
                oo = __builtin_amdgcn_mfma_f32_32x32x16_bf16(__builtin_bit_cast(bf16x8, pw2), ATT_PK(2), oo, 0, 0, 0);
                oo = __builtin_amdgcn_mfma_f32_32x32x16_bf16(__builtin_bit_cast(bf16x8, pw3), ATT_PK(3), oo, 0, 0, 0);
#undef ATT_PK
                if (d0 == 0) o0 = oo; else o1 = oo;
            }
        }
        slot = (slot + 1) % 3;
    }
#undef ATT_DMA
    { auto rr = __builtin_amdgcn_permlane32_swap(__float_as_uint(lsum), __float_as_uint(lsum), false, false); lsum = __uint_as_float(rr[0]) + __uint_as_float(rr[1]); }
    if (hi == 0) wsf[32 + r32] = lsum;
    asm volatile("s_waitcnt lgkmcnt(0)" ::: "memory");
    bf16_t* Ow = Y + (rowbase + q0 + wid * 32) * 1024 + 512 + h * 64;
    LAS bf16_t* stg = (LAS bf16_t*)(lds + LOST) + wid * 2048;
#pragma unroll
    for (int r = 0; r < 16; ++r) { const int orow = crow(r, hi); const float rl = fast_rcp(wsf[32 + orow]);
        stg[orow * 64 + r32] = f2bf(o0[r] * rl); stg[orow * 64 + 32 + r32] = f2bf(o1[r] * rl); }
    asm volatile("s_waitcnt lgkmcnt(0)" ::: "memory");
#pragma unroll
    for (int i = 0; i < 4; ++i) { const int row = i * 8 + (lane >> 3), ch = lane & 7; const u32x4 v = *(const LAS u32x4*)(stg + row * 64 + ch * 8); *(u32x4*)(Ow + (long)row * 1024 + ch * 8) = v; }
    asm volatile("s_waitcnt lgkmcnt(0)\n\ts_barrier" ::: "memory");
}
__device__ __forceinline__ void attn_phase(Frame& F, int l, bf16_t* Y) {
    const bf16_t* Q = (const bf16_t*)(F.dout + DO_Q); const bf16_t* K = (const bf16_t*)(F.dout + DO_K); const bf16_t* V = (const bf16_t*)(F.ws + WS_V);
    const float* tb = (const float*)(F.ws + WS_MISC + MISC_TB) + (size_t)l * 8 * 256; const float* am = (const float*)(F.ws + WS_MISC + MISC_ATTM) + l * 8;
    for (int u = blockIdx.x; u < 4 * 32 * 8; u += F.G) {
        const int h = u & 7, cq = (u >> 3) & 31, b = u >> 8;
        const float negM = -__hip_atomic_load(am + h, __ATOMIC_RELAXED, __HIP_MEMORY_SCOPE_AGENT);
        attn_unit(b, cq, h, Q, K, V, Y, F.lds, tb + h * 256, negM);
    }
}
}

__device__ __forceinline__ void sgu_unit(Frame& F, int l, int blk, int gp, bf16_t* Y) {
    using namespace att;
    const int tid = opaque(threadIdx.x), lane = tid & 63, r32 = lane & 31, hi = lane >> 5; const int wid = __builtin_amdgcn_readfirstlane(tid >> 6);
    LAS unsigned char* lds = F.lds; const unsigned lds0 = (unsigned)(uintptr_t)lds;
    const bf16_t* Zu = (const bf16_t*)(F.ws + WS_ZU); const bf16_t* Zv = (const bf16_t*)(F.ws + WS_ZV); const float* ssv = (const float*)(F.ws + WS_SSV);
    const bf16_t* Wm = (const bf16_t*)(F.ws + WS_MISC + MISC_WM) + (size_t)l * 4 * 16384;
    const float* gn = F.in[6] + l * 256; const float* b_s = F.in[8] + l * 512;
    const long t0 = (long)blk * 128; const int rb = wid & 3, gi = wid >> 2, g = 2 * gp + gi;
    LAS float* rst = (LAS float*)(lds + 32768); LAS float* stg = (LAS float*)(lds + 34816) + wid * 2048;
#pragma unroll
    for (int sl = 0; sl < 4; ++sl) { const int jt = sl & 1, gg = 2 * gp + (sl >> 1);
        const bf16_t* vsrc = Zv + (t0 + 64 * jt + 16 * (wid & 3) + (lane >> 2)) * 256 + gg * 64 + (wid >> 2) * 32 + (lane & 3) * 8;
        glds16(vsrc, (unsigned)__builtin_amdgcn_readfirstlane(lds0 + sl * 8192 + wid * 1024)); }
    if (tid < 128) { const f32x4 v = *(const f32x4*)(ssv + (t0 + tid) * 4); rst[tid] = rsqrtf(((v[0] + v[1]) + (v[2] + v[3])) * (1.0f / 256.0f) + EPS); }
    asm volatile("s_waitcnt vmcnt(0) lgkmcnt(0)\n\ts_barrier" ::: "memory");
    f32x16 o0 = {}, o1 = {};
    const int njt = rb < 2 ? 1 : 2;
    for (int jt = 0; jt < njt; ++jt) {
        const bf16_t* wrow = Wm + (size_t)g * 16384 + (size_t)(32 * rb + r32) * 128 + 64 * jt + 4 * hi;
        float p0[16], p1[16];
#pragma unroll
        for (int rg = 0; rg < 4; ++rg) {
            const u32x2 w0 = *(const u32x2*)(wrow + 8 * rg), w1 = *(const u32x2*)(wrow + 8 * rg + 32);
            const f32x4 r0 = *(const LAS f32x4*)(rst + 64 * jt + 8 * rg + 4 * hi), r1 = *(const LAS f32x4*)(rst + 64 * jt + 8 * rg + 4 * hi + 32);
            p0[4 * rg] = bflo(w0.x) * r0[0]; p0[4 * rg + 1] = bfhi(w0.x) * r0[1]; p0[4 * rg + 2] = bflo(w0.y) * r0[2]; p0[4 * rg + 3] = bfhi(w0.y) * r0[3];
            p1[4 * rg] = bflo(w1.x) * r1[0]; p1[4 * rg + 1] = bfhi(w1.x) * r1[1]; p1[4 * rg + 2] = bflo(w1.y) * r1[2]; p1[4 * rg + 3] = bfhi(w1.y) * r1[3];
        }
        u32x4 pw0, pw1, pw2, pw3;
        pw0 = (u32x4){cvt_pk_bf16(p0[0], p0[1]), cvt_pk_bf16(p0[2], p0[3]), cvt_pk_bf16(p0[4], p0[5]), cvt_pk_bf16(p0[6], p0[7])};
        pw1 = (u32x4){cvt_pk_bf16(p0[8], p0[9]), cvt_pk_bf16(p0[10], p0[11]), cvt_pk_bf16(p0[12], p0[13]), cvt_pk_bf16(p0[14], p0[15])};
        pw2 = (u32x4){cvt_pk_bf16(p1[0], p1[1]), cvt_pk_bf16(p1[2], p1[3]), cvt_pk_bf16(p1[4], p1[5]), cvt_pk_bf16(p1[6], p1[7])};
        pw3 = (u32x4){cvt_pk_bf16(p1[8], p1[9]), cvt_pk_bf16(p1[10], p1[11]), cvt_pk_bf16(p1[12], p1[13]), cvt_pk_bf16(p1[14], p1[15])};
        const int vb = (int)(lds0 + (gi * 2 + jt) * 8192) + ((lane >> 4) & 1) * 32 + (lane & 3) * 8 + (4 * hi + ((lane & 15) >> 2)) * 64;
#pragma unroll
        for (int d0 = 0; d0 < 2; ++d0) { s16x4 vlo[4], vhi[4];
#pragma unroll
            for (int ks = 0; ks < 4; ++ks) {
                asm volatile("ds_read_b64_tr_b16 %0,%1 offset:%c2" : "=&v"(vlo[ks]) : "v"(vb), "i"(d0 * 4096 + ks * 1024) : "memory");
                asm volatile("ds_read_b64_tr_b16 %0,%1 offset:%c2" : "=&v"(vhi[ks]) : "v"(vb), "i"(d0 * 4096 + ks * 1024 + 512) : "memory"); }
            asm volatile("s_waitcnt lgkmcnt(0)" ::: "memory"); __builtin_amdgcn_sched_barrier(0);
#define SGU_PK(k) (bf16x8){vlo[k][0], vlo[k][1], vlo[k][2], vlo[k][3], vhi[k][0], vhi[k][1], vhi[k][2], vhi[k][3]}
            f32x16 oo = d0 == 0 ? o0 : o1;
            oo = __builtin_amdgcn_mfma_f32_32x32x16_bf16(__builtin_bit_cast(bf16x8, pw0), SGU_PK(0), oo, 0, 0, 0);
            oo = __builtin_amdgcn_mfma_f32_32x32x16_bf16(__builtin_bit_cast(bf16x8, pw1), SGU_PK(1), oo, 0, 0, 0);
            oo = __builtin_amdgcn_mfma_f32_32x32x16_bf16(__builtin_bit_cast(bf16x8, pw2), SGU_PK(2), oo, 0, 0, 0);
            oo = __builtin_amdgcn_mfma_f32_32x32x16_bf16(__builtin_bit_cast(bf16x8, pw3), SGU_PK(3), oo, 0, 0, 0);
#undef SGU_PK
            if (d0 == 0) o0 = oo; else o1 = oo;
        }
    }
    const float g0 = gn[g * 64 + r32], g1 = gn[g * 64 + 32 + r32];
#pragma unroll
    for (int r = 0; r < 16; ++r) { const int orow = crow(r, hi); const float bb = b_s[g * 128 + 32 * rb + orow];
        stg[orow * 64 + r32] = o0[r] * g0 + bb; stg[orow * 64 + 32 + r32] = o1[r] * g1 + bb; }
    asm volatile("s_waitcnt lgkmcnt(0)" ::: "memory");
#pragma unroll
    for (int i = 0; i < 4; ++i) { const int row = i * 8 + (lane >> 3), ch = lane & 7; const long t = t0 + 32 * rb + row;
        const f32x4 m0 = *(const LAS f32x4*)(stg + row * 64 + ch * 8), m1 = *(const LAS f32x4*)(stg + row * 64 + ch * 8 + 4);
        f32x4 ua, ub; unpack8(*(const u32x4*)(Zu + t * 256 + g * 64 + ch * 8), ua, ub);
        *(u32x4*)(Y + t * 1024 + 256 + g * 64 + ch * 8) = pack8(ua * m0, ub * m1); }
    asm volatile("s_waitcnt lgkmcnt(0)\n\ts_barrier" ::: "memory");
}
__device__ __forceinline__ void sgu_pool_phase(Frame& F, int l, bf16_t* Y) {
    for (int u = blockIdx.x; u < 4 * 64 * 2; u += F.G) sgu_unit(F, l, u >> 1, u & 1, Y);
    const bf16_t* Za = (const bf16_t*)(F.ws + WS_ZA);
    for (int it = blockIdx.x * 512 + opaque(F.tid); it < (M / 16) * 32; it += F.G * 512) {
        const int ch = it & 31, t0 = (it >> 5) * 16, w = 2 << (ch >> 3), s0 = t0 & (SEQ - 1);
        const bf16_t* zp = Za + (size_t)t0 * 256 + ch * 8;
        f32x4 sa = {0.f, 0.f, 0.f, 0.f}, sb = sa;
#pragma unroll
        for (int j = 1; j < 16; ++j) { if (j < w && j <= s0) { f32x4 a, b; unpack8(*(const u32x4*)(zp - (size_t)j * 256), a, b); sa += a; sb += b; } }
#pragma unroll
        for (int i = 0; i < 16; ++i) {
            f32x4 a, b; unpack8(*(const u32x4*)(zp + (size_t)i * 256), a, b); sa += a; sb += b;
            const int s = s0 + i; const int cnt = (s + 1 < w) ? s + 1 : w; const float ic = 1.0f / (float)cnt;
            *(u32x4*)(Y + (size_t)(t0 + i) * 1024 + ch * 8) = pack8(sa * ic - a, sb * ic - b);
            if (s + 1 >= w) { f32x4 oa, ob; unpack8(*(const u32x4*)(zp + ((ptrdiff_t)i + 1 - w) * 256), oa, ob); sa -= oa; sb -= ob; }
        }
    }
}

constexpr int NPH = 1 + 8 * DEPTH;
#ifndef PROBE_PHASE
#define PROBE_PHASE 0
#define PROBE_N 1
#endif
#ifndef PHMASK
#define PHMASK 0xFFFF
#endif
#define EN(b) ((PHMASK >> (b)) & 1)
__global__ void __launch_bounds__(512, 2) fwd(Args args) {
    extern __shared__ __attribute__((aligned(16))) unsigned char lds_raw[];
    Frame F;
    F.lds = (LAS unsigned char*)lds_raw; F.ws = args.ws; F.dout = (unsigned char*)args.out; F.ctl = (gu32*)(args.ws + WS_CTL); F.in = (inptr_t)__builtin_amdgcn_kernarg_segment_ptr();
    F.tid = threadIdx.x; F.lane = F.tid & 63; F.wave = __builtin_amdgcn_readfirstlane(F.tid >> 6); F.G = gridDim.x;
    F.gw = blockIdx.x * 8 + F.wave; F.NGW = F.G * 8;
    for (int u = F.tid; u < (LDS_BYTES - LDSCTL_OFF) / 4; u += 512) ((LAS unsigned*)(F.lds + LDSCTL_OFF))[u] = 0u;
    __syncthreads();
    XcdBarrier bar = xcd_barrier_post((unsigned*)(F.ctl + CW_BAR), (volatile LAS unsigned*)(F.lds + LDSCTL_OFF));
#define IN(k) true
#define SEAM(k) xcd_barrier(bar)
    for (int rp_ = 0, nr_ = (PROBE_PHASE == 9 ? args.rep_n : 1); rp_ < nr_; ++rp_) { if (rp_) xcd_barrier(bar);
    if (EN(0) && IN(0)) { prologue(F); prep_layer(F, 0); } }
    SEAM(0);
    unsigned char* const ws0 = F.ws; unsigned char* const do0 = F.dout; const inptr_t in0 = (inptr_t)__builtin_amdgcn_kernarg_segment_ptr();
    for (int l = 0; l < DEPTH; ++l) {
        const int pb = 1 + 8 * l;
#define OPQ() unsigned char* ws = ws0; unsigned char* dout = do0; inptr_t inq = in0; asm volatile("" : "+s"(ws), "+s"(dout), "+s"(inq)); F.ws = ws; F.dout = dout; F.in = inq; \
        bf16_t* Xc = (bf16_t*)(ws + (l == 0 ? WS_XA : WS_XB)); bf16_t* Xo = (bf16_t*)(ws + (l == 0 ? WS_XB : WS_XA)); \
        bf16_t* Y = (l == 0) ? Xo : (bf16_t*)(dout + DO_PY); float* ss1 = (float*)(ws + WS_SS1); \
        (void)Xc; (void)Xo; (void)Y; (void)ss1;
#define SETB(S) do { (S).ws = ws; (S).dout = dout; (S).l = l; } while (0)
        for (int rp_ = 0, nr_ = (PROBE_PHASE == 1 ? args.rep_n : 1); rp_ < nr_; ++rp_) { if (rp_) xcd_barrier(bar);
        if (EN(1) && IN(pb + 0)) { OPQ();
            InGemm S; SETB(S); S.inq = inq; S.a_base = (const char*)Xc; S.lda = 2048; S.b_base = (const char*)(ws + WS_WIN); S.ldb = 2048; S.nt = 16; S.ord.init(M, 2304, F.G, blockIdx.x); S.pn_off = 0; S.gsc = 1.f;
            g8::gemm_phase(F.lds, S);
            S.a_base = (const char*)(ws + WS_X8); S.lda = 1024; S.b_base = (const char*)(ws + WS_WIN8); S.ldb = 1024; S.nt = 8; S.ord.init(M, 3072, F.G, blockIdx.x); S.pn_off = 9; S.gsc = INV_S8;
            g8::gemm_phase<InGemm, false, true>(F.lds, S);
        }
        }
        SEAM(pb + 0);
        for (int rp_ = 0, nr_ = (PROBE_PHASE == 2 ? args.rep_n : 1); rp_ < nr_; ++rp_) { if (rp_) xcd_barrier(bar);
        if (EN(2) && IN(pb + 1)) { OPQ(); att::attn_phase(F, l, Y); sgu_pool_phase(F, l, Y); }
        }
        SEAM(pb + 1);
        for (int rp_ = 0, nr_ = (PROBE_PHASE == 3 ? args.rep_n : 1); rp_ < nr_; ++rp_) { if (rp_) xcd_barrier(bar);
        if (EN(3) && IN(pb + 2)) { OPQ();
            BranchGemm S; SETB(S); S.a_base = (const char*)Y; S.lda = 2048; S.b_base = (const char*)(ws + WS_WBR); S.ldb = 2048; S.nt = 16; S.ord.init(M, D, F.G, blockIdx.x);
            g8::gemm_phase<BranchGemm, true>(F.lds, S);
        }
        }
        SEAM(pb + 2);
        for (int rp_ = 0, nr_ = (PROBE_PHASE == 4 ? args.rep_n : 1); rp_ < nr_; ++rp_) { if (rp_) xcd_barrier(bar);
        if (EN(4) && IN(pb + 3)) { OPQ();
            OutGemm S; SETB(S); S.a_base = (const char*)(ws + WS_MERGED); S.lda = 2048; S.b_base = (const char*)(ws + WS_WOUT); S.ldb = 2048; S.nt = 16; S.ord.init(M, D, F.G, blockIdx.x);
            S.alpha = rp_ ? 0.f : 1.f; g8::gemm_phase(F.lds, S);
        }
        }
        SEAM(pb + 3);
        for (int rp_ = 0, nr_ = (PROBE_PHASE == 5 ? args.rep_n : 1); rp_ < nr_; ++rp_) { if (rp_) xcd_barrier(bar);
        if (EN(5) && IN(pb + 4)) { OPQ(); router_phase(F, l, Xc, ss1, rp_ > 0); }
        }
        SEAM(pb + 4);
        for (int rp_ = 0, nr_ = (PROBE_PHASE == 6 ? args.rep_n : 1); rp_ < nr_; ++rp_) { if (rp_) xcd_barrier(bar);
        if (EN(6) && IN(pb + 5)) { OPQ();
            gu32* cnt = (gu32*)(ws + WS_CTL) + CW_CNT + (size_t)l * 160 * 64;
            build_class_tables(F, cnt, NEXP);
            Moe1Gemm S; S.ws = ws; S.dout = dout; S.a_base = (const char*)(ws + WS_X8); S.lda = 1024; S.b_base = (const char*)(ws + WS_WEIN); S.ldb = 1024; S.nt = 8; S.G = F.G; S.c = blockIdx.x;
            S.tpre = (const LAS int*)(F.lds + LT_PRE); S.ccnt = (const LAS int*)(F.lds + LT_CNT);
            const int tot1 = S.tpre[NEXP];
            g8::gemm_phase<Moe1Gemm, false, true>(F.lds, S);
            StoreGemm P; SETB(P); P.a_base = (const char*)(ws + WS_PB); P.lda = 512; P.b_base = (const char*)(ws + WS_WPLE + (size_t)l * MiB); P.ldb = 512; P.nt = 4;
            { const int extra = (tot1 > F.G && tot1 < 2 * F.G) ? tot1 - F.G : 0; P.nfree = F.G - extra; P.rank = (int)blockIdx.x - extra; P.nunits = (M / 256) * 4; }
            g8::gemm_phase(F.lds, P);
        }
        }
        SEAM(pb + 5);
        for (int rp_ = 0, nr_ = (PROBE_PHASE == 7 ? args.rep_n : 1); rp_ < nr_; ++rp_) { if (rp_) xcd_barrier(bar);
        if (EN(7) && IN(pb + 6)) { OPQ();
            gu32* cnt = (gu32*)(ws + WS_CTL) + CW_CNT + (size_t)l * 160 * 64 + 32 * 64;
            build_class_tables(F, cnt, NPAIR);
            Moe2Gemm S; S.ws = ws; S.dout = dout; S.l = l; S.a_base = (const char*)(ws + WS_H); S.lda = 512; S.b_base = (const char*)(ws + WS_WEOUT); S.ldb = 256; S.nt = 4; S.G = F.G; S.c = blockIdx.x;
            S.alpha = rp_ ? 0.f : 1.f;
            S.tpre = (const LAS int*)(F.lds + LT_PRE); S.ccnt = (const LAS int*)(F.lds + LT_CNT);
            g8::gemm_phase(F.lds, S);
        }
        }
        SEAM(pb + 6);
        for (int rp_ = 0, nr_ = (PROBE_PHASE == 8 ? args.rep_n : 1); rp_ < nr_; ++rp_) { if (rp_) xcd_barrier(bar);
        if (EN(8) && IN(pb + 7)) { OPQ();
            if (l + 1 < DEPTH) { prep_layer(F, l + 1); __syncthreads(); }
            PleGemm S; SETB(S); S.a_base = (const char*)(ws + WS_X8P); S.lda = 1024; S.b_base = (const char*)(ws + WS_WGATE + (size_t)l * 2 * MiB); S.ldb = 1024; S.nt = 8; S.ord.init(M, D, F.G, blockIdx.x);
            S.lastl = (l == DEPTH - 1); S.gsc = INV_S8;
            g8::gemm_phase<PleGemm, false, true>(F.lds, S);
        }
        }
        if (l + 1 < DEPTH) SEAM(pb + 7);
    }
#undef SETB
#undef OPQ
#undef IN
#undef SEAM
}

#ifndef N_LAUNCHES
#define N_LAUNCHES 1
#endif
extern "C" void kernel_launch(void* const* d_in, const int* in_sizes, int n_in, void* d_out, int out_size, void* d_ws, size_t ws_size, hipStream_t stream) {
    static int grid = 0;
    if (grid == 0) {
        if (n_in != 27 || out_size != M * D || ws_size < WS_END) { fprintf(stderr, "kernel_launch: unexpected shapes (n_in %d out %d ws %zu)\n", n_in, out_size, ws_size); grid = -1; return; }
        int dev = 0, cus = 0;
        if (hipGetDevice(&dev) != hipSuccess || hipDeviceGetAttribute(&cus, hipDeviceAttributeMultiprocessorCount, dev) != hipSuccess) { grid = -1; return; }
        if (hipFuncSetAttribute((const void*)fwd, hipFuncAttributeMaxDynamicSharedMemorySize, LDS_BYTES) != hipSuccess) { fprintf(stderr, "kernel_launch: hipFuncSetAttribute failed\n"); grid = -1; return; }
        int per_cu = 0;
        if (hipOccupancyMaxActiveBlocksPerMultiprocessor(&per_cu, (const void*)fwd, 512, LDS_BYTES) != hipSuccess || per_cu < 1) fprintf(stderr, "kernel_launch: occupancy query says %d\n", per_cu);
        (void)hipGetLastError();
        grid = cus;
    }
    if (grid < 0) return;
    (void)hipMemsetAsync((char*)d_ws + WS_CTL, 0, CTL_ZERO_BYTES, stream);
    Args a{};
    for (int i = 0; i < 27; ++i) a.in[i] = (const float*)d_in[i];
    a.out = (float*)d_out; a.ws = (unsigned char*)d_ws; a.rep_n = PROBE_N;
    hipLaunchKernelGGL(fwd, dim3(grid), dim3(512), LDS_BYTES, stream, a);
}
```

```cpp
#include <hip/hip_runtime.h>
#include <cstdio>
#include <cstdint>

#define LAS __attribute__((address_space(3)))
#define GAS __attribute__((address_space(1)))
typedef unsigned short bf16_t;
typedef short bf16x8 __attribute__((ext_vector_type(8)));
typedef float f32x4 __attribute__((ext_vector_type(4)));
typedef float f32x2 __attribute__((ext_vector_type(2)));
typedef unsigned u32x4 __attribute__((ext_vector_type(4)));
typedef unsigned u32x2 __attribute__((ext_vector_type(2)));
typedef GAS unsigned gu32;
typedef const float* const __attribute__((address_space(4)))* inptr_t;

constexpr int M = 32768, D = 1024, SEQ = 8192, NIN = 5376, DEPTH = 2, PLE = 256;
constexpr int NEXP = 32, DEXP = 128, NPAIR = 112, CAP = 32768;
constexpr float EPS = 1e-6f;
constexpr float LOG2E = 1.4426950408889634f;
constexpr float C2 = 0.125f * LOG2E;

constexpr size_t MiB = 1u << 20;
constexpr size_t WS_CTL = 0, CTL_ZERO_BYTES = 1 * MiB;
constexpr size_t WS_MISC = 1 * MiB;
constexpr size_t MISC_ATTM = 0, MISC_GQK = 1024, MISC_TB = 4096, MISC_TOKE = 32768, MISC_TOKW = 196608, MISC_WM = 524288;
constexpr size_t WS_WR = 2 * MiB, WR_BIAS = 896 * 1024;
constexpr size_t WS_SSX = 3 * MiB, WS_SS1 = 5 * MiB, WS_SS2 = 7 * MiB, WS_SSV = 9 * MiB;
constexpr size_t WS_WGATE = 10 * MiB, WS_WPLE = 14 * MiB;
constexpr size_t WS_WIN = 16 * MiB, WS_WBR = 27 * MiB, WS_WOUT = 29 * MiB, WS_WEIN = 31 * MiB, WS_WEOUT = 47 * MiB;
constexpr size_t WS_PB = 58 * MiB;
constexpr size_t WS_XA = 74 * MiB, WS_XB = 138 * MiB;
constexpr size_t WS_ZA = 202 * MiB, WS_ZU = 218 * MiB, WS_ZV = 234 * MiB, WS_V = 250 * MiB, WS_G = 282 * MiB;
constexpr size_t WS_MERGED = 202 * MiB, WS_H = 202 * MiB, WS_ELIST = 218 * MiB, WS_PLIST = 222 * MiB;
constexpr size_t WS_WIN8 = 21 * MiB;
constexpr size_t WS_X8 = 474 * MiB, WS_X8P = 236 * MiB;
constexpr size_t WS_END = 506 * MiB;
constexpr float SX8 = 8.0f, SW8 = 64.0f, INV_S8 = 1.0f / (8.0f * 64.0f);
constexpr size_t DO_PY = 0, DO_Q = 64 * MiB, DO_K = 96 * MiB;
constexpr int CW_TMO = 0, CW_BAR = 4096, CW_CNT = 16384;

constexpr int LDS_BYTES = 152576;
constexpr int LDSCTL_OFF = 152576 - 2048;

__device__ __forceinline__ float bflo(unsigned w) { return __uint_as_float(w << 16); }
__device__ __forceinline__ float bfhi(unsigned w) { return __uint_as_float(w & 0xffff0000u); }
__device__ __forceinline__ float bf2f(bf16_t h) { return __uint_as_float((unsigned)h << 16); }
typedef __bf16 bf16x2_t __attribute__((ext_vector_type(2)));
__device__ __forceinline__ unsigned cvt_pk_bf16(float lo, float hi) { const f32x2 v = {lo, hi}; const bf16x2_t b = __builtin_convertvector(v, bf16x2_t); return __builtin_bit_cast(unsigned, b); }
__device__ __forceinline__ bf16_t f2bf(float f) { return (bf16_t)(cvt_pk_bf16(f, 0.f) & 0xffffu); }
__device__ __forceinline__ u32x2 pack8_fp8(f32x4 a, f32x4 b, float sc) {
    int lo = __builtin_amdgcn_cvt_pk_fp8_f32(a[0] * sc, a[1] * sc, 0, false); lo = __builtin_amdgcn_cvt_pk_fp8_f32(a[2] * sc, a[3] * sc, lo, true);
    int hi = __builtin_amdgcn_cvt_pk_fp8_f32(b[0] * sc, b[1] * sc, 0, false); hi = __builtin_amdgcn_cvt_pk_fp8_f32(b[2] * sc, b[3] * sc, hi, true);
    return (u32x2){(unsigned)lo, (unsigned)hi}; }
__device__ __forceinline__ float fast_rcp(float x) { return __builtin_amdgcn_rcpf(x); }
__device__ __forceinline__ float fast_exp2(float x) { return __builtin_amdgcn_exp2f(x); }
__device__ __forceinline__ float gelu_t(float x) { const float u = x + 0.044715f * x * x * x; return x * fast_rcp(1.f + fast_exp2(-2.302208198f * u)); }
__device__ __forceinline__ float sigmoid_f(float x) { return fast_rcp(1.f + fast_exp2(-LOG2E * x)); }
__device__ __forceinline__ float silu_f(float x) { return x * sigmoid_f(x); }
__device__ __forceinline__ int opaque(int v) { asm volatile("" : "+v"(v)); return v; }
__device__ __forceinline__ float wave_sum(float v) {
#pragma unroll
    for (int o = 1; o < 64; o <<= 1) v += __shfl_xor(v, o);
    return v;
}
__device__ __forceinline__ u32x4 pack8(f32x4 a, f32x4 b) { u32x4 w; w.x = cvt_pk_bf16(a[0], a[1]); w.y = cvt_pk_bf16(a[2], a[3]); w.z = cvt_pk_bf16(b[0], b[1]); w.w = cvt_pk_bf16(b[2], b[3]); return w; }
__device__ __forceinline__ void unpack8(u32x4 w, f32x4& a, f32x4& b) { a = (f32x4){bflo(w.x), bfhi(w.x), bflo(w.y), bfhi(w.y)}; b = (f32x4){bflo(w.z), bfhi(w.z), bflo(w.w), bfhi(w.w)}; }
__device__ __forceinline__ float sq4(f32x4 a) { return (a[0] * a[0] + a[1] * a[1]) + (a[2] * a[2] + a[3] * a[3]); }
__device__ __forceinline__ float sqpk(u32x4 w) { f32x4 a, b; unpack8(w, a, b); return sq4(a) + sq4(b); }

namespace g8 {
constexpr int BM = 256, BK = 64, HALF = 128, HTB = HALF * BK * 2, STAGE_BYTES = 8 * HTB, NXCD = 8, WGM = 8;
__host__ __device__ __forceinline__ int lds_byte(int r, int c) { const int st = (r >> 4) * 2 + (c >> 5), rr = r & 15, cc = c & 31, ob = rr * 64 + cc * 2; return st * 1024 + (ob ^ (((ob >> 9) & 1) << 5)); }
__host__ __device__ __forceinline__ void stage_rc(int b, int& R, int& C) { const int st = b / 1024, sb = b % 1024, swz = sb ^ (((sb >> 9) & 1) << 5); R = (st >> 1) * 16 + swz / 64; C = (st & 1) * 32 + (swz % 64) / 2; }
__host__ __device__ __forceinline__ int perm32(int rho) { const int n = rho >> 4, i = rho & 15; return 8 * (i >> 2) + 4 * n + (i & 3); }

struct Unit { int pm, pn; };
struct StaticOrder {
    int nM, nN, nwg, G, c;
    __device__ void init(int Mr, int N, int G_, int c_) { nM = Mr / BM; nN = N / BM; nwg = nM * nN; G = G_; c = c_; }
    __device__ bool next(int i, Unit& u) const { return map((long)i * G + c, u); }
    __device__ bool map(long L, Unit& u) const {
        if (L >= nwg) return false;
        int wgid = (int)L; { const int q = nwg / NXCD, r = nwg % NXCD, xcd = wgid % NXCD, off = wgid / NXCD; wgid = (xcd < r ? xcd * (q + 1) : r * (q + 1) + (xcd - r) * q) + off; }
        const int nig = WGM * nN, gid = wgid / nig, fm = gid * WGM, gsz = (nM - fm) < WGM ? (nM - fm) : WGM;
        u.pm = fm + ((wgid % nig) % gsz); u.pn = (wgid % nig) / gsz; return true;
    }
};
struct DenseBase {
    typedef g8::Unit Unit;
    const char* a_base; unsigned lda; const char* b_base; unsigned ldb; int nt; StaticOrder ord;
    unsigned char* ws; unsigned char* dout; inptr_t inq; int l;
    __device__ __forceinline__ bool next(int i, Unit& u) const { return ord.next(i, u); }
    static constexpr bool GATHER = false;
    __device__ __forceinline__ void a_off(const Unit&, const int (&)[2], const int (&)[2], unsigned (&)[2][2]) const {}
    __device__ __forceinline__ const char* a_tile(const Unit& u) const { return a_base + (size_t)u.pm * BM * lda; }
    __device__ __forceinline__ const char* b_tile(const Unit& u, int kt) const { return b_base + (size_t)u.pn * BM * ldb + (size_t)kt * (BK * 2); }
    __device__ __forceinline__ void mid(f32x4 (&)[2][2][4][2], const Unit&, int, int, int, int, int) const {}
};

template <class P, bool HOOK = false, bool FP8 = false>
__device__ __forceinline__ void gemm_phase(LAS unsigned char* lds, const P& S) {
    typedef int v8i __attribute__((ext_vector_type(8))); typedef int v4i __attribute__((ext_vector_type(4)));
    typedef typename P::Unit Unit;
    const int tid = opaque(threadIdx.x), wid = __builtin_amdgcn_readfirstlane(tid >> 6), lane = tid & 63, wr = wid >> 2, wc = wid & 3, fr = lane & 15, fq = lane >> 4;
    const int nt = S.nt;
    int R[2], C[2]; unsigned voffB[2];
#pragma unroll
    for (int i = 0; i < 2; ++i) { stage_rc(tid * 16 + i * 8192, R[i], C[i]); const int Rb = P::PERM ? ((R[i] & ~31) + perm32(R[i] & 31)) : R[i]; voffB[i] = (unsigned)Rb * S.ldb + (unsigned)C[i] * 2u; }
    const size_t hstepB = (size_t)HALF * S.ldb;
    unsigned voffA[2] = {0u, 0u}; size_t hstepA = 0;
    if constexpr (!P::GATHER) { hstepA = (size_t)HALF * S.lda;
#pragma unroll
        for (int i = 0; i < 2; ++i) voffA[i] = (unsigned)R[i] * S.lda + (unsigned)C[i] * 2u; }
    const unsigned ldsw = (unsigned)wid * 1024u;
    const int aoff = lds_byte(wr * 64 + fr, fq * 8), boff = lds_byte(wc * 32 + fr, fq * 8);
    const char* const Ab = S.a_base;
#define G8_SA(b, h) (((b) * 2 + (h)) * HTB)
#define G8_SB(b, h) ((4 + (b) * 2 + (h)) * HTB)
#define G8_STAGE_A(bufoff, sel, h, kt) do { if constexpr (P::GATHER) { _Pragma("unroll") for (int _i = 0; _i < 2; ++_i) \
        __builtin_amdgcn_global_load_lds((const unsigned*)(Ab + (size_t)((sel) ? no[h][_i] : co[h][_i]) + (size_t)(kt) * (BK * 2)), (LAS unsigned*)(lds + (bufoff) + ldsw + _i * 8192), 16, 0, 0); } \
      else { const char* _g = ((sel) ? nA : cA) + (size_t)(h) * hstepA + (size_t)(kt) * (BK * 2); _Pragma("unroll") for (int _i = 0; _i < 2; ++_i) \
        __builtin_amdgcn_global_load_lds((const unsigned*)(_g + voffA[_i]), (LAS unsigned*)(lds + (bufoff) + ldsw + _i * 8192), 16, 0, 0); } } while (0)
#define G8_STAGE_B(bufoff, gbase) do { _Pragma("unroll") for (int _i = 0; _i < 2; ++_i) \
        __builtin_amdgcn_global_load_lds((const unsigned*)((const char*)(gbase) + voffB[_i]), (LAS unsigned*)(lds + (bufoff) + ldsw + _i * 8192), 16, 0, 0); } while (0)
#define G8_LDA(dst, b, h) do { if constexpr (FP8) { _Pragma("unroll") for (int m = 0; m < 4; ++m) { dst##8[m].lo = *(const LAS v4i*)(lds + G8_SA(b, h) + aoff + m * 2048); dst##8[m].hi = *(const LAS v4i*)(lds + G8_SA(b, h) + aoff + m * 2048 + 1024); } } \
      else { _Pragma("unroll") for (int m = 0; m < 4; ++m) _Pragma("unroll") for (int k = 0; k < 2; ++k) dst[m][k] = *(const LAS bf16x8*)(lds + G8_SA(b, h) + aoff + m * 2048 + k * 1024); } } while (0)
#define G8_LDB(dst, b, h) do { if constexpr (FP8) { _Pragma("unroll") for (int n = 0; n < 2; ++n) { dst##8[n].lo = *(const LAS v4i*)(lds + G8_SB(b, h) + boff + n * 2048); dst##8[n].hi = *(const LAS v4i*)(lds + G8_SB(b, h) + boff + n * 2048 + 1024); } } \
      else { _Pragma("unroll") for (int n = 0; n < 2; ++n) _Pragma("unroll") for (int k = 0; k < 2; ++k) dst[n][k] = *(const LAS bf16x8*)(lds + G8_SB(b, h) + boff + n * 2048 + k * 1024); } } while (0)
#define G8_MMA(ai, bj, At, Bt) do { __builtin_amdgcn_s_setprio(1); if constexpr (FP8) { _Pragma("unroll") for (int m = 0; m < 4; ++m) _Pragma("unroll") for (int n = 0; n < 2; ++n) \
        asm volatile("v_mfma_f32_16x16x128_f8f6f4 %0, %1, %2, %0" : "+v"(acc[ai][bj][m][n]) : "v"(Bt##8[n]), "v"(At##8[m])); } \
      else { _Pragma("unroll") for (int m = 0; m < 4; ++m) _Pragma("unroll") for (int n = 0; n < 2; ++n) _Pragma("unroll") for (int k = 0; k < 2; ++k) \
        acc[ai][bj][m][n] = __builtin_amdgcn_mfma_f32_16x16x32_bf16(Bt[n][k], At[m][k], acc[ai][bj][m][n], 0, 0, 0); } __builtin_amdgcn_s_setprio(0); } while (0)
#define G8_WAIT_V(n) asm volatile("s_waitcnt vmcnt(" #n ")" ::: "memory")
#define G8_WAIT_L(n) asm volatile("s_waitcnt lgkmcnt(" #n ")" ::: "memory")
#define G8_BAR __builtin_amdgcn_s_barrier()
#define G8_SCHED __builtin_amdgcn_sched_barrier(0)
    Unit cur, nxt; int ui = 0;
    if (!S.next(0, cur)) return;
    unsigned co[2][2], no[2][2];
    S.a_off(cur, R, C, co);
    const char* cA = nullptr; const char* nA = nullptr;
    if constexpr (!P::GATHER) { cA = S.a_tile(cur); nA = cA; }
    f32x4 acc[2][2][4][2];
#pragma unroll
    for (int a = 0; a < 2; ++a)
#pragma unroll
        for (int b = 0; b < 2; ++b)
#pragma unroll
            for (int m = 0; m < 4; ++m)
#pragma unroll
                for (int n = 0; n < 2; ++n) acc[a][b][m][n] = (f32x4){0.f, 0.f, 0.f, 0.f};
    bf16x8 At[4][2], B0[2][2], B1[2][2]; v8i At8[4], B08[2], B18[2];
    {
        const char* b0 = S.b_tile(cur, 0); const char* b1 = S.b_tile(cur, 1);
        G8_STAGE_B(G8_SB(0, 0), b0); G8_STAGE_B(G8_SB(0, 1), b0 + hstepB); G8_STAGE_A(G8_SA(0, 0), false, 0, 0); G8_STAGE_A(G8_SA(0, 1), false, 1, 0);
        if (wr == 1) G8_BAR;
        G8_WAIT_V(2); G8_BAR;
        G8_STAGE_B(G8_SB(1, 0), b1); G8_STAGE_A(G8_SA(1, 0), false, 0, 1); G8_STAGE_B(G8_SB(1, 1), b1 + hstepB);
        G8_WAIT_V(6); G8_BAR;
    }
    for (;;) {
        const bool has_next = S.next(ui + 1, nxt);
        if (!has_next) nxt = cur;
        S.a_off(nxt, R, C, no);
        if constexpr (!P::GATHER) nA = S.a_tile(nxt);
        for (int t = 0; t < nt; t += 2) {
            const bool last = (t == nt - 2);
            const int k2 = last ? 0 : t + 2, k3 = k2 + 1;
            const char* b2 = last ? S.b_tile(nxt, 0) : S.b_tile(cur, t + 2);
            const char* b3 = last ? S.b_tile(nxt, 1) : S.b_tile(cur, t + 3);
            G8_LDB(B0, 0, 0); G8_LDB(B1, 0, 1); G8_SCHED; G8_LDA(At, 0, 0); G8_STAGE_A(G8_SA(1, 1), false, 1, t + 1);
            G8_WAIT_V(8); G8_WAIT_L(0); G8_BAR; G8_MMA(0, 0, At, B0); G8_MMA(0, 1, At, B1); G8_BAR; G8_SCHED;
            G8_LDA(At, 0, 1); G8_STAGE_B(G8_SB(0, 0), b2); G8_STAGE_B(G8_SB(0, 1), b2 + hstepB); G8_STAGE_A(G8_SA(0, 0), last, 0, k2);
            G8_WAIT_V(8); G8_WAIT_L(0); G8_BAR; G8_MMA(1, 0, At, B0); G8_MMA(1, 1, At, B1); G8_BAR; G8_SCHED;
            G8_LDB(B0, 1, 0); G8_LDB(B1, 1, 1); G8_SCHED; G8_LDA(At, 1, 0); G8_STAGE_A(G8_SA(0, 1), last, 1, k2);
            G8_WAIT_V(8); G8_WAIT_L(0); G8_BAR; G8_MMA(0, 0, At, B0); G8_MMA(0, 1, At, B1); G8_BAR; G8_SCHED;
            G8_LDA(At, 1, 1); G8_STAGE_B(G8_SB(1, 0), b3); G8_STAGE_B(G8_SB(1, 1), b3 + hstepB); G8_STAGE_A(G8_SA(1, 0), last, 0, k3);
            G8_WAIT_V(8); G8_WAIT_L(0); G8_BAR; G8_MMA(1, 0, At, B0); G8_MMA(1, 1, At, B1); G8_BAR; G8_SCHED;
            if constexpr (HOOK) { if (!last) S.mid(acc, cur, t + 2, wr, wc, fr, fq); }
        }
        if constexpr (FP8) asm volatile("s_nop 15\n\ts_nop 15" ::: "memory");
        if (wr == 0) G8_BAR;
        S.epi(acc, cur, wr, wc, fr, fq);
        if (!has_next) break;
#pragma unroll
        for (int a = 0; a < 2; ++a)
#pragma unroll
            for (int b = 0; b < 2; ++b)
#pragma unroll
                for (int m = 0; m < 4; ++m)
#pragma unroll
                    for (int n = 0; n < 2; ++n) acc[a][b][m][n] = (f32x4){0.f, 0.f, 0.f, 0.f};
        cur = nxt; cA = nA;
#pragma unroll
        for (int h = 0; h < 2; ++h)
#pragma unroll
            for (int i = 0; i < 2; ++i) co[h][i] = no[h][i];
        ++ui;
        if (wr == 1) G8_BAR;
    }
    G8_WAIT_V(0);
    G8_BAR;
#undef G8_SA
#undef G8_SB
#undef G8_STAGE_A
#undef G8_STAGE_B
#undef G8_LDA
#undef G8_LDB
#undef G8_MMA
#undef G8_WAIT_V
#undef G8_WAIT_L
#undef G8_BAR
#undef G8_SCHED
}
}

__device__ __forceinline__ float rstd_from(const float* ss, int row, int fq) {
    const f32x4 v = *(const f32x4*)(ss + (size_t)row * 16 + fq * 4);
    float s = (v[0] + v[1]) + (v[2] + v[3]); s += __shfl_xor(s, 16); s += __shfl_xor(s, 32);
    return rsqrtf(s * (1.0f / D) + EPS);
}
__device__ __forceinline__ void rstd8(const float* ss, const int (&rows)[2][4], int fq, float (&rs)[2][4]) {
    f32x4 v[2][4];
#pragma unroll
    for (int ai = 0; ai < 2; ++ai)
#pragma unroll
        for (int m = 0; m < 4; ++m) v[ai][m] = *(const f32x4*)(ss + (size_t)rows[ai][m] * 16 + fq * 4);
#pragma unroll
    for (int ai = 0; ai < 2; ++ai)
#pragma unroll
        for (int m = 0; m < 4; ++m) { float s = (v[ai][m][0] + v[ai][m][1]) + (v[ai][m][2] + v[ai][m][3]); s += __shfl_xor(s, 16); s += __shfl_xor(s, 32); rs[ai][m] = rsqrtf(s * (1.0f / D) + EPS); }
}
__device__ __forceinline__ void rows8(int row0, int (&rows)[2][4]) {
#pragma unroll
    for (int ai = 0; ai < 2; ++ai)
#pragma unroll
        for (int m = 0; m < 4; ++m) rows[ai][m] = row0 + ai * 128 + m * 16;
}
__device__ __forceinline__ size_t gate_off(int pm, int k, int pn, int wid, int lane) { return ((((size_t)pm * 3 + k) * 4 + pn) * 8 + wid) * 8192 + (size_t)lane * 8; }
#define GATE_EL(ai, m, bj) ((((ai) * 4 + (m)) * 2 + (bj)) * 512)
__device__ __forceinline__ u32x2 pack8_u8(f32x4 a, f32x4 b) {
    unsigned lo = 0, hi = 0;
#pragma unroll
    for (int j = 0; j < 4; ++j) { lo = __builtin_amdgcn_cvt_pk_u8_f32(fmaxf(__builtin_rintf(a[j] * 255.0f), 1.0f), j, lo); hi = __builtin_amdgcn_cvt_pk_u8_f32(fmaxf(__builtin_rintf(b[j] * 255.0f), 1.0f), j, hi); }
    return (u32x2){lo, hi}; }
__device__ __forceinline__ void unpack8_u8(u32x2 w, f32x4& a, f32x4& b) {
    a = (f32x4){(float)(w.x & 255u), (float)((w.x >> 8) & 255u), (float)((w.x >> 16) & 255u), (float)(w.x >> 24)};
    b = (f32x4){(float)(w.y & 255u), (float)((w.y >> 8) & 255u), (float)((w.y >> 16) & 255u), (float)(w.y >> 24)}; }

typedef f32x4 Acc[2][2][4][2];
struct InGemm : g8::DenseBase {
    static constexpr bool PERM = true;
    int pn_off; float gsc;
    __device__ __forceinline__ bool next(int i, Unit& u) const {
        if (pn_off == 0 || ord.G != 256) return ord.next(i, u);
        if (i < 8) return ord.map((long)i * 256 + ord.c, u);
        if (ord.c >= 128 && i < 10) return ord.map(2048 + (long)(ord.c - 128) * 2 + (i - 8), u);
        return false;
    }
    __device__ __forceinline__ void epi(Acc& acc, const Unit& u, int wr, int wc, int fr, int fq) const {
        fr = opaque(fr); fq = opaque(fq);
        unsigned char* w_ = ws; unsigned char* d_ = dout; asm volatile("" : "+s"(w_), "+s"(d_));
        bf16_t* Z3 = (bf16_t*)(w_ + WS_ZA); bf16_t* QK = (bf16_t*)(d_ + DO_Q); bf16_t* V = (bf16_t*)(w_ + WS_V); bf16_t* G = (bf16_t*)(w_ + WS_G);
        float* ssv = (float*)(w_ + WS_SSV); const float* ssx = (const float*)(w_ + WS_SSX); const float* gqk = (const float*)(w_ + WS_MISC + MISC_GQK) + l * 128;
        inptr_t in_ = inq; asm volatile("" : "+s"(in_)); const float* gate_b = in_[12] + (size_t)l * 3072;
        const int row0 = opaque(u.pm * 256 + wr * 64 + fr), pn = u.pn + pn_off, cl = wc * 32 + fq * 8;
        int rows[2][4]; rows8(row0, rows); float rs[2][4]; rstd8(ssx, rows, fq, rs);
        if (pn_off) {
#pragma unroll
            for (int ai = 0; ai < 2; ++ai)
#pragma unroll
                for (int m = 0; m < 4; ++m) rs[ai][m] *= gsc;
        }
        if (pn <= 2) {
            bf16_t* O = Z3 + (size_t)pn * ((size_t)M * 256);
#pragma unroll
            for (int ai = 0; ai < 2; ++ai)
#pragma unroll
                for (int m = 0; m < 4; ++m) {
                    const int row = rows[ai][m]; const float r = rs[ai][m]; float sq = 0.f;
#pragma unroll
                    for (int bj = 0; bj < 2; ++bj) {
                        f32x4 a = acc[ai][bj][m][0] * r, b = acc[ai][bj][m][1] * r;
                        if (pn >= 1) {
#pragma unroll
                            for (int j = 0; j < 4; ++j) { a[j] = gelu_t(a[j]); b[j] = gelu_t(b[j]); }
                        }
                        const u32x4 w = pack8(a, b); sq += sqpk(w);
                        *(u32x4*)(O + (size_t)row * 256 + bj * 128 + cl) = w;
                    }
                    if (pn == 2) { sq += __shfl_xor(sq, 16); sq += __shfl_xor(sq, 32); if (fq == 0) ssv[(size_t)row * 4 + wc] = sq; }
                }
        } else if (pn <= 6) {
            const bool isq = pn <= 4; const float* gg = gqk + (isq ? 0 : 64); bf16_t* O = QK + (isq ? (size_t)0 : (size_t)M * 512);
            const int head = 4 * ((pn - 3) & 1) + wc;
            f32x4 gv[2][2];
#pragma unroll
            for (int bj = 0; bj < 2; ++bj)
#pragma unroll
                for (int n = 0; n < 2; ++n) gv[bj][n] = *(const f32x4*)(gg + bj * 32 + fq * 8 + n * 4);
#pragma unroll
            for (int ai = 0; ai < 2; ++ai)
#pragma unroll
                for (int m = 0; m < 4; ++m) {
                    const int row = rows[ai][m]; const float r = rs[ai][m];
                    f32x4 v[2][2]; float sq = 0.f;
#pragma unroll
                    for (int bj = 0; bj < 2; ++bj)
#pragma unroll
                        for (int n = 0; n < 2; ++n) { v[bj][n] = acc[ai][bj][m][n] * r; sq += sq4(v[bj][n]); }
                    sq += __shfl_xor(sq, 16); sq += __shfl_xor(sq, 32);
                    const float ri = rsqrtf(sq * (1.0f / 64.0f) + EPS) * (isq ? C2 : 1.0f);
#pragma unroll
                    for (int bj = 0; bj < 2; ++bj)
                        *(u32x4*)(O + (size_t)row * 512 + head * 64 + bj * 32 + fq * 8) = pack8(v[bj][0] * ri * gv[bj][0], v[bj][1] * ri * gv[bj][1]);
                }
        } else if (pn <= 8) {
#pragma unroll
            for (int ai = 0; ai < 2; ++ai)
#pragma unroll
                for (int m = 0; m < 4; ++m) {
                    const int row = rows[ai][m]; const float r = rs[ai][m];
#pragma unroll
                    for (int bj = 0; bj < 2; ++bj)
                        *(u32x4*)(V + (size_t)row * 512 + (pn - 7) * 256 + bj * 128 + cl) = pack8(acc[ai][bj][m][0] * r, acc[ai][bj][m][1] * r);
                }
        } else {
            const int gc = (pn - 9) * 256, k = (pn - 9) >> 2, pnn = (pn - 9) & 3;
            unsigned char* gp = (unsigned char*)G + gate_off(u.pm, k, pnn, wr * 4 + wc, fq * 16 + fr);
            f32x4 gb[2][2];
#pragma unroll
            for (int bj = 0; bj < 2; ++bj)
#pragma unroll
                for (int n = 0; n < 2; ++n) gb[bj][n] = *(const f32x4*)(gate_b + gc + bj * 128 + cl + n * 4);
#pragma unroll
            for (int ai = 0; ai < 2; ++ai)
#pragma unroll
                for (int m = 0; m < 4; ++m) {
                    const float r = rs[ai][m];
#pragma unroll
                    for (int bj = 0; bj < 2; ++bj) {
                        f32x4 a = acc[ai][bj][m][0] * r + gb[bj][0], b = acc[ai][bj][m][1] * r + gb[bj][1];
#pragma unroll
                        for (int j = 0; j < 4; ++j) { a[j] = sigmoid_f(a[j]); b[j] = sigmoid_f(b[j]); }
                        *(u32x2*)(gp + GATE_EL(ai, m, bj)) = pack8_u8(a, b);
                    }
                }
        }
    }
};
struct StoreGemm : g8::DenseBase {
    static constexpr bool PERM = true;
    int nfree, rank, nunits;
    __device__ __forceinline__ bool next(int i, Unit& u) const { if (rank < 0) return false; const int p = i * nfree + rank; if (p >= nunits) return false; u.pm = p >> 2; u.pn = p & 3; return true; }
    __device__ __forceinline__ void epi(Acc& acc, const Unit& u, int wr, int wc, int fr, int fq) const {
        fr = opaque(fr); fq = opaque(fq);
        unsigned char* w_ = ws; unsigned char* d_ = dout; asm volatile("" : "+s"(w_), "+s"(d_));
        bf16_t* O = (l == 0) ? (bf16_t*)(d_ + DO_PY) : (bf16_t*)(w_ + WS_XA); const int ldo = 1024;
        const int row0 = opaque(u.pm * 256 + wr * 64 + fr), cl = u.pn * 256 + wc * 32 + fq * 8;
#pragma unroll
        for (int ai = 0; ai < 2; ++ai)
#pragma unroll
            for (int m = 0; m < 4; ++m) {
                const int row = row0 + ai * 128 + m * 16;
#pragma unroll
                for (int bj = 0; bj < 2; ++bj) *(u32x4*)(O + (size_t)row * ldo + bj * 128 + cl) = pack8(acc[ai][bj][m][0], acc[ai][bj][m][1]);
            }
    }
};
struct BranchGemm : g8::DenseBase {
    static constexpr bool PERM = true;
    __device__ __forceinline__ void mid(Acc& acc, const Unit& u, int kdone, int wr, int wc, int fr, int fq) const {
        if (kdone != 4 && kdone != 8) return;
        fr = opaque(fr); fq = opaque(fq);
        const int k0 = (kdone == 4) ? 0 : 1;
        unsigned char* w_ = ws; unsigned char* d_ = dout; asm volatile("" : "+s"(w_), "+s"(d_));
        const bf16_t* G = (const bf16_t*)(w_ + WS_G);
        const int lane = opaque(fq * 16 + fr);
        const unsigned char* gn = (const unsigned char*)G + gate_off(u.pm, k0, u.pn, wr * 4 + wc, lane); const unsigned char* gd = (const unsigned char*)G + gate_off(u.pm, k0 + 1, u.pn, wr * 4 + wc, lane);
#pragma unroll
        for (int ai = 0; ai < 2; ++ai) {
            u32x2 nv[4][2], dv[4][2];
#pragma unroll
            for (int m = 0; m < 4; ++m)
#pragma unroll
                for (int bj = 0; bj < 2; ++bj) { nv[m][bj] = *(const u32x2*)(gn + GATE_EL(ai, m, bj)); dv[m][bj] = *(const u32x2*)(gd + GATE_EL(ai, m, bj)); }
#pragma unroll
            for (int m = 0; m < 4; ++m)
#pragma unroll
                for (int bj = 0; bj < 2; ++bj) { f32x4 na, nb, da, db; unpack8_u8(nv[m][bj], na, nb); unpack8_u8(dv[m][bj], da, db);
#pragma unroll
                    for (int j = 0; j < 4; ++j) { acc[ai][bj][m][0][j] *= na[j] * fast_rcp(da[j]); acc[ai][bj][m][1][j] *= nb[j] * fast_rcp(db[j]); } }
            asm volatile("" ::: "memory");
        }
    }
    __device__ __forceinline__ void epi(Acc& acc, const Unit& u, int wr, int wc, int fr, int fq) const {
        fr = opaque(fr); fq = opaque(fq);
        unsigned char* w_ = ws; unsigned char* d_ = dout; asm volatile("" : "+s"(w_), "+s"(d_));
        const bf16_t* G = (const bf16_t*)(w_ + WS_G); bf16_t* Mg = (bf16_t*)(w_ + WS_MERGED);
        const int row0 = opaque(u.pm * 256 + wr * 64 + fr), cl = u.pn * 256 + wc * 32 + fq * 8;
        const unsigned char* gc = (const unsigned char*)G + gate_off(u.pm, 2, u.pn, wr * 4 + wc, fq * 16 + fr);
        u32x2 gv[2][4][2];
#pragma unroll
        for (int ai = 0; ai < 2; ++ai)
#pragma unroll
            for (int m = 0; m < 4; ++m)
#pragma unroll
                for (int bj = 0; bj < 2; ++bj) gv[ai][m][bj] = *(const u32x2*)(gc + GATE_EL(ai, m, bj));
#pragma unroll
        for (int ai = 0; ai < 2; ++ai)
#pragma unroll
            for (int m = 0; m < 4; ++m) {
                const int row = row0 + ai * 128 + m * 16;
#pragma unroll
                for (int bj = 0; bj < 2; ++bj) { f32x4 ga, gb; unpack8_u8(gv[ai][m][bj], ga, gb);
                    *(u32x4*)(Mg + (size_t)row * 1024 + bj * 128 + cl) = pack8(acc[ai][bj][m][0] * (ga * (1.0f / 255.0f)), acc[ai][bj][m][1] * (gb * (1.0f / 255.0f))); }
            }
    }
};
struct OutGemm : g8::DenseBase {
    static constexpr bool PERM = true;
    float alpha;
    __device__ __forceinline__ void epi(Acc& acc, const Unit& u, int wr, int wc, int fr, int fq) const {
        fr = opaque(fr); fq = opaque(fq);
        unsigned char* w_ = ws; unsigned char* d_ = dout; asm volatile("" : "+s"(w_), "+s"(d_));
        bf16_t* X = (bf16_t*)(w_ + (l == 0 ? WS_XA : WS_XB)); float* ss = (float*)(w_ + WS_SS1);
        const int row0 = opaque(u.pm * 256 + wr * 64 + fr), cl = u.pn * 256 + wc * 32 + fq * 8;
#pragma unroll
        for (int ai = 0; ai < 2; ++ai) {
            u32x4 xv[4][2];
#pragma unroll
            for (int m = 0; m < 4; ++m)
#pragma unroll
                for (int bj = 0; bj < 2; ++bj) xv[m][bj] = *(const u32x4*)(X + (size_t)(row0 + ai * 128 + m * 16) * 1024 + bj * 128 + cl);
#pragma unroll
            for (int m = 0; m < 4; ++m) {
                const int row = row0 + ai * 128 + m * 16; float sq = 0.f;
#pragma unroll
                for (int bj = 0; bj < 2; ++bj) { f32x4 pa, pb; unpack8(xv[m][bj], pa, pb);
                    const f32x4 na = pa + acc[ai][bj][m][0] * alpha, nb = pb + acc[ai][bj][m][1] * alpha; const u32x4 w = pack8(na, nb); sq += sqpk(w);
                    *(u32x4*)(X + (size_t)row * 1024 + bj * 128 + cl) = w; *(u32x2*)(w_ + WS_X8 + (size_t)row * 1024 + bj * 128 + cl) = pack8_fp8(na, nb, SX8); }
                sq += __shfl_xor(sq, 16); sq += __shfl_xor(sq, 32);
                if (fq == 0) ss[(size_t)row * 16 + u.pn * 4 + wc] = sq;
            }
            asm volatile("" ::: "memory");
        }
    }
};
struct PleGemm : g8::DenseBase {
    static constexpr bool PERM = true;
    int lastl; float gsc;
    __device__ __forceinline__ void epi(Acc& acc, const Unit& u, int wr, int wc, int fr, int fq) const {
        fr = opaque(fr); fq = opaque(fq);
        unsigned char* w_ = ws; unsigned char* d_ = dout; asm volatile("" : "+s"(w_), "+s"(d_));
        const bf16_t* X = (const bf16_t*)(w_ + (l == 0 ? WS_XA : WS_XB)); bf16_t* Xn = (bf16_t*)(w_ + (l == 0 ? WS_XB : WS_XA)); const bf16_t* Pp = (l == 0) ? (const bf16_t*)(d_ + DO_PY) : (const bf16_t*)(w_ + WS_XA);
        const float* ss2 = (const float*)(w_ + WS_SS2); float* ssn = (float*)(w_ + WS_SSX); float* out = (float*)d_; unsigned char* X8n = w_ + WS_X8;
        const int row0 = opaque(u.pm * 256 + wr * 64 + fr), cl = u.pn * 256 + wc * 32 + fq * 8;
        int rows[2][4]; rows8(row0, rows); float rs[2][4]; rstd8(ss2, rows, fq, rs);
#pragma unroll
        for (int ai = 0; ai < 2; ++ai)
#pragma unroll
            for (int m = 0; m < 4; ++m) rs[ai][m] *= gsc;
#pragma unroll
        for (int ai = 0; ai < 2; ++ai)
#pragma unroll
            for (int mp = 0; mp < 2; ++mp) {
                u32x4 xv[2][2], pv[2][2];
#pragma unroll
                for (int mm = 0; mm < 2; ++mm)
#pragma unroll
                    for (int bj = 0; bj < 2; ++bj) { const size_t off = (size_t)rows[ai][mp * 2 + mm] * 1024 + bj * 128 + cl; xv[mm][bj] = *(const u32x4*)(X + off); pv[mm][bj] = *(const u32x4*)(Pp + off); }
#pragma unroll
                for (int mm = 0; mm < 2; ++mm) {
                    const int m = mp * 2 + mm; const int row = rows[ai][m]; const float r = rs[ai][m]; float sq = 0.f;
#pragma unroll
                    for (int bj = 0; bj < 2; ++bj) {
                        const size_t off = (size_t)row * 1024 + bj * 128 + cl;
                        f32x4 xa, xb, pa, pb; unpack8(xv[mm][bj], xa, xb); unpack8(pv[mm][bj], pa, pb);
                        f32x4 a = acc[ai][bj][m][0] * r, b = acc[ai][bj][m][1] * r;
#pragma unroll
                        for (int j = 0; j < 4; ++j) { a[j] = xa[j] + pa[j] * sigmoid_f(a[j]); b[j] = xb[j] + pb[j] * sigmoid_f(b[j]); }
                        if (lastl) { *(f32x4*)(out + off) = a; *(f32x4*)(out + off + 4) = b; }
                        else { const u32x4 w = pack8(a, b); sq += sqpk(w); *(u32x4*)(Xn + off) = w; *(u32x2*)(X8n + off) = pack8_fp8(a, b, SX8); }
                    }
                    if (!lastl) { sq += __shfl_xor(sq, 16); sq += __shfl_xor(sq, 32); if (fq == 0) ssn[(size_t)row * 16 + u.pn * 4 + wc] = sq; }
                }
                asm volatile("" ::: "memory");
            }
    }
};

#define XB_TMO      128
#define XB_XCNT(j)  (256  + 64 * (j))
#define XB_XSUB(j)  (1280 + 64 * (j))
#define XB_XGEN(j)  (2304 + 64 * (j))
#define XB_TOP      3328
#define XB_TOPGEN   3392
#define XCD_BAR_WORDS 3456
#define XB_SPIN_CAP (1u << 18)

__device__ __forceinline__ unsigned xb_ld(unsigned* p)              { return __hip_atomic_load(p, __ATOMIC_RELAXED, __HIP_MEMORY_SCOPE_AGENT); }
__device__ __forceinline__ unsigned xb_add(unsigned* p, unsigned v) { return __hip_atomic_fetch_add(p, v, __ATOMIC_RELAXED, __HIP_MEMORY_SCOPE_AGENT); }
__device__ __forceinline__ unsigned xb_xcc_id() { return (unsigned)__builtin_amdgcn_s_getreg((3 << 11) | 20) & 0xFu; }
#define XB_SPIN(cond, bar) do { unsigned _sp = 0; while (cond) { __builtin_amdgcn_s_sleep(1); \
    if ((++_sp & 255u) == 0u) { if (xb_ld(&(bar)[XB_TMO])) break; if (_sp > XB_SPIN_CAP) { atomicAdd(&(bar)[XB_TMO], 1u); break; } } } } while (0)

struct XcdBarrier {
    unsigned* bar; unsigned x;
    volatile LAS unsigned* st;
};

__device__ __forceinline__ XcdBarrier xcd_barrier_post(unsigned* bar, volatile LAS unsigned* st) {
    XcdBarrier b; b.bar = bar; b.x = xb_xcc_id(); b.st = st;
    if (threadIdx.x == 0) (void)xb_add(&bar[XB_XCNT(b.x)], 1u);
    return b;
}
__device__ __forceinline__ void xcd_barrier_complete(unsigned* bar, unsigned x, unsigned& nloc, unsigned& nx) {
    const unsigned G = gridDim.x * gridDim.y * gridDim.z;
    unsigned sum, cnt, mine, sp = 0u;
    for (;;) {
        sum = 0u; cnt = 0u; mine = 0u;
#pragma unroll
        for (unsigned j = 0; j < 16; ++j) { const unsigned c = xb_ld(&bar[XB_XCNT(j)]); sum += c; cnt += (c > 0u) ? 1u : 0u; mine = (j == x) ? c : mine; }
        if (sum == G) break;
        __builtin_amdgcn_s_sleep(1);
        if ((++sp & 255u) == 0u) { if (xb_ld(&bar[XB_TMO])) break; if (sp > XB_SPIN_CAP) { atomicAdd(&bar[XB_TMO], 1u); break; } }
    }
    nloc = mine > 0u ? mine : 1u; nx = cnt > 0u ? cnt : 1u;
}

__device__ __forceinline__ void xcd_barrier(const XcdBarrier& b) {
    asm volatile("s_waitcnt vmcnt(0)" ::: "memory");
    __syncthreads();
    if (threadIdx.x == 0) {
        unsigned* bar = b.bar; unsigned bx = b.x; asm volatile("" : "+s"(bar), "+s"(bx));
        __builtin_amdgcn_s_waitcnt(0);
        unsigned nloc = b.st[0], nx = b.st[1];
        if (nloc == 0u) { xcd_barrier_complete(bar, bx, nloc, nx); b.st[0] = nloc; b.st[1] = nx; }
        const unsigned old = xb_add(&bar[XB_XSUB(bx)], 1u);
        const unsigned gen = old / nloc;
        if (old + 1u == (gen + 1u) * nloc) {
            __builtin_amdgcn_fence(__ATOMIC_RELEASE, "agent");
            asm volatile("s_waitcnt vmcnt(0)" ::: "memory");
            const unsigned og = xb_add(&bar[XB_TOP], 1u);
            const unsigned tg = og / nx;
            if (og + 1u == (tg + 1u) * nx) xb_add(&bar[XB_TOPGEN], 1u);
            else XB_SPIN(xb_ld(&bar[XB_TOPGEN]) == tg, bar);
            __builtin_amdgcn_fence(__ATOMIC_ACQUIRE, "agent");
            xb_add(&bar[XB_XGEN(bx)], 1u);
            asm volatile("s_waitcnt vmcnt(0)" ::: "memory");
        } else {
            XB_SPIN(xb_ld(&bar[XB_XGEN(bx)]) == gen, bar);
            __builtin_amdgcn_fence(__ATOMIC_ACQUIRE, "agent");
            asm volatile("s_waitcnt vmcnt(0)" ::: "memory");
        }
    }
    __syncthreads();
}

struct Args { const float* in[27]; float* out; unsigned char* ws; int rep_n, pad; };
struct Frame {
    LAS unsigned char* lds; gu32* ctl; unsigned char* ws; unsigned char* dout;
    int tid, lane, wave, G, gw, NGW;
    inptr_t in;
};

__device__ __forceinline__ void transpose_item(const float* src, int src_ld, int k0, int src_col0, bf16_t* dst, int dst_ld, int dst_row0, int dst_k0, const float* kscale, LAS float* scr, int lane, float fp8s = 0.f) {
#pragma unroll 8
    for (int i = 0; i < 32; ++i) { const int kk = 2 * i + (lane >> 5); float v = src[(size_t)(k0 + kk) * src_ld + src_col0 + (lane & 31)]; if (kscale) v *= kscale[k0 + kk]; scr[kk * 33 + (lane & 31)] = v; }
    asm volatile("s_waitcnt lgkmcnt(0)" ::: "memory");
    const int c = lane & 7;
#pragma unroll
    for (int j = 0; j < 4; ++j) { const int n = (lane >> 3) + 8 * j; const LAS float* s = scr + (8 * c) * 33 + n;
        if (fp8s != 0.f) { const f32x4 a = {s[0 * 33], s[1 * 33], s[2 * 33], s[3 * 33]}, b = {s[4 * 33], s[5 * 33], s[6 * 33], s[7 * 33]};
            *(u32x2*)((unsigned char*)dst + (size_t)(dst_row0 + n) * dst_ld + dst_k0 + k0 + 8 * c) = pack8_fp8(a, b, fp8s); continue; }
        u32x4 o; o.x = cvt_pk_bf16(s[0 * 33], s[1 * 33]); o.y = cvt_pk_bf16(s[2 * 33], s[3 * 33]); o.z = cvt_pk_bf16(s[4 * 33], s[5 * 33]); o.w = cvt_pk_bf16(s[6 * 33], s[7 * 33]);
        *(u32x4*)(dst + (size_t)(dst_row0 + n) * dst_ld + dst_k0 + k0 + 8 * c) = o; }
    asm volatile("s_waitcnt lgkmcnt(0)" ::: "memory");
}
__device__ __forceinline__ void transpose_item64(const float* src, int src_ld, int k0, int col0a, int col0b, bf16_t* dst, int dst_ld, int dst_row0, int dst_k0, const float* kscale, LAS float* scr, int lane, float fp8s = 0.f) {
    const int cq = lane & 15, kr = lane >> 4; const int scol = (cq < 8) ? col0a + 4 * cq : col0b + 4 * (cq - 8);
    f32x4 v[16];
#pragma unroll
    for (int i = 0; i < 16; ++i) v[i] = *(const f32x4*)(src + (size_t)(k0 + kr + 4 * i) * src_ld + scol);
    if (kscale) {
#pragma unroll
        for (int i = 0; i < 16; ++i) v[i] = v[i] * kscale[k0 + kr + 4 * i];
    }
#pragma unroll
    for (int i = 0; i < 16; ++i) { LAS float* p = scr + (4 * cq) * 65 + kr + 4 * i; p[0] = v[i][0]; p[65] = v[i][1]; p[130] = v[i][2]; p[195] = v[i][3]; }
    asm volatile("s_waitcnt lgkmcnt(0)" ::: "memory");
    const int c = lane & 7;
#pragma unroll
    for (int j = 0; j < 8; ++j) { const int n = (lane >> 3) + 8 * j; const LAS float* q = scr + n * 65 + 8 * c;
        const f32x4 a = {q[0], q[1], q[2], q[3]}, b = {q[4], q[5], q[6], q[7]};
        if (fp8s != 0.f) *(u32x2*)((unsigned char*)dst + (size_t)(dst_row0 + n) * dst_ld + dst_k0 + k0 + 8 * c) = pack8_fp8(a, b, fp8s);
        else *(u32x4*)(dst + (size_t)(dst_row0 + n) * dst_ld + dst_k0 + k0 + 8 * c) = pack8(a, b); }
    asm volatile("s_waitcnt lgkmcnt(0)" ::: "memory");
}
__device__ __forceinline__ int win_src_col(int n) {
    const int pn = n >> 8, c = n & 255;
    if (pn >= 3 && pn <= 6) { const int bj = c >> 7, wcc = (c >> 5) & 3; const int base = (pn <= 4) ? 768 : 1280; return base + (4 * ((pn - 3) & 1) + wcc) * 64 + 32 * bj; }
    return n;
}
__device__ __forceinline__ void prep_layer(Frame& Fr, int l) {
    Frame F = Fr; F.lane = opaque(Fr.lane); F.gw = blockIdx.x * 8 + __builtin_amdgcn_readfirstlane(opaque(Fr.tid) >> 6);
    LAS float* scr = (LAS float*)(F.lds + F.wave * 16896);
    const float* mixg = F.in[2] + (size_t)l * D; const float* w_in = F.in[3] + (size_t)l * D * NIN;
    const float* pool_w = F.in[4] + (size_t)l * 4 * 64 * 64; const float* pool_s = F.in[5] + (size_t)l * 256;
    const float* wba = F.in[13] + (size_t)l * 256 * D; const float* wbb = F.in[14] + (size_t)l * 256 * D; const float* wbc = F.in[15] + (size_t)l * 512 * D;
    const float* wout = F.in[16] + (size_t)l * D * D; const float* ffng = F.in[17] + (size_t)l * D;
    const float* wein = F.in[22] + (size_t)l * NEXP * D * 256; const float* weout = F.in[23] + (size_t)l * NEXP * DEXP * D;
    bf16_t* Win_t = (bf16_t*)(F.ws + WS_WIN); bf16_t* Wbr_t = (bf16_t*)(F.ws + WS_WBR); bf16_t* Wout_t = (bf16_t*)(F.ws + WS_WOUT);
    bf16_t* Wein_t = (bf16_t*)(F.ws + WS_WEIN); bf16_t* Weout_t = (bf16_t*)(F.ws + WS_WEOUT);
    constexpr int I_IN = 16 * 80, I_POOL = 1024, I_BA = 4 * 16, I_BC = 8 * 16, I_OUT = 16 * 16, I_EIN = NEXP * 16 * 4, I_EOUT = NEXP * 2 * 16;
    constexpr int NITEMS = I_IN + I_POOL + 2 * I_BA + I_BC + I_OUT + I_EIN + I_EOUT;
    for (int it = F.gw; it < NITEMS; it += F.NGW) {
        int r = it;
        if (r < I_IN) { const int kb = r / 80, nb = r % 80 + 4;
            if (nb < 12) transpose_item64(w_in, NIN, 64 * kb, 64 * nb, 64 * nb + 32, Win_t, D, 64 * nb, 0, mixg, scr, F.lane);
            else transpose_item64(w_in, NIN, 64 * kb, win_src_col(64 * nb), win_src_col(64 * nb + 32), (bf16_t*)(F.ws + WS_WIN8), D, 64 * nb - 768, 0, mixg, scr, F.lane, SW8);
            continue; } r -= I_IN;
        if (r < I_POOL) {
            const int nb = r & 7, kb = r >> 3, g = nb >> 1, d0 = (nb & 1) * 32, nn = F.lane & 31, kh = F.lane >> 5, kbase = kb * 8 + kh * 4;
            float a[4] = {0.f, 0.f, 0.f, 0.f};
#pragma unroll 8
            for (int c = 0; c < 64; ++c) { const float pw = pool_w[(size_t)g * 4096 + c * 64 + d0 + nn];
#pragma unroll
                for (int j = 0; j < 4; ++j) a[j] += w_in[(size_t)(kbase + j) * NIN + g * 64 + c] * pw; }
            const float sc = pool_s[g * 64 + d0 + nn];
            u32x2 o; o.x = cvt_pk_bf16(a[0] * sc * mixg[kbase], a[1] * sc * mixg[kbase + 1]); o.y = cvt_pk_bf16(a[2] * sc * mixg[kbase + 2], a[3] * sc * mixg[kbase + 3]);
            *(u32x2*)(Win_t + (size_t)(g * 64 + d0 + nn) * D + kbase) = o; continue; } r -= I_POOL;
        if (r < I_BA) { transpose_item64(wba, D, 64 * (r / 16), 64 * (r % 16), 64 * (r % 16) + 32, Wbr_t, D, 64 * (r % 16), 0, nullptr, scr, F.lane); continue; } r -= I_BA;
        if (r < I_BA) { transpose_item64(wbb, D, 64 * (r / 16), 64 * (r % 16), 64 * (r % 16) + 32, Wbr_t, D, 64 * (r % 16), 256, nullptr, scr, F.lane); continue; } r -= I_BA;
        if (r < I_BC) { transpose_item64(wbc, D, 64 * (r / 16), 64 * (r % 16), 64 * (r % 16) + 32, Wbr_t, D, 64 * (r % 16), 512, nullptr, scr, F.lane); continue; } r -= I_BC;
        if (r < I_OUT) { transpose_item64(wout, D, 64 * (r / 16), 64 * (r % 16), 64 * (r % 16) + 32, Wout_t, D, 64 * (r % 16), 0, nullptr, scr, F.lane); continue; } r -= I_OUT;
        if (r < I_EIN) { const int e = r / 64, q = r % 64; transpose_item64(wein + (size_t)e * D * 256, 256, 64 * (q / 4), 64 * (q % 4), 64 * (q % 4) + 32, (bf16_t*)((unsigned char*)Wein_t + (size_t)e * 256 * D), D, 64 * (q % 4), 0, ffng, scr, F.lane, SW8); continue; } r -= I_EIN;
        { const int e = r / 32, q = r % 32; transpose_item64(weout + (size_t)e * DEXP * D, D, 64 * (q / 16), 64 * (q % 16), 64 * (q % 16) + 32, Weout_t + (size_t)e * D * DEXP, DEXP, 64 * (q % 16), 0, nullptr, scr, F.lane); }
    }
    const float* p = F.in[1] + (size_t)l * M * PLE; bf16_t* pb = (bf16_t*)(F.ws + WS_PB);
#pragma unroll 4
    for (size_t i = (size_t)F.gw * 64 + F.lane; i < (size_t)M * PLE / 8; i += (size_t)F.NGW * 64) {
        const f32x4 a = *(const f32x4*)(p + i * 8), b = *(const f32x4*)(p + i * 8 + 4); *(u32x4*)(pb + i * 8) = pack8(a, b); }
}
__device__ __forceinline__ void prologue(Frame& Fr) {
    Frame F = Fr; F.lane = opaque(Fr.lane); F.gw = blockIdx.x * 8 + __builtin_amdgcn_readfirstlane(opaque(Fr.tid) >> 6);
    LAS float* scr = (LAS float*)(F.lds + F.wave * 16896);
    constexpr int I_G = 16 * 16, I_P = 4 * 16;
    for (int it = F.gw; it < DEPTH * (I_G + I_P); it += F.NGW) {
        const int l = it / (I_G + I_P); int r = it % (I_G + I_P);
        if (r < I_G) { transpose_item64(F.in[26] + (size_t)l * D * D, D, 64 * (r / 16), 64 * (r % 16), 64 * (r % 16) + 32, (bf16_t*)(F.ws + WS_WGATE + (size_t)l * 2 * MiB), D, 64 * (r % 16), 0, F.in[24] + (size_t)l * D, scr, F.lane, SW8); continue; } r -= I_G;
        transpose_item64(F.in[25] + (size_t)l * PLE * D, D, 64 * (r / 16), 64 * (r % 16), 64 * (r % 16) + 32, (bf16_t*)(F.ws + WS_WPLE) + (size_t)l * (512 * 1024), PLE, 64 * (r % 16), 0, nullptr, scr, F.lane);
    }
    for (int i = F.gw * 64 + F.lane; i < DEPTH * 96 * D; i += F.NGW * 64) {
        const int l = i / (96 * D), o = (i / D) % 96, k = i % D; bf16_t r = 0;
        if (o < 72) { const int oo = o < 36 ? o : o - 36;
            const float w = ((oo < 4) ? F.in[18][((size_t)l * D + k) * 4 + oo] : F.in[20][((size_t)l * D + k) * 32 + (oo - 4)]) * F.in[17][(size_t)l * D + k];
            const bf16_t h = f2bf(w); r = (o < 36) ? h : f2bf(w - bf2f(h)); }
        ((bf16_t*)(F.ws + WS_WR))[i] = r;
    }
    if (F.gw == 0) { for (int i = F.lane; i < DEPTH * 36; i += 64) { const int l = i / 36, o = i % 36; ((float*)(F.ws + WS_WR + WR_BIAS))[i] = (o < 4) ? F.in[19][l * 4 + o] : F.in[21][l * 32 + o - 4]; } }
    if (F.gw == 1) { for (int i = F.lane; i < DEPTH * 128; i += 64) { const int l = i >> 7, j = i & 127; ((float*)(F.ws + WS_MISC + MISC_GQK))[i] = (j < 64) ? F.in[9][l * 64 + j] : F.in[10][l * 64 + j - 64]; } }
    for (int i = F.gw * 64 + F.lane; i < DEPTH * 4 * 128 * 128; i += F.NGW * 64) { const int ii = (i >> 7) & 127, jj = i & 127; ((bf16_t*)(F.ws + WS_MISC + MISC_WM))[i] = ((jj >> 6) <= (ii >> 6)) ? f2bf(F.in[7][i]) : (bf16_t)0; }
    for (int i = F.gw * 64 + F.lane; i < DEPTH * 8 * 256; i += F.NGW * 64) { const int lh = i >> 8, ii = i & 255; const int idx = ii + 65 > 256 ? 256 : ii + 65; ((float*)(F.ws + WS_MISC + MISC_TB))[i] = F.in[11][(size_t)lh * 257 + idx] * LOG2E; }
    if (F.gw < DEPTH * 8) {
        const int l = F.gw >> 3; float mq = fabsf(F.in[9][l * 64 + F.lane]), mk = fabsf(F.in[10][l * 64 + F.lane]), mb = -1e30f;
        for (int i = F.lane; i < 257; i += 64) mb = fmaxf(mb, F.in[11][(size_t)F.gw * 257 + i]);
#pragma unroll
        for (int o = 1; o < 64; o <<= 1) { mq = fmaxf(mq, __shfl_xor(mq, o)); mk = fmaxf(mk, __shfl_xor(mk, o)); mb = fmaxf(mb, __shfl_xor(mb, o)); }
        if (F.lane == 0) ((float*)(F.ws + WS_MISC + MISC_ATTM))[F.gw] = (8.0f * mq * mk + mb) * LOG2E;
    }
    bf16_t* XA = (bf16_t*)(F.ws + WS_XA); float* ssx = (float*)(F.ws + WS_SSX);
    for (int m0 = F.gw * 4; m0 < M; m0 += F.NGW * 4) {
        f32x4 v[4][4];
#pragma unroll
        for (int q = 0; q < 4; ++q)
#pragma unroll
            for (int j = 0; j < 4; ++j) v[q][j] = ((const f32x4*)(F.in[0] + (size_t)(m0 + q) * D) + F.lane)[64 * j];
#pragma unroll
        for (int q = 0; q < 4; ++q) { const int m = m0 + q; float s = 0.f;
#pragma unroll
            for (int j = 0; j < 4; ++j) { const f32x4 x = v[q][j]; u32x2 w; w.x = cvt_pk_bf16(x[0], x[1]); w.y = cvt_pk_bf16(x[2], x[3]);
                const float a0 = bflo(w.x), a1 = bfhi(w.x), a2 = bflo(w.y), a3 = bfhi(w.y); s += (a0 * a0 + a1 * a1) + (a2 * a2 + a3 * a3);
                *(u32x2*)(XA + (size_t)m * D + 256 * j + 4 * F.lane) = w;
                { int p8 = __builtin_amdgcn_cvt_pk_fp8_f32(x[0] * SX8, x[1] * SX8, 0, false); p8 = __builtin_amdgcn_cvt_pk_fp8_f32(x[2] * SX8, x[3] * SX8, p8, true); *(int*)(F.ws + WS_X8 + (size_t)m * D + 256 * j + 4 * F.lane) = p8; } }
            s = wave_sum(s);
            if (F.lane < 16) ssx[(size_t)m * 16 + F.lane] = (F.lane == 0) ? s : 0.f; }
    }
}

__device__ __forceinline__ void router_phase(Frame& Fr, int l, const bf16_t* X, const float* ss1, bool dry) {
    typedef float f32x16 __attribute__((ext_vector_type(16)));
    Frame F = Fr; F.lane = opaque(Fr.lane); F.tid = opaque(Fr.tid); F.gw = blockIdx.x * 8 + __builtin_amdgcn_readfirstlane(F.tid >> 6);
    const int lane = F.lane, r16 = lane & 15, kq = lane >> 4;
    const bf16_t* Wt = (const bf16_t*)(F.ws + WS_WR) + (size_t)l * 96 * D; const float* br = (const float*)(F.ws + WS_WR + WR_BIAS) + l * 36;
    LAS float* lg;
    int* tok_e = (int*)(F.ws + WS_MISC + MISC_TOKE); float* tok_w = (float*)(F.ws + WS_MISC + MISC_TOKW);
    int* elist = (int*)(F.ws + WS_ELIST); int* plist = (int*)(F.ws + WS_PLIST);
    gu32* cnt = F.ctl + CW_CNT + (size_t)l * 160 * 64;
    LAS unsigned char* tb = F.lds; constexpr int TPITCH = 272, TBUF = 80 * TPITCH;
    lg = (LAS float*)(F.lds + 45056) + F.wave * (16 * 81);
    const int tid = F.tid;
    for (int wt = blockIdx.x; wt < M / 128; wt += F.G) {
        const int tok0 = wt * 128 + F.wave * 16;
        const bf16_t* xr = X + (size_t)(tok0 + r16) * D + kq * 8;
        u32x4 tr[3]; bf16x8 xc[4], xn[4];
#define RT_LOADT(c) do { _Pragma("unroll") for (int p_ = 0; p_ < 3; ++p_) { const int pc_ = tid + 512 * p_; if (pc_ < 1280) tr[p_] = *(const u32x4*)(Wt + (size_t)(pc_ >> 4) * D + (c) * 128 + (pc_ & 15) * 8); } } while (0)
#define RT_STORET(b) do { _Pragma("unroll") for (int p_ = 0; p_ < 3; ++p_) { const int pc_ = tid + 512 * p_; if (pc_ < 1280) *(LAS u32x4*)(tb + (b) * TBUF + (pc_ >> 4) * TPITCH + (pc_ & 15) * 16) = tr[p_]; } } while (0)
        RT_LOADT(0);
#pragma unroll
        for (int s4 = 0; s4 < 4; ++s4) xc[s4] = *(const bf16x8*)(xr + 32 * s4);
        asm volatile("s_waitcnt lgkmcnt(0)\n\ts_barrier" ::: "memory");
        RT_STORET(0);
        f32x4 a0 = {0.f, 0.f, 0.f, 0.f}, a1 = a0, a2 = a0, a3 = a0, a4 = a0;
#pragma unroll 1
        for (int c = 0; c < 8; ++c) {
            if (c + 1 < 8) { RT_LOADT(c + 1);
#pragma unroll
                for (int s4 = 0; s4 < 4; ++s4) xn[s4] = *(const bf16x8*)(xr + 128 * (c + 1) + 32 * s4); }
            asm volatile("s_waitcnt lgkmcnt(0)\n\ts_barrier" ::: "memory");
            const LAS unsigned char* bb = tb + (c & 1) * TBUF + r16 * TPITCH + kq * 16;
#pragma unroll
            for (int s4 = 0; s4 < 4; ++s4) {
                const bf16x8 b0 = *(const LAS bf16x8*)(bb + s4 * 64), b1 = *(const LAS bf16x8*)(bb + 16 * TPITCH + s4 * 64), b2 = *(const LAS bf16x8*)(bb + 32 * TPITCH + s4 * 64),
                             b3 = *(const LAS bf16x8*)(bb + 48 * TPITCH + s4 * 64), b4 = *(const LAS bf16x8*)(bb + 64 * TPITCH + s4 * 64);
                a0 = __builtin_amdgcn_mfma_f32_16x16x32_bf16(xc[s4], b0, a0, 0, 0, 0); a1 = __builtin_amdgcn_mfma_f32_16x16x32_bf16(xc[s4], b1, a1, 0, 0, 0); a2 = __builtin_amdgcn_mfma_f32_16x16x32_bf16(xc[s4], b2, a2, 0, 0, 0);
                a3 = __builtin_amdgcn_mfma_f32_16x16x32_bf16(xc[s4], b3, a3, 0, 0, 0); a4 = __builtin_amdgcn_mfma_f32_16x16x32_bf16(xc[s4], b4, a4, 0, 0, 0);
            }
            if (c + 1 < 8) { RT_STORET((c + 1) & 1);
#pragma unroll
                for (int s4 = 0; s4 < 4; ++s4) xc[s4] = xn[s4]; }
        }
#undef RT_LOADT
#undef RT_STORET
#pragma unroll
        for (int r = 0; r < 4; ++r) { LAS float* p = lg + (4 * kq + r) * 81 + r16; p[0] = a0[r]; p[16] = a1[r]; p[32] = a2[r]; p[48] = a3[r]; p[64] = a4[r]; }
        asm volatile("s_waitcnt lgkmcnt(0)" ::: "memory");
        if (lane < 16) {
            const int tok = tok0 + lane; const LAS float* q = lg + lane * 81;
            const f32x4* sp = (const f32x4*)(ss1 + (size_t)tok * 16); const f32x4 s0 = sp[0], s1 = sp[1], s2 = sp[2], s3 = sp[3];
            const float ssum = (((s0[0] + s0[1]) + (s0[2] + s0[3])) + ((s1[0] + s1[1]) + (s1[2] + s1[3]))) + (((s2[0] + s2[1]) + (s2[2] + s2[3])) + ((s3[0] + s3[1]) + (s3[2] + s3[3])));
            const float rstd = rsqrtf(ssum * (1.0f / D) + EPS);
#define RLOGIT(o) ((q[(o)] + q[36 + (o)]) * rstd + br[(o)])
            int g = 0; float gm = RLOGIT(0); float gl[4]; gl[0] = gm;
#pragma unroll
            for (int j = 1; j < 4; ++j) { gl[j] = RLOGIT(j); if (gl[j] > gm) { gm = gl[j]; g = j; } }
            float gs = 0.f;
#pragma unroll
            for (int j = 0; j < 4; ++j) gs += __expf(gl[j] - gm);
            const float gp = 1.0f / gs;
            int i1 = 0, i2 = -1; float m1 = -3.0e38f, m2 = -3.0e38f;
            for (int j = 0; j < 8; ++j) { const float v = RLOGIT(4 + 8 * g + j); if (v > m1) { m2 = m1; i2 = i1; m1 = v; i1 = j; } else if (v > m2) { m2 = v; i2 = j; } }
#undef RLOGIT
            const float e2 = __expf(m2 - m1), w1 = gp / (1.0f + e2), w2 = gp * e2 / (1.0f + e2);
            const int a = i1 < i2 ? i1 : i2, b = i1 < i2 ? i2 : i1; const float wlo = i1 < i2 ? w1 : w2, whi = i1 < i2 ? w2 : w1;
            const int lo = g * 8 + a, hh = g * 8 + b, pc = g * 28 + (a * 8 - (a * (a + 1)) / 2) + (b - a - 1);
            tok_e[tok] = lo | (hh << 8) | (pc << 16); tok_w[2 * tok] = wlo; tok_w[2 * tok + 1] = whi;
            if (!dry) {
            const unsigned p0 = __hip_atomic_fetch_add(cnt + 64 * lo, 1u, __ATOMIC_RELAXED, __HIP_MEMORY_SCOPE_AGENT); elist[(size_t)lo * CAP + p0] = tok * 2;
            const unsigned p1 = __hip_atomic_fetch_add(cnt + 64 * hh, 1u, __ATOMIC_RELAXED, __HIP_MEMORY_SCOPE_AGENT); elist[(size_t)hh * CAP + p1] = tok * 2 + 1;
            const unsigned p2 = __hip_atomic_fetch_add(cnt + 64 * (32 + pc), 1u, __ATOMIC_RELAXED, __HIP_MEMORY_SCOPE_AGENT); plist[(size_t)pc * CAP + p2] = tok; }
        }
    }
    __syncthreads();
}

constexpr int LT_PRE = LDSCTL_OFF + 64, LT_CNT = LT_PRE + 116 * 4;
__device__ __forceinline__ void build_class_tables(Frame& F, gu32* cnt, int ncls) {
    LAS int* tpre = (LAS int*)(F.lds + LT_PRE); LAS int* ccnt = (LAS int*)(F.lds + LT_CNT);
    __syncthreads();
    const int tid = opaque(F.tid);
    if (tid < ncls) ccnt[tid] = (int)__hip_atomic_load(cnt + 64 * tid, __ATOMIC_RELAXED, __HIP_MEMORY_SCOPE_AGENT);
    __syncthreads();
    if (tid <= ncls) { int a = 0;
#pragma unroll 8
        for (int c = 0; c < tid; ++c) a += (ccnt[c] + 255) >> 8;
        tpre[tid] = a; }
    __syncthreads();
}
struct Moe1Gemm {
    struct Unit { int pm, pn, e, cnt; };
    static constexpr bool PERM = true, GATHER = true;
    const char* a_base; unsigned lda; const char* b_base; unsigned ldb; int nt; int G, c;
    unsigned char* ws; unsigned char* dout; const LAS int* tpre; const LAS int* ccnt;
    __device__ __forceinline__ bool next(int i, Unit& u) const {
        const int L = i * G + c; if (L >= tpre[NEXP]) return false;
        int e = 0;
#pragma unroll
        for (int st = 16; st >= 1; st >>= 1) { if (tpre[e + st] <= L) e += st; }
        u.e = e; u.pm = L - tpre[e]; u.pn = 0; u.cnt = ccnt[e]; return true;
    }
    __device__ __forceinline__ void a_off(const Unit& u, const int (&R)[2], const int (&C)[2], unsigned (&o)[2][2]) const {
        unsigned char* w_ = ws; unsigned char* d_ = dout; asm volatile("" : "+s"(w_), "+s"(d_));
        const int* elist = (const int*)(w_ + WS_ELIST);
#pragma unroll
        for (int h = 0; h < 2; ++h)
#pragma unroll
            for (int i = 0; i < 2; ++i) { const int r = u.pm * 256 + h * 128 + R[i]; const int ent = (r < u.cnt) ? elist[(size_t)u.e * CAP + r] : 0; o[h][i] = (unsigned)(ent >> 1) * lda + (unsigned)C[i] * 2u; }
    }
    __device__ __forceinline__ const char* a_tile(const Unit&) const { return a_base; }
    __device__ __forceinline__ const char* b_tile(const Unit& u, int kt) const { return b_base + (size_t)u.e * 256 * ldb + (size_t)kt * 128; }
    __device__ __forceinline__ void mid(Acc&, const Unit&, int, int, int, int, int) const {}
    __device__ __forceinline__ void epi(Acc& acc, const Unit& u, int wr, int wc, int fr, int fq) const {
        fr = opaque(fr); fq = opaque(fq);
        unsigned char* w_ = ws; unsigned char* d_ = dout; asm volatile("" : "+s"(w_), "+s"(d_));
        const int* elist = (const int*)(w_ + WS_ELIST); const float* tok_w = (const float*)(w_ + WS_MISC + MISC_TOKW); const float* ss1 = (const float*)(w_ + WS_SS1); bf16_t* H = (bf16_t*)(w_ + WS_H);
        const int r0 = opaque(u.pm * 256 + wr * 64 + fr);
        int ent[2][4], rows[2][4]; float rs[2][4], w[2][4];
#pragma unroll
        for (int ai = 0; ai < 2; ++ai)
#pragma unroll
            for (int m = 0; m < 4; ++m) { const int r = r0 + ai * 128 + m * 16; ent[ai][m] = (r < u.cnt) ? elist[(size_t)u.e * CAP + r] : -1; }
#pragma unroll
        for (int ai = 0; ai < 2; ++ai)
#pragma unroll
            for (int m = 0; m < 4; ++m) { const int e0 = ent[ai][m] < 0 ? 0 : ent[ai][m]; rows[ai][m] = e0 >> 1; w[ai][m] = tok_w[e0]; }
        rstd8(ss1, rows, fq, rs);
#pragma unroll
        for (int ai = 0; ai < 2; ++ai)
#pragma unroll
            for (int m = 0; m < 4; ++m) {
                const float r = rs[ai][m] * INV_S8, ww = w[ai][m]; f32x4 a, b;
#pragma unroll
                for (int j = 0; j < 4; ++j) { a[j] = silu_f(acc[ai][0][m][0][j] * r) * (acc[ai][1][m][0][j] * r) * ww; b[j] = silu_f(acc[ai][0][m][1][j] * r) * (acc[ai][1][m][1][j] * r) * ww; }
                if (ent[ai][m] >= 0) *(u32x4*)(H + (size_t)rows[ai][m] * 256 + (ent[ai][m] & 1) * 128 + wc * 32 + fq * 8) = pack8(a, b);
            }
    }
};
struct Moe2Gemm {
    struct Unit { int pm, pn, lo, hi, cnt, pc; };
    static constexpr bool PERM = true, GATHER = true;
    const char* a_base; unsigned lda; const char* b_base; unsigned ldb; int nt; int G, c;
    unsigned char* ws; unsigned char* dout; int l; const LAS int* tpre; const LAS int* ccnt; float alpha;
    __device__ __forceinline__ bool next(int i, Unit& u) const {
        const int L = i * G + c, T = L >> 2; if (T >= tpre[NPAIR]) return false;
        int pc = 0;
#pragma unroll
        for (int st = 64; st >= 1; st >>= 1) { if (pc + st <= NPAIR && tpre[pc + st] <= T) pc += st; }
        u.pc = pc; u.pm = T - tpre[pc]; u.pn = L & 3; u.cnt = ccnt[pc];
        const int g = pc / 28; int pi = pc - g * 28, a = 0; while (pi >= 7 - a) { pi -= 7 - a; ++a; }
        u.lo = g * 8 + a; u.hi = g * 8 + a + 1 + pi; return true;
    }
    __device__ __forceinline__ void a_off(const Unit& u, const int (&R)[2], const int (&C)[2], unsigned (&o)[2][2]) const {
        unsigned char* w_ = ws; unsigned char* d_ = dout; asm volatile("" : "+s"(w_), "+s"(d_));
        const int* plist = (const int*)(w_ + WS_PLIST);
#pragma unroll
        for (int h = 0; h < 2; ++h)
#pragma unroll
            for (int i = 0; i < 2; ++i) { const int r = u.pm * 256 + h * 128 + R[i]; const int tok = (r < u.cnt) ? plist[(size_t)u.pc * CAP + r] : 0; o[h][i] = (unsigned)tok * lda + (unsigned)C[i] * 2u; }
    }
    __device__ __forceinline__ const char* a_tile(const Unit&) const { return a_base; }
    __device__ __forceinline__ const char* b_tile(const Unit& u, int kt) const { return b_base + (size_t)(kt < 2 ? u.lo : u.hi) * D * ldb + (size_t)u.pn * 256 * ldb + (size_t)(kt & 1) * 128; }
    __device__ __forceinline__ void mid(Acc&, const Unit&, int, int, int, int, int) const {}
    __device__ __forceinline__ void epi(Acc& acc, const Unit& u, int wr, int wc, int fr, int fq) const {
        fr = opaque(fr); fq = opaque(fq);
        unsigned char* w_ = ws; unsigned char* d_ = dout; asm volatile("" : "+s"(w_), "+s"(d_));
        const int* plist = (const int*)(w_ + WS_PLIST); bf16_t* X = (bf16_t*)(w_ + (l == 0 ? WS_XA : WS_XB)); float* ss = (float*)(w_ + WS_SS2); unsigned char* X8p = w_ + WS_X8P;
        const int r0 = opaque(u.pm * 256 + wr * 64 + fr), cl = u.pn * 256 + wc * 32 + fq * 8;
        int tok[2][4];
#pragma unroll
        for (int ai = 0; ai < 2; ++ai)
#pragma unroll
            for (int m = 0; m < 4; ++m) { const int r = r0 + ai * 128 + m * 16; tok[ai][m] = (r < u.cnt) ? plist[(size_t)u.pc * CAP + r] : -1; }
#pragma unroll
        for (int ai = 0; ai < 2; ++ai) {
            u32x4 xv[4][2];
#pragma unroll
            for (int m = 0; m < 4; ++m)
#pragma unroll
                for (int bj = 0; bj < 2; ++bj) xv[m][bj] = *(const u32x4*)(X + (size_t)(tok[ai][m] < 0 ? 0 : tok[ai][m]) * 1024 + bj * 128 + cl);
#pragma unroll
            for (int m = 0; m < 4; ++m) {
                const bool ok = tok[ai][m] >= 0; const size_t t = ok ? tok[ai][m] : 0; float sq = 0.f;
#pragma unroll
                for (int bj = 0; bj < 2; ++bj) { f32x4 pa, pb; unpack8(xv[m][bj], pa, pb);
                    const f32x4 na = pa + acc[ai][bj][m][0] * alpha, nb = pb + acc[ai][bj][m][1] * alpha; const u32x4 w = pack8(na, nb); sq += sqpk(w);
                    if (ok) { *(u32x4*)(X + t * 1024 + bj * 128 + cl) = w; *(u32x2*)(X8p + t * 1024 + bj * 128 + cl) = pack8_fp8(na, nb, SX8); } }
                sq += __shfl_xor(sq, 16); sq += __shfl_xor(sq, 32);
                if (ok && fq == 0) ss[t * 16 + u.pn * 4 + wc] = sq;
            }
            asm volatile("" ::: "memory");
        }
    }
};

namespace att {
typedef float f32x16 __attribute__((ext_vector_type(16)));
typedef short s16x4 __attribute__((ext_vector_type(4)));
constexpr int LK = 0, LV = 24576, LWS = 49152, LOST = 51200, LTB = 83968, LDS_NEED = 84992;
__device__ __forceinline__ int crow(int r, int hi) { return (r & 3) + 8 * (r >> 2) + 4 * hi; }
__device__ __forceinline__ void glds16(const void* gsrc, unsigned lds_dst) { unsigned keep;
    asm volatile("s_mov_b32 %0, m0\n\ts_mov_b32 m0, %2\n\ts_nop 0\n\tglobal_load_lds_dwordx4 %1, off\n\ts_mov_b32 m0, %0" : "=&s"(keep) : "v"(gsrc), "s"(lds_dst) : "memory"); }
__device__ __forceinline__ void attn_unit(int b, int cq, int h, const bf16_t* Q, const bf16_t* K, const bf16_t* V, bf16_t* Y, LAS unsigned char* lds, const float* tbg, float negM) {
    const int tid = opaque(threadIdx.x), lane = tid & 63, r32 = lane & 31, hi = lane >> 5; const int wid = __builtin_amdgcn_readfirstlane(tid >> 6);
    const long rowbase = (long)b * SEQ; const int q0 = cq * 256;
    const bf16_t* Qw = Q + (rowbase + q0 + wid * 32) * 512 + h * 64;
    const bf16_t* Kh = K + rowbase * 512 + h * 64; const bf16_t* Vh = V + rowbase * 512 + h * 64;
    const unsigned lds0 = (unsigned)(uintptr_t)lds;
    LAS float* wsf = (LAS float*)(lds + LWS) + wid * 64; LAS float* tbl = (LAS float*)(lds + LTB);
    if (tid < 256) tbl[tid] = tbg[tid];
    const float negMfar = negM + tbg[255];
    const bf16_t* ksrc = Kh + (long)lane * 512 + wid * 8;
    const bf16_t* vsrc = Vh + (long)(16 * (wid & 3) + (lane >> 2)) * 512 + (wid >> 2) * 32 + (lane & 3) * 8;
    const unsigned kdst = lds0 + LK + wid * 1024, vdst = lds0 + LV + wid * 1024;
    bf16x8 qr[4];
#pragma unroll
    for (int d0 = 0; d0 < 4; ++d0) qr[d0] = *(const bf16x8*)(Qw + (long)r32 * 512 + d0 * 16 + hi * 8);
    f32x16 o0 = {}, o1 = {}; float lsum = 0.f;
    const int ci = wid >> 1, jfirst = (cq >= 2) ? 0 : 8 - 4 * cq;
#define ATT_DMA(j, sl) do { const long ko_ = (long)(4 * cq - 8 + (j)) * 64 * 512; glds16(ksrc + ko_, (unsigned)__builtin_amdgcn_readfirstlane(kdst + (sl) * 8192)); glds16(vsrc + ko_, (unsigned)__builtin_amdgcn_readfirstlane(vdst + (sl) * 8192)); } while (0)
    ATT_DMA(jfirst, 0);
    if (jfirst + 1 < 12) ATT_DMA(jfirst + 1, 1);
    int slot = 0;
    for (int j = jfirst; j < 12; ++j) {
        if (j + 1 < 12) asm volatile("s_waitcnt vmcnt(2) lgkmcnt(0)\n\ts_barrier" ::: "memory"); else asm volatile("s_waitcnt vmcnt(0) lgkmcnt(0)\n\ts_barrier" ::: "memory");
        if (j + 2 < 12) ATT_DMA(j + 2, (slot + 2) % 3);
        if (j >= ci && j <= ci + 8) {
            const int delta = ci + 8 - j;
            const float cv = delta >= 3 ? negMfar : negM;
            f32x16 cin;
#pragma unroll
            for (int r = 0; r < 16; ++r) cin[r] = cv;
            f32x16 p0, p1;
            const LAS unsigned char* kb = lds + LK + slot * 8192 + hi * 1024 + r32 * 16;
#pragma unroll
            for (int d0 = 0; d0 < 4; ++d0) {
                const bf16x8 b0 = *(const LAS bf16x8*)(kb + d0 * 2048), b1 = *(const LAS bf16x8*)(kb + d0 * 2048 + 512);
                if (d0 == 0) { p0 = __builtin_amdgcn_mfma_f32_32x32x16_bf16(b0, qr[0], cin, 0, 0, 0); p1 = __builtin_amdgcn_mfma_f32_32x32x16_bf16(b1, qr[0], cin, 0, 0, 0); }
                else { p0 = __builtin_amdgcn_mfma_f32_32x32x16_bf16(b0, qr[d0], p0, 0, 0, 0); p1 = __builtin_amdgcn_mfma_f32_32x32x16_bf16(b1, qr[d0], p1, 0, 0, 0); }
            }
            if (delta < 3) {
                const LAS float* tb = tbl + (32 * (wid & 1) + r32 + 64 * delta + 63 - 4 * hi);
#pragma unroll
                for (int r = 0; r < 16; ++r) { const int cr = (r & 3) + 8 * (r >> 2); p0[r] += tb[-cr]; p1[r] += tb[-cr - 32]; }
            }
            float sacc = 0.f;
#pragma unroll
            for (int r = 0; r < 16; ++r) { p0[r] = fast_exp2(p0[r]); p1[r] = fast_exp2(p1[r]); sacc += p0[r] + p1[r]; }
            lsum += sacc;
            u32x4 pw0, pw1, pw2, pw3;
            pw0 = (u32x4){cvt_pk_bf16(p0[0], p0[1]), cvt_pk_bf16(p0[2], p0[3]), cvt_pk_bf16(p0[4], p0[5]), cvt_pk_bf16(p0[6], p0[7])};
            pw1 = (u32x4){cvt_pk_bf16(p0[8], p0[9]), cvt_pk_bf16(p0[10], p0[11]), cvt_pk_bf16(p0[12], p0[13]), cvt_pk_bf16(p0[14], p0[15])};
            pw2 = (u32x4){cvt_pk_bf16(p1[0], p1[1]), cvt_pk_bf16(p1[2], p1[3]), cvt_pk_bf16(p1[4], p1[5]), cvt_pk_bf16(p1[6], p1[7])};
            pw3 = (u32x4){cvt_pk_bf16(p1[8], p1[9]), cvt_pk_bf16(p1[10], p1[11]), cvt_pk_bf16(p1[12], p1[13]), cvt_pk_bf16(p1[14], p1[15])};
            const int vb = (int)(lds0 + LV + slot * 8192) + ((lane >> 4) & 1) * 32 + (lane & 3) * 8 + (4 * hi + ((lane & 15) >> 2)) * 64;
#pragma unroll
            for (int d0 = 0; d0 < 2; ++d0) { s16x4 vlo[4], vhi[4];
#pragma unroll
                for (int ks = 0; ks < 4; ++ks) {
                    asm volatile("ds_read_b64_tr_b16 %0,%1 offset:%c2" : "=&v"(vlo[ks]) : "v"(vb), "i"(d0 * 4096 + ks * 1024) : "memory");
                    asm volatile("ds_read_b64_tr_b16 %0,%1 offset:%c2" : "=&v"(vhi[ks]) : "v"(vb), "i"(d0 * 4096 + ks * 1024 + 512) : "memory"); }
                asm volatile("s_waitcnt lgkmcnt(0)" ::: "memory"); __builtin_amdgcn_sched_barrier(0);
#define ATT_PK(k) (bf16x8){vlo[k][0], vlo[k][1], vlo[k][2], vlo[k][3], vhi[k][0], vhi[k][1], vhi[k][2], vhi[k][3]}
                f32x16 oo = d0 == 0 ? o0 : o1;
                oo = __builtin_amdgcn_mfma_f32_32x32x16_bf16(__builtin_bit_cast(bf16x8, pw0), ATT_PK(0), oo, 0, 0, 0);
                oo = __builtin_amdgcn_mfma_f32_32x32x16_bf16(__builtin_bit_cast(bf16x8, pw1), ATT_PK(1), oo, 0, 0, 0);
                oo = __builtin_amdgcn_mfma_f32_32x32x16_bf16(__builtin_bit_cast(bf16x8, pw2), ATT_PK(2), oo, 0, 0, 0);
                oo = __builtin_amdgcn_mfma_f32_32x32x16_bf16(__builtin_bit_cast(bf16x8, pw3), ATT_PK(3), oo, 0, 0, 0);
#undef ATT_PK
                if (d0 == 0) o0 = oo; else o1 = oo;
            }
        }
        slot = (slot + 1) % 3;
    }
#undef ATT_DMA
    { auto rr = __builtin_amdgcn_permlane32_swap(__float_as_uint(lsum), __float_as_uint(lsum), false, false); lsum = __uint_as_float(rr[0]) + __uint_as_float(rr[1]); }
    if (hi == 0) wsf[32 + r32] = lsum;
    asm volatile("s_waitcnt lgkmcnt(0)" ::: "memory");
    bf16_t* Ow = Y + (rowbase + q0 + wid * 32) * 1024 + 512 + h * 64;
    LAS bf16_t* stg = (LAS bf16_t*)(lds + LOST) + wid * 2048;
#pragma unroll
    for (int r = 0; r < 16; ++r) { const int orow = crow(r, hi); const float rl = fast_rcp(wsf[32 + orow]);
        stg[orow * 64 + r32] = f2bf(o0[r] * rl); stg[orow * 64 + 32 + r32] = f2bf(o1[r] * rl); }
    asm volatile("s_waitcnt lgkmcnt(0)" ::: "memory");
#pragma unroll
    for (int i = 0; i < 4; ++i) { const int row = i * 8 + (lane >> 3), ch = lane & 7; const u32x4 v = *(const LAS u32x4*)(stg + row * 64 + ch * 8); *(u32x4*)(Ow + (long)row * 1024 + ch * 8) = v; }
    asm volatile("s_waitcnt lgkmcnt(0)\n\ts_barrier" ::: "memory");
}
__device__ __forceinline__ void attn_phase(Frame& F, int l, bf16_t* Y) {
    const bf16_t* Q = (const bf16_t*)(F.dout + DO_Q); const bf16_t* K = (const bf16_t*)(F.dout + DO_K); const bf16_t* V = (const bf16_t*)(F.ws + WS_V);
    const float* tb = (const float*)(F.ws + WS_MISC + MISC_TB) + (size_t)l * 8 * 256; const float* am = (const float*)(F.ws + WS_MISC + MISC_ATTM) + l * 8;
    for (int u = blockIdx.x; u < 4 * 32 * 8; u += F.G) {
        const int h = u & 7, cq = (u >> 3) & 31, b = u >> 8;
        const float negM = -__hip_atomic_load(am + h, __ATOMIC_RELAXED, __HIP_MEMORY_SCOPE_AGENT);
        attn_unit(b, cq, h, Q, K, V, Y, F.lds, tb + h * 256, negM);
    }
}
}

__device__ __forceinline__ void sgu_unit(Frame& F, int l, int blk, int gp, bf16_t* Y) {
    using namespace att;
    const int tid = opaque(threadIdx.x), lane = tid & 63, r32 = lane & 31, hi = lane >> 5; const int wid = __builtin_amdgcn_readfirstlane(tid >> 6);
    LAS unsigned char* lds = F.lds; const unsigned lds0 = (unsigned)(uintptr_t)lds;
    const bf16_t* Zu = (const bf16_t*)(F.ws + WS_ZU); const bf16_t* Zv = (const bf16_t*)(F.ws + WS_ZV); const float* ssv = (const float*)(F.ws + WS_SSV);
    const bf16_t* Wm = (const bf16_t*)(F.ws + WS_MISC + MISC_WM) + (size_t)l * 4 * 16384;
    const float* gn = F.in[6] + l * 256; const float* b_s = F.in[8] + l * 512;
    const long t0 = (long)blk * 128; const int rb = wid & 3, gi = wid >> 2, g = 2 * gp + gi;
    LAS float* rst = (LAS float*)(lds + 32768); LAS float* stg = (LAS float*)(lds + 34816) + wid * 2048;
#pragma unroll
    for (int sl = 0; sl < 4; ++sl) { const int jt = sl & 1, gg = 2 * gp + (sl >> 1);
        const bf16_t* vsrc = Zv + (t0 + 64 * jt + 16 * (wid & 3) + (lane >> 2)) * 256 + gg * 64 + (wid >> 2) * 32 + (lane & 3) * 8;
        glds16(vsrc, (unsigned)__builtin_amdgcn_readfirstlane(lds0 + sl * 8192 + wid * 1024)); }
    if (tid < 128) { const f32x4 v = *(const f32x4*)(ssv + (t0 + tid) * 4); rst[tid] = rsqrtf(((v[0] + v[1]) + (v[2] + v[3])) * (1.0f / 256.0f) + EPS); }
    asm volatile("s_waitcnt vmcnt(0) lgkmcnt(0)\n\ts_barrier" ::: "memory");
    f32x16 o0 = {}, o1 = {};
    const int njt = rb < 2 ? 1 : 2;
    for (int jt = 0; jt < njt; ++jt) {
        const bf16_t* wrow = Wm + (size_t)g * 16384 + (size_t)(32 * rb + r32) * 128 + 64 * jt + 4 * hi;
        float p0[16], p1[16];
#pragma unroll
        for (int rg = 0; rg < 4; ++rg) {
            const u32x2 w0 = *(const u32x2*)(wrow + 8 * rg), w1 = *(const u32x2*)(wrow + 8 * rg + 32);
            const f32x4 r0 = *(const LAS f32x4*)(rst + 64 * jt + 8 * rg + 4 * hi), r1 = *(const LAS f32x4*)(rst + 64 * jt + 8 * rg + 4 * hi + 32);
            p0[4 * rg] = bflo(w0.x) * r0[0]; p0[4 * rg + 1] = bfhi(w0.x) * r0[1]; p0[4 * rg + 2] = bflo(w0.y) * r0[2]; p0[4 * rg + 3] = bfhi(w0.y) * r0[3];
            p1[4 * rg] = bflo(w1.x) * r1[0]; p1[4 * rg + 1] = bfhi(w1.x) * r1[1]; p1[4 * rg + 2] = bflo(w1.y) * r1[2]; p1[4 * rg + 3] = bfhi(w1.y) * r1[3];
        }
        u32x4 pw0, pw1, pw2, pw3;
        pw0 = (u32x4){cvt_pk_bf16(p0[0], p0[1]), cvt_pk_bf16(p0[2], p0[3]), cvt_pk_bf16(p0[4], p0[5]), cvt_pk_bf16(p0[6], p0[7])};
        pw1 = (u32x4){cvt_pk_bf16(p0[8], p0[9]), cvt_pk_bf16(p0[10], p0[11]), cvt_pk_bf16(p0[12], p0[13]), cvt_pk_bf16(p0[14], p0[15])};
        pw2 = (u32x4){cvt_pk_bf16(p1[0], p1[1]), cvt_pk_bf16(p1[2], p1[3]), cvt_pk_bf16(p1[4], p1[5]), cvt_pk_bf16(p1[6], p1[7])};
        pw3 = (u32x4){cvt_pk_bf16(p1[8], p1[9]), cvt_pk_bf16(p1[10], p1[11]), cvt_pk_bf16(p1[12], p1[13]), cvt_pk_bf16(p1[14], p1[15])};
        const int vb = (int)(lds0 + (gi * 2 + jt) * 8192) + ((lane >> 4) & 1) * 32 + (lane & 3) * 8 + (4 * hi + ((lane & 15) >> 2)) * 64;
#pragma unroll
        for (int d0 = 0; d0 < 2; ++d0) { s16x4 vlo[4], vhi[4];
#pragma unroll
            for (int ks = 0; ks < 4; ++ks) {
                asm volatile("ds_read_b64_tr_b16 %0,%1 offset:%c2" : "=&v"(vlo[ks]) : "v"(vb), "i"(d0 * 4096 + ks * 1024) : "memory");
                asm volatile("ds_read_b64_tr_b16 %0,%1 offset:%c2" : "=&v"(vhi[ks]) : "v"(vb), "i"(d0 * 4096 + ks * 1024 + 512) : "memory"); }
            asm volatile("s_waitcnt lgkmcnt(0)" ::: "memory"); __builtin_amdgcn_sched_barrier(0);
#define SGU_PK(k) (bf16x8){vlo[k][0], vlo[k][1], vlo[k][2], vlo[k][3], vhi[k][0], vhi[k][1], vhi[k][2], vhi[k][3]}
            f32x16 oo = d0 == 0 ? o0 : o1;
            oo = __builtin_amdgcn_mfma_f32_32x32x16_bf16(__builtin_bit_cast(bf16x8, pw0), SGU_PK(0), oo, 0, 0, 0);
            oo = __builtin_amdgcn_mfma_f32_32x32x16_bf16(__builtin_bit_cast(bf16x8, pw1), SGU_PK(1), oo, 0, 0, 0);
            oo = __builtin_amdgcn_mfma_f32_32x32x16_bf16(__builtin_bit_cast(bf16x8, pw2), SGU_PK(2), oo, 0, 0, 0);
            oo = __builtin_amdgcn_mfma_f32_32x32x16_bf16(__builtin_bit_cast(bf16x8, pw3), SGU_PK(3), oo, 0, 0, 0);
#undef SGU_PK
            if (d0 == 0) o0 = oo; else o1 = oo;
        }
    }
    const float g0 = gn[g * 64 + r32], g1 = gn[g * 64 + 32 + r32];
#pragma unroll
    for (int r = 0; r < 16; ++r) { const int orow = crow(r, hi); const float bb = b_s[g * 128 + 32 * rb + orow];
        stg[orow * 64 + r32] = o0[r] * g0 + bb; stg[orow * 64 + 32 + r32] = o1[r] * g1 + bb; }
    asm volatile("s_waitcnt lgkmcnt(0)" ::: "memory");
#pragma unroll
    for (int i = 0; i < 4; ++i) { const int row = i * 8 + (lane >> 3), ch = lane & 7; const long t = t0 + 32 * rb + row;
        const f32x4 m0 = *(const LAS f32x4*)(stg + row * 64 + ch * 8), m1 = *(const LAS f32x4*)(stg + row * 64 + ch * 8 + 4);
        f32x4 ua, ub; unpack8(*(const u32x4*)(Zu + t * 256 + g * 64 + ch * 8), ua, ub);
        *(u32x4*)(Y + t * 1024 + 256 + g * 64 + ch * 8) = pack8(ua * m0, ub * m1); }
    asm volatile("s_waitcnt lgkmcnt(0)\n\ts_barrier" ::: "memory");
}
__device__ __forceinline__ void sgu_pool_phase(Frame& F, int l, bf16_t* Y) {
    for (int u = blockIdx.x; u < 4 * 64 * 2; u += F.G) sgu_unit(F, l, u >> 1, u & 1, Y);
    const bf16_t* Za = (const bf16_t*)(F.ws + WS_ZA);
    for (int it = blockIdx.x * 512 + opaque(F.tid); it < (M / 16) * 32; it += F.G * 512) {
        const int ch = it & 31, t0 = (it >> 5) * 16, w = 2 << (ch >> 3), s0 = t0 & (SEQ - 1);
        const bf16_t* zp = Za + (size_t)t0 * 256 + ch * 8;
        f32x4 sa = {0.f, 0.f, 0.f, 0.f}, sb = sa;
#pragma unroll
        for (int j = 1; j < 16; ++j) { if (j < w && j <= s0) { f32x4 a, b; unpack8(*(const u32x4*)(zp - (size_t)j * 256), a, b); sa += a; sb += b; } }
#pragma unroll
        for (int i = 0; i < 16; ++i) {
            f32x4 a, b; unpack8(*(const u32x4*)(zp + (size_t)i * 256), a, b); sa += a; sb += b;
            const int s = s0 + i; const int cnt = (s + 1 < w) ? s + 1 : w; const float ic = 1.0f / (float)cnt;
            *(u32x4*)(Y + (size_t)(t0 + i) * 1024 + ch * 8) = pack8(sa * ic - a, sb * ic - b);
            if (s + 1 >= w) { f32x4 oa, ob; unpack8(*(const u32x4*)(zp + ((ptrdiff_t)i + 1 - w) * 256), oa, ob); sa -= oa; sb -= ob; }
        }
    }
}

constexpr int NPH = 1 + 8 * DEPTH;
#ifndef PROBE_PHASE
#define PROBE_PHASE 0
#define PROBE_N 1
#endif
#ifndef PHMASK
#define PHMASK 0xFFFF
#endif
#define EN(b) ((PHMASK >> (b)) & 1)
__global__ void __launch_bounds__(512, 2) fwd(Args args) {
    extern __shared__ __attribute__((aligned(16))) unsigned char lds_raw[];
    Frame F;
    F.lds = (LAS unsigned char*)lds_raw; F.ws = args.ws; F.dout = (unsigned char*)args.out; F.ctl = (gu32*)(args.ws + WS_CTL); F.in = (inptr_t)__builtin_amdgcn_kernarg_segment_ptr();
    F.tid = threadIdx.x; F.lane = F.tid & 63; F.wave = __builtin_amdgcn_readfirstlane(F.tid >> 6); F.G = gridDim.x;
    F.gw = blockIdx.x * 8 + F.wave; F.NGW = F.G * 8;
    for (int u = F.tid; u < (LDS_BYTES - LDSCTL_OFF) / 4; u += 512) ((LAS unsigned*)(F.lds + LDSCTL_OFF))[u] = 0u;
    __syncthreads();
    XcdBarrier bar = xcd_barrier_post((unsigned*)(F.ctl + CW_BAR), (volatile LAS unsigned*)(F.lds + LDSCTL_OFF));
#define IN(k) true
#define SEAM(k) xcd_barrier(bar)
    for (int rp_ = 0, nr_ = (PROBE_PHASE == 9 ? args.rep_n : 1); rp_ < nr_; ++rp_) { if (rp_) xcd_barrier(bar);
    if (EN(0) && IN(0)) { prologue(F); prep_layer(F, 0); } }
    SEAM(0);
    unsigned char* const ws0 = F.ws; unsigned char* const do0 = F.dout; const inptr_t in0 = (inptr_t)__builtin_amdgcn_kernarg_segment_ptr();
    for (int l = 0; l < DEPTH; ++l) {
        const int pb = 1 + 8 * l;
#define OPQ() unsigned char* ws = ws0; unsigned char* dout = do0; inptr_t inq = in0; asm volatile("" : "+s"(ws), "+s"(dout), "+s"(inq)); F.ws = ws; F.dout = dout; F.in = inq; \
        bf16_t* Xc = (bf16_t*)(ws + (l == 0 ? WS_XA : WS_XB)); bf16_t* Xo = (bf16_t*)(ws + (l == 0 ? WS_XB : WS_XA)); \
        bf16_t* Y = (l == 0) ? Xo : (bf16_t*)(dout + DO_PY); float* ss1 = (float*)(ws + WS_SS1); \
        (void)Xc; (void)Xo; (void)Y; (void)ss1;
#define SETB(S) do { (S).ws = ws; (S).dout = dout; (S).l = l; } while (0)
        for (int rp_ = 0, nr_ = (PROBE_PHASE == 1 ? args.rep_n : 1); rp_ < nr_; ++rp_) { if (rp_) xcd_barrier(bar);
        if (EN(1) && IN(pb + 0)) { OPQ();
            InGemm S; SETB(S); S.inq = inq; S.a_base = (const char*)Xc; S.lda = 2048; S.b_base = (const char*)(ws + WS_WIN); S.ldb = 2048; S.nt = 16; S.ord.init(M, 768, F.G, blockIdx.x); S.pn_off = 0; S.gsc = 1.f;
            g8::gemm_phase(F.lds, S);
            S.a_base = (const char*)(ws + WS_X8); S.lda = 1024; S.b_base = (const char*)(ws + WS_WIN8); S.ldb = 1024; S.nt = 8; S.ord.init(M, 4608, F.G, blockIdx.x); S.pn_off = 3; S.gsc = INV_S8;
            g8::gemm_phase<InGemm, false, true>(F.lds, S);
        }
        }
        SEAM(pb + 0);
        for (int rp_ = 0, nr_ = (PROBE_PHASE == 2 ? args.rep_n : 1); rp_ < nr_; ++rp_) { if (rp_) xcd_barrier(bar);
        if (EN(2) && IN(pb + 1)) { OPQ(); att::attn_phase(F, l, Y); sgu_pool_phase(F, l, Y); }
        }
        SEAM(pb + 1);
        for (int rp_ = 0, nr_ = (PROBE_PHASE == 3 ? args.rep_n : 1); rp_ < nr_; ++rp_) { if (rp_) xcd_barrier(bar);
        if (EN(3) && IN(pb + 2)) { OPQ();
            BranchGemm S; SETB(S); S.a_base = (const char*)Y; S.lda = 2048; S.b_base = (const char*)(ws + WS_WBR); S.ldb = 2048; S.nt = 16; S.ord.init(M, D, F.G, blockIdx.x);
            g8::gemm_phase<BranchGemm, true>(F.lds, S);
        }
        }
        SEAM(pb + 2);
        for (int rp_ = 0, nr_ = (PROBE_PHASE == 4 ? args.rep_n : 1); rp_ < nr_; ++rp_) { if (rp_) xcd_barrier(bar);
        if (EN(4) && IN(pb + 3)) { OPQ();
            OutGemm S; SETB(S); S.a_base = (const char*)(ws + WS_MERGED); S.lda = 2048; S.b_base = (const char*)(ws + WS_WOUT); S.ldb = 2048; S.nt = 16; S.ord.init(M, D, F.G, blockIdx.x);
            S.alpha = rp_ ? 0.f : 1.f; g8::gemm_phase(F.lds, S);
        }
        }
        SEAM(pb + 3);
        for (int rp_ = 0, nr_ = (PROBE_PHASE == 5 ? args.rep_n : 1); rp_ < nr_; ++rp_) { if (rp_) xcd_barrier(bar);
        if (EN(5) && IN(pb + 4)) { OPQ(); router_phase(F, l, Xc, ss1, rp_ > 0); }
        }
        SEAM(pb + 4);
        for (int rp_ = 0, nr_ = (PROBE_PHASE == 6 ? args.rep_n : 1); rp_ < nr_; ++rp_) { if (rp_) xcd_barrier(bar);
        if (EN(6) && IN(pb + 5)) { OPQ();
            gu32* cnt = (gu32*)(ws + WS_CTL) + CW_CNT + (size_t)l * 160 * 64;
            build_class_tables(F, cnt, NEXP);
            Moe1Gemm S; S.ws = ws; S.dout = dout; S.a_base = (const char*)(ws + WS_X8); S.lda = 1024; S.b_base = (const char*)(ws + WS_WEIN); S.ldb = 1024; S.nt = 8; S.G = F.G; S.c = blockIdx.x;
            S.tpre = (const LAS int*)(F.lds + LT_PRE); S.ccnt = (const LAS int*)(F.lds + LT_CNT);
            const int tot1 = S.tpre[NEXP];
            g8::gemm_phase<Moe1Gemm, false, true>(F.lds, S);
            StoreGemm P; SETB(P); P.a_base = (const char*)(ws + WS_PB); P.lda = 512; P.b_base = (const char*)(ws + WS_WPLE + (size_t)l * MiB); P.ldb = 512; P.nt = 4;
            { const int extra = (tot1 > F.G && tot1 < 2 * F.G) ? tot1 - F.G : 0; P.nfree = F.G - extra; P.rank = (int)blockIdx.x - extra; P.nunits = (M / 256) * 4; }
            g8::gemm_phase(F.lds, P);
        }
        }
        SEAM(pb + 5);
        for (int rp_ = 0, nr_ = (PROBE_PHASE == 7 ? args.rep_n : 1); rp_ < nr_; ++rp_) { if (rp_) xcd_barrier(bar);
        if (EN(7) && IN(pb + 6)) { OPQ();
            gu32* cnt = (gu32*)(ws + WS_CTL) + CW_CNT + (size_t)l * 160 * 64 + 32 * 64;
            build_class_tables(F, cnt, NPAIR);
            Moe2Gemm S; S.ws = ws; S.dout = dout; S.l = l; S.a_base = (const char*)(ws + WS_H); S.lda = 512; S.b_base = (const char*)(ws + WS_WEOUT); S.ldb = 256; S.nt = 4; S.G = F.G; S.c = blockIdx.x;
            S.alpha = rp_ ? 0.f : 1.f;
            S.tpre = (const LAS int*)(F.lds + LT_PRE); S.ccnt = (const LAS int*)(F.lds + LT_CNT);
            g8::gemm_phase(F.lds, S);
        }
        }
        SEAM(pb + 6);
        for (int rp_ = 0, nr_ = (PROBE_PHASE == 8 ? args.rep_n : 1); rp_ < nr_; ++rp_) { if (rp_) xcd_barrier(bar);
        if (EN(8) && IN(pb + 7)) { OPQ();
            if (l + 1 < DEPTH) { prep_layer(F, l + 1); __syncthreads(); }
            PleGemm S; SETB(S); S.a_base = (const char*)(ws + WS_X8P); S.lda = 1024; S.b_base = (const char*)(ws + WS_WGATE + (size_t)l * 2 * MiB); S.ldb = 1024; S.nt = 8; S.ord.init(M, D, F.G, blockIdx.x);
            S.lastl = (l == DEPTH - 1); S.gsc = INV_S8;
            g8::gemm_phase<PleGemm, false, true>(F.lds, S);
        }
        }
        if (l + 1 < DEPTH) SEAM(pb + 7);
    }
#undef SETB
#undef OPQ
#undef IN
#undef SEAM
}

#ifndef N_LAUNCHES
#define N_LAUNCHES 1
#endif
extern "C" void kernel_launch(void* const* d_in, const int* in_sizes, int n_in, void* d_out, int out_size, void* d_ws, size_t ws_size, hipStream_t stream) {
    static int grid = 0;
    if (grid == 0) {
        if (n_in != 27 || out_size != M * D || ws_size < WS_END) { fprintf(stderr, "kernel_launch: unexpected shapes (n_in %d out %d ws %zu)\n", n_in, out_size, ws_size); grid = -1; return; }
        int dev = 0, cus = 0;
        if (hipGetDevice(&dev) != hipSuccess || hipDeviceGetAttribute(&cus, hipDeviceAttributeMultiprocessorCount, dev) != hipSuccess) { grid = -1; return; }
        if (hipFuncSetAttribute((const void*)fwd, hipFuncAttributeMaxDynamicSharedMemorySize, LDS_BYTES) != hipSuccess) { fprintf(stderr, "kernel_launch: hipFuncSetAttribute failed\n"); grid = -1; return; }
        int per_cu = 0;
        if (hipOccupancyMaxActiveBlocksPerMultiprocessor(&per_cu, (const void*)fwd, 512, LDS_BYTES) != hipSuccess || per_cu < 1) fprintf(stderr, "kernel_launch: occupancy query says %d\n", per_cu);
        (void)hipGetLastError();
        grid = cus;
    }
    if (grid < 0) return;
    (void)hipMemsetAsync((char*)d_ws + WS_CTL, 0, CTL_ZERO_BYTES, stream);
    Args a{};
    for (int i = 0; i < 27; ++i) a.in[i] = (const float*)d_in[i];
    a.out = (float*)d_out; a.ws = (unsigned char*)d_ws; a.rep_n = PROBE_N;
    hipLaunchKernelGGL(fwd, dim3(grid), dim3(512), LDS_BYTES, stream, a);
}
```

```cpp
#include <hip/hip_runtime.h>
#include <cstdio>
#include <cstdint>

#define LAS __attribute__((address_space(3)))
#define GAS __attribute__((address_space(1)))
typedef unsigned short bf16_t;
typedef short bf16x8 __attribute__((ext_vector_type(8)));
typedef float f32x4 __attribute__((ext_vector_type(4)));
typedef float f32x2 __attribute__((ext_vector_type(2)));
typedef unsigned u32x4 __attribute__((ext_vector_type(4)));
typedef unsigned u32x2 __attribute__((ext_vector_type(2)));
typedef GAS unsigned gu32;
typedef const float* const __attribute__((address_space(4)))* inptr_t;

constexpr int M = 32768, D = 1024, SEQ = 8192, NIN = 5376, DEPTH = 2, PLE = 256;
constexpr int NEXP = 32, DEXP = 128, NPAIR = 112, CAP = 32768;
constexpr float EPS = 1e-6f;
constexpr float LOG2E = 1.4426950408889634f;
constexpr float C2 = 0.125f * LOG2E;

constexpr size_t MiB = 1u << 20;
constexpr size_t WS_CTL = 0, CTL_ZERO_BYTES = 1 * MiB;
constexpr size_t WS_MISC = 1 * MiB;
constexpr size_t MISC_ATTM = 0, MISC_GQK = 1024, MISC_TB = 4096, MISC_TOKE = 32768, MISC_TOKW = 196608, MISC_WM = 524288;
constexpr size_t WS_WR = 2 * MiB, WR_BIAS = 896 * 1024;
constexpr size_t WS_SSX = 3 * MiB, WS_SS1 = 5 * MiB, WS_SS2 = 7 * MiB, WS_SSV = 9 * MiB;
constexpr size_t WS_WGATE = 10 * MiB, WS_WPLE = 14 * MiB;
constexpr size_t WS_WIN = 16 * MiB, WS_WBR = 27 * MiB, WS_WOUT = 29 * MiB, WS_WEIN = 31 * MiB, WS_WEOUT = 47 * MiB;
constexpr size_t WS_PB = 58 * MiB;
constexpr size_t WS_XA = 74 * MiB, WS_XB = 138 * MiB;
constexpr size_t WS_ZA = 202 * MiB, WS_ZU = 218 * MiB, WS_ZV = 234 * MiB, WS_V = 250 * MiB, WS_G = 282 * MiB;
constexpr size_t WS_MERGED = 202 * MiB, WS_H = 202 * MiB, WS_ELIST = 218 * MiB, WS_PLIST = 222 * MiB;
constexpr size_t WS_WIN8 = 21 * MiB;
constexpr size_t WS_X8 = 474 * MiB, WS_X8P = 236 * MiB;
constexpr size_t WS_END = 506 * MiB;
constexpr float SX8 = 8.0f, SW8 = 64.0f, INV_S8 = 1.0f / (8.0f * 64.0f);
constexpr size_t DO_PY = 0, DO_Q = 64 * MiB, DO_K = 96 * MiB;
constexpr int CW_TMO = 0, CW_BAR = 4096, CW_CNT = 16384;

constexpr int LDS_BYTES = 152576;
constexpr int LDSCTL_OFF = 152576 - 2048;

__device__ __forceinline__ float bflo(unsigned w) { return __uint_as_float(w << 16); }
__device__ __forceinline__ float bfhi(unsigned w) { return __uint_as_float(w & 0xffff0000u); }
__device__ __forceinline__ float bf2f(bf16_t h) { return __uint_as_float((unsigned)h << 16); }
typedef __bf16 bf16x2_t __attribute__((ext_vector_type(2)));
__device__ __forceinline__ unsigned cvt_pk_bf16(float lo, float hi) { const f32x2 v = {lo, hi}; const bf16x2_t b = __builtin_convertvector(v, bf16x2_t); return __builtin_bit_cast(unsigned, b); }
__device__ __forceinline__ bf16_t f2bf(float f) { return (bf16_t)(cvt_pk_bf16(f, 0.f) & 0xffffu); }
__device__ __forceinline__ u32x2 pack8_fp8(f32x4 a, f32x4 b, float sc) {
    int lo = __builtin_amdgcn_cvt_pk_fp8_f32(a[0] * sc, a[1] * sc, 0, false); lo = __builtin_amdgcn_cvt_pk_fp8_f32(a[2] * sc, a[3] * sc, lo, true);
    int hi = __builtin_amdgcn_cvt_pk_fp8_f32(b[0] * sc, b[1] * sc, 0, false); hi = __builtin_amdgcn_cvt_pk_fp8_f32(b[2] * sc, b[3] * sc, hi, true);
    return (u32x2){(unsigned)lo, (unsigned)hi}; }
__device__ __forceinline__ float fast_rcp(float x) { return __builtin_amdgcn_rcpf(x); }
__device__ __forceinline__ float fast_exp2(float x) { return __builtin_amdgcn_exp2f(x); }
__device__ __forceinline__ float gelu_t(float x) { const float u = x + 0.044715f * x * x * x; return x * fast_rcp(1.f + fast_exp2(-2.302208198f * u)); }
__device__ __forceinline__ float sigmoid_f(float x) { return fast_rcp(1.f + fast_exp2(-LOG2E * x)); }
__device__ __forceinline__ float silu_f(float x) { return x * sigmoid_f(x); }
__device__ __forceinline__ int hw_lane() { return (int)__builtin_amdgcn_mbcnt_hi(~0u, __builtin_amdgcn_mbcnt_lo(~0u, 0u)); }
__device__ __forceinline__ int opaque(int v) { asm volatile("" : "+v"(v)); return v; }
__device__ __forceinline__ float wave_sum(float v) {
#pragma unroll
    for (int o = 1; o < 64; o <<= 1) v += __shfl_xor(v, o);
    return v;
}
__device__ __forceinline__ u32x4 pack8(f32x4 a, f32x4 b) { u32x4 w; w.x = cvt_pk_bf16(a[0], a[1]); w.y = cvt_pk_bf16(a[2], a[3]); w.z = cvt_pk_bf16(b[0], b[1]); w.w = cvt_pk_bf16(b[2], b[3]); return w; }
__device__ __forceinline__ void unpack8(u32x4 w, f32x4& a, f32x4& b) { a = (f32x4){bflo(w.x), bfhi(w.x), bflo(w.y), bfhi(w.y)}; b = (f32x4){bflo(w.z), bfhi(w.z), bflo(w.w), bfhi(w.w)}; }
__device__ __forceinline__ float sq4(f32x4 a) { return (a[0] * a[0] + a[1] * a[1]) + (a[2] * a[2] + a[3] * a[3]); }
__device__ __forceinline__ float sqpk(u32x4 w) { f32x4 a, b; unpack8(w, a, b); return sq4(a) + sq4(b); }

namespace g8 {
constexpr int BM = 256, BK = 64, HALF = 128, HTB = HALF * BK * 2, STAGE_BYTES = 8 * HTB, NXCD = 8, WGM = 8;
__host__ __device__ __forceinline__ int lds_byte(int r, int c) { const int st = (r >> 4) * 2 + (c >> 5), rr = r & 15, cc = c & 31, ob = rr * 64 + cc * 2; return st * 1024 + (ob ^ (((ob >> 9) & 1) << 5)); }
__host__ __device__ __forceinline__ void stage_rc(int b, int& R, int& C) { const int st = b / 1024, sb = b % 1024, swz = sb ^ (((sb >> 9) & 1) << 5); R = (st >> 1) * 16 + swz / 64; C = (st & 1) * 32 + (swz % 64) / 2; }
__host__ __device__ __forceinline__ int perm32(int rho) { const int n = rho >> 4, i = rho & 15; return 8 * (i >> 2) + 4 * n + (i & 3); }

struct Unit { int pm, pn; };
struct StaticOrder {
    int nM, nN, nwg, G, c;
    __device__ void init(int Mr, int N, int G_, int c_) { nM = Mr / BM; nN = N / BM; nwg = nM * nN; G = G_; c = c_; }
    __device__ bool next(int i, Unit& u) const { return map((long)i * G + c, u); }
    __device__ bool map(long L, Unit& u) const {
        if (L >= nwg) return false;
        int wgid = (int)L; { const int q = nwg / NXCD, r = nwg % NXCD, xcd = wgid % NXCD, off = wgid / NXCD; wgid = (xcd < r ? xcd * (q + 1) : r * (q + 1) + (xcd - r) * q) + off; }
        const int nig = WGM * nN, gid = wgid / nig, fm = gid * WGM, gsz = (nM - fm) < WGM ? (nM - fm) : WGM;
        u.pm = fm + ((wgid % nig) % gsz); u.pn = (wgid % nig) / gsz; return true;
    }
};
struct DenseBase {
    typedef g8::Unit Unit;
    const char* a_base; unsigned lda; const char* b_base; unsigned ldb; int nt; StaticOrder ord;
    unsigned char* ws; unsigned char* dout; inptr_t inq; int l;
    __device__ __forceinline__ bool next(int i, Unit& u) const { return ord.next(i, u); }
    static constexpr bool GATHER = false;
    __device__ __forceinline__ void a_off(const Unit&, const int (&)[2], const int (&)[2], unsigned (&)[2][2]) const {}
    __device__ __forceinline__ const char* a_tile(const Unit& u) const { return a_base + (size_t)u.pm * BM * lda; }
    __device__ __forceinline__ const char* b_tile(const Unit& u, int kt) const { return b_base + (size_t)u.pn * BM * ldb + (size_t)kt * (BK * 2); }
    __device__ __forceinline__ void mid(f32x4 (&)[2][2][4][2], const Unit&, int, int, int, int, int) const {}
    static constexpr bool EPC = false;
    __device__ __forceinline__ void epc_issue(const Unit&, LAS unsigned char*, int, int) const {}
};

template <class P, bool HOOK = false, bool FP8 = false>
__device__ __forceinline__ void gemm_phase(LAS unsigned char* lds, const P& S, const int wv  ) {
    typedef int v8i __attribute__((ext_vector_type(8))); typedef int v4i __attribute__((ext_vector_type(4)));
    typedef typename P::Unit Unit;
    int wid = wv; asm volatile("" : "+s"(wid));
    const int lane = opaque(hw_lane()), tid = wid * 64 + lane, wr = wid >> 2, wc = wid & 3, fr = lane & 15, fq = lane >> 4;
    const int nt = S.nt;
    int R[2], C[2]; unsigned voffB[2];
#pragma unroll
    for (int i = 0; i < 2; ++i) { stage_rc(tid * 16 + i * 8192, R[i], C[i]); const int Rb = P::PERM ? ((R[i] & ~31) + perm32(R[i] & 31)) : R[i]; voffB[i] = (unsigned)Rb * S.ldb + (unsigned)C[i] * 2u; }
    const size_t hstepB = (size_t)HALF * S.ldb;
    unsigned voffA[2] = {0u, 0u}; size_t hstepA = 0;
    if constexpr (!P::GATHER) { hstepA = (size_t)HALF * S.lda;
#pragma unroll
        for (int i = 0; i < 2; ++i) voffA[i] = (unsigned)R[i] * S.lda + (unsigned)C[i] * 2u; }
    const unsigned ldsw = (unsigned)wid * 1024u;
    const int aoff = lds_byte(wr * 64 + fr, fq * 8), boff = lds_byte(wc * 32 + fr, fq * 8);
    const char* const Ab = S.a_base;
#define G8_SA(b, h) (((b) * 2 + (h)) * HTB)
#define G8_SB(b, h) ((4 + (b) * 2 + (h)) * HTB)
#define G8_STAGE_A(bufoff, sel, h, kt) do { if constexpr (P::GATHER) { _Pragma("unroll") for (int _i = 0; _i < 2; ++_i) \
        __builtin_amdgcn_global_load_lds((const unsigned*)(Ab + (size_t)((sel) ? no[h][_i] : co[h][_i]) + (size_t)(kt) * (BK * 2)), (LAS unsigned*)(lds + (bufoff) + ldsw + _i * 8192), 16, 0, 0); } \
      else { const char* _g = ((sel) ? nA : cA) + (size_t)(h) * hstepA + (size_t)(kt) * (BK * 2); _Pragma("unroll") for (int _i = 0; _i < 2; ++_i) \
        __builtin_amdgcn_global_load_lds((const unsigned*)(_g + voffA[_i]), (LAS unsigned*)(lds + (bufoff) + ldsw + _i * 8192), 16, 0, 0); } } while (0)
#define G8_STAGE_B(bufoff, gbase) do { _Pragma("unroll") for (int _i = 0; _i < 2; ++_i) \
        __builtin_amdgcn_global_load_lds((const unsigned*)((const char*)(gbase) + voffB[_i]), (LAS unsigned*)(lds + (bufoff) + ldsw + _i * 8192), 16, 0, 0); } while (0)
#define G8_LDA(dst, b, h) do { if constexpr (FP8) { _Pragma("unroll") for (int m = 0; m < 4; ++m) { dst##8[m].lo = *(const LAS v4i*)(lds + G8_SA(b, h) + aoff + m * 2048); dst##8[m].hi = *(const LAS v4i*)(lds + G8_SA(b, h) + aoff + m * 2048 + 1024); } } \
      else { _Pragma("unroll") for (int m = 0; m < 4; ++m) _Pragma("unroll") for (int k = 0; k < 2; ++k) dst[m][k] = *(const LAS bf16x8*)(lds + G8_SA(b, h) + aoff + m * 2048 + k * 1024); } } while (0)
#define G8_LDB(dst, b, h) do { if constexpr (FP8) { _Pragma("unroll") for (int n = 0; n < 2; ++n) { dst##8[n].lo = *(const LAS v4i*)(lds + G8_SB(b, h) + boff + n * 2048); dst##8[n].hi = *(const LAS v4i*)(lds + G8_SB(b, h) + boff + n * 2048 + 1024); } } \
      else { _Pragma("unroll") for (int n = 0; n < 2; ++n) _Pragma("unroll") for (int k = 0; k < 2; ++k) dst[n][k] = *(const LAS bf16x8*)(lds + G8_SB(b, h) + boff + n * 2048 + k * 1024); } } while (0)
#define G8_MMA(ai, bj, At, Bt) do { __builtin_amdgcn_s_setprio(1); if constexpr (FP8) { _Pragma("unroll") for (int m = 0; m < 4; ++m) _Pragma("unroll") for (int n = 0; n < 2; ++n) \
        asm volatile("v_mfma_f32_16x16x128_f8f6f4 %0, %1, %2, %0" : "+v"(acc[ai][bj][m][n]) : "v"(Bt##8[n]), "v"(At##8[m])); } \
      else { _Pragma("unroll") for (int m = 0; m < 4; ++m) _Pragma("unroll") for (int n = 0; n < 2; ++n) _Pragma("unroll") for (int k = 0; k < 2; ++k) \
        acc[ai][bj][m][n] = __builtin_amdgcn_mfma_f32_16x16x32_bf16(Bt[n][k], At[m][k], acc[ai][bj][m][n], 0, 0, 0); } __builtin_amdgcn_s_setprio(0); } while (0)
#define G8_WAIT_V(n) asm volatile("s_waitcnt vmcnt(" #n ")" ::: "memory")
#define G8_WAIT_L(n) asm volatile("s_waitcnt lgkmcnt(" #n ")" ::: "memory")
#define G8_BAR __builtin_amdgcn_s_barrier()
#define G8_SCHED __builtin_amdgcn_sched_barrier(0)
    Unit cur, nxt; int ui = 0;
    if (!S.next(0, cur)) return;
    unsigned co[2][2], no[2][2];
    S.a_off(cur, R, C, co);
    const char* cA = nullptr; const char* nA = nullptr;
    if constexpr (!P::GATHER) { cA = S.a_tile(cur); nA = cA; }
    f32x4 acc[2][2][4][2];
#pragma unroll
    for (int a = 0; a < 2; ++a)
#pragma unroll
        for (int b = 0; b < 2; ++b)
#pragma unroll
            for (int m = 0; m < 4; ++m)
#pragma unroll
                for (int n = 0; n < 2; ++n) acc[a][b][m][n] = (f32x4){0.f, 0.f, 0.f, 0.f};
    bf16x8 At[4][2], B0[2][2], B1[2][2]; v8i At8[4], B08[2], B18[2];
    {
        const char* b0 = S.b_tile(cur, 0); const char* b1 = S.b_tile(cur, 1);
        G8_STAGE_B(G8_SB(0, 0), b0); G8_STAGE_B(G8_SB(0, 1), b0 + hstepB); G8_STAGE_A(G8_SA(0, 0), false, 0, 0); G8_STAGE_A(G8_SA(0, 1), false, 1, 0);
        if (wr == 1) G8_BAR;
        G8_WAIT_V(2); G8_BAR;
        G8_STAGE_B(G8_SB(1, 0), b1); G8_STAGE_A(G8_SA(1, 0), false, 0, 1); G8_STAGE_B(G8_SB(1, 1), b1 + hstepB);
        G8_WAIT_V(6); G8_BAR;
    }
    for (;;) {
        const bool has_next = S.next(ui + 1, nxt);
        if (!has_next) nxt = cur;
        S.a_off(nxt, R, C, no);
        if constexpr (!P::GATHER) nA = S.a_tile(nxt);
        for (int t = 0; t < nt; t += 2) {
            const bool last = (t == nt - 2);
            if constexpr (P::EPC) { if (last) S.epc_issue(cur, lds + STAGE_BYTES, wid, lane); }
            const int k2 = last ? 0 : t + 2, k3 = k2 + 1;
            const char* b2 = last ? S.b_tile(nxt, 0) : S.b_tile(cur, t + 2);
            const char* b3 = last ? S.b_tile(nxt, 1) : S.b_tile(cur, t + 3);
            G8_LDB(B0, 0, 0); G8_LDB(B1, 0, 1); G8_SCHED; G8_LDA(At, 0, 0); G8_STAGE_A(G8_SA(1, 1), false, 1, t + 1);
            G8_WAIT_V(8); G8_WAIT_L(0); G8_BAR; G8_MMA(0, 0, At, B0); G8_MMA(0, 1, At, B1); G8_BAR; G8_SCHED;
            G8_LDA(At, 0, 1); G8_STAGE_B(G8_SB(0, 0), b2); G8_STAGE_B(G8_SB(0, 1), b2 + hstepB); G8_STAGE_A(G8_SA(0, 0), last, 0, k2);
            G8_WAIT_V(8); G8_WAIT_L(0); G8_BAR; G8_MMA(1, 0, At, B0); G8_MMA(1, 1, At, B1); G8_BAR; G8_SCHED;
            G8_LDB(B0, 1, 0); G8_LDB(B1, 1, 1); G8_SCHED; G8_LDA(At, 1, 0); G8_STAGE_A(G8_SA(0, 1), last, 1, k2);
            G8_WAIT_V(8); G8_WAIT_L(0); G8_BAR; G8_MMA(0, 0, At, B0); G8_MMA(0, 1, At, B1); G8_BAR; G8_SCHED;
            G8_LDA(At, 1, 1); G8_STAGE_B(G8_SB(1, 0), b3); G8_STAGE_B(G8_SB(1, 1), b3 + hstepB); G8_STAGE_A(G8_SA(1, 0), last, 0, k3);
            G8_WAIT_V(8); G8_WAIT_L(0); G8_BAR; G8_MMA(1, 0, At, B0); G8_MMA(1, 1, At, B1); G8_BAR; G8_SCHED;
            if constexpr (HOOK) { if (!last) S.mid(acc, cur, t + 2, wr, wc, fr, fq); }
        }
        if constexpr (FP8) asm volatile("s_nop 15\n\ts_nop 15" ::: "memory");
        if (wr == 0) G8_BAR;
        if constexpr (P::EPC) G8_BAR;
        S.epi(acc, cur, wr, wc, fr, fq);
        if (!has_next) break;
#pragma unroll
        for (int a = 0; a < 2; ++a)
#pragma unroll
            for (int b = 0; b < 2; ++b)
#pragma unroll
                for (int m = 0; m < 4; ++m)
#pragma unroll
                    for (int n = 0; n < 2; ++n) acc[a][b][m][n] = (f32x4){0.f, 0.f, 0.f, 0.f};
        cur = nxt; cA = nA;
#pragma unroll
        for (int h = 0; h < 2; ++h)
#pragma unroll
            for (int i = 0; i < 2; ++i) co[h][i] = no[h][i];
        ++ui;
        if (wr == 1) G8_BAR;
    }
    G8_WAIT_V(0);
    G8_BAR;
#undef G8_SA
#undef G8_SB
#undef G8_STAGE_A
#undef G8_STAGE_B
#undef G8_LDA
#undef G8_LDB
#undef G8_MMA
#undef G8_WAIT_V
#undef G8_WAIT_L
#undef G8_BAR
#undef G8_SCHED
}
}

__device__ __forceinline__ float rstd_from(const float* ss, int row, int fq) {
    const f32x4 v = *(const f32x4*)(ss + (size_t)row * 16 + fq * 4);
    float s = (v[0] + v[1]) + (v[2] + v[3]); s += __shfl_xor(s, 16); s += __shfl_xor(s, 32);
    return rsqrtf(s * (1.0f / D) + EPS);
}
__device__ __forceinline__ void rstd8(const float* ss, const int (&rows)[2][4], int fq, float (&rs)[2][4]) {
    f32x4 v[2][4];
#pragma unroll
    for (int ai = 0; ai < 2; ++ai)
#pragma unroll
        for (int m = 0; m < 4; ++m) v[ai][m] = *(const f32x4*)(ss + (size_t)rows[ai][m] * 16 + fq * 4);
#pragma unroll
    for (int ai = 0; ai < 2; ++ai)
#pragma unroll
        for (int m = 0; m < 4; ++m) { float s = (v[ai][m][0] + v[ai][m][1]) + (v[ai][m][2] + v[ai][m][3]); s += __shfl_xor(s, 16); s += __shfl_xor(s, 32); rs[ai][m] = rsqrtf(s * (1.0f / D) + EPS); }
}
__device__ __forceinline__ void rows8(int row0, int (&rows)[2][4]) {
#pragma unroll
    for (int ai = 0; ai < 2; ++ai)
#pragma unroll
        for (int m = 0; m < 4; ++m) rows[ai][m] = row0 + ai * 128 + m * 16;
}
__device__ __forceinline__ size_t gate_off(int pm, int k, int pn, int wid, int lane) { return ((((size_t)pm * 3 + k) * 4 + pn) * 8 + wid) * 8192 + (size_t)lane * 8; }
#define GATE_EL(ai, m, bj) ((((ai) * 4 + (m)) * 2 + (bj)) * 512)
__device__ __forceinline__ u32x2 pack8_u8(f32x4 a, f32x4 b) {
    unsigned lo = 0, hi = 0;
#pragma unroll
    for (int j = 0; j < 4; ++j) { lo = __builtin_amdgcn_cvt_pk_u8_f32(fmaxf(__builtin_rintf(a[j] * 255.0f), 1.0f), j, lo); hi = __builtin_amdgcn_cvt_pk_u8_f32(fmaxf(__builtin_rintf(b[j] * 255.0f), 1.0f), j, hi); }
    return (u32x2){lo, hi}; }
__device__ __forceinline__ void unpack8_u8(u32x2 w, f32x4& a, f32x4& b) {
    a = (f32x4){(float)(w.x & 255u), (float)((w.x >> 8) & 255u), (float)((w.x >> 16) & 255u), (float)(w.x >> 24)};
    b = (f32x4){(float)(w.y & 255u), (float)((w.y >> 8) & 255u), (float)((w.y >> 16) & 255u), (float)(w.y >> 24)}; }

typedef f32x4 Acc[2][2][4][2];
struct InGemm : g8::DenseBase {
    static constexpr bool PERM = true, EPC = true;
    __device__ __forceinline__ void epc_issue(const Unit& u, LAS unsigned char* epc, int wid, int lane) const {
        unsigned long long z_ = 0; asm volatile("" : "+s"(z_)); unsigned char* w_ = ws + z_;
        const float* ssx = (const float*)(w_ + WS_SSX) + (size_t)u.pm * 256 * 16;
#pragma unroll
        for (int i = 0; i < 2; ++i) __builtin_amdgcn_global_load_lds((const unsigned*)(ssx + ((wid * 2 + i) * 64 + lane) * 4), (LAS unsigned*)(epc + (wid * 2 + i) * 1024), 16, 0, 0);
        if (wid == 0) { const int pn = u.pn + pn_off; const float* cb;
            if (pn >= 9) { inptr_t in_ = inq; asm volatile("" : "+s"(in_)); cb = in_[12] + (size_t)l * 3072 + (pn - 9) * 256; }
            else cb = (const float*)(w_ + WS_MISC + MISC_GQK) + l * 128 + ((pn >= 5) ? 64 : 0);
            __builtin_amdgcn_global_load_lds((const unsigned*)(cb + lane * 4), (LAS unsigned*)(epc + 16384), 16, 0, 0); }
    }
    LAS unsigned char* epc;
    int pn_off; float gsc;
    __device__ __forceinline__ bool next(int i, Unit& u) const {
        if (pn_off == 0 || ord.G != 256) return ord.next(i, u);
        if (i < 8) return ord.map((long)i * 256 + ord.c, u);
        if (ord.c >= 128 && i < 10) return ord.map(2048 + (long)(ord.c - 128) * 2 + (i - 8), u);
        return false;
    }
    __device__ __forceinline__ void epi(Acc& acc, const Unit& u, int wr, int wc, int fr, int fq) const {
        fr = opaque(fr); fq = opaque(fq);
        unsigned long long z_ = 0; asm volatile("" : "+s"(z_)); unsigned char* w_ = ws + z_; unsigned char* d_ = dout + z_;
        bf16_t* Z3 = (bf16_t*)(w_ + WS_ZA); bf16_t* QK = (bf16_t*)(d_ + DO_Q); bf16_t* V = (bf16_t*)(w_ + WS_V); bf16_t* G = (bf16_t*)(w_ + WS_G);
        float* ssv = (float*)(w_ + WS_SSV);
        const int row0 = opaque(u.pm * 256 + wr * 64 + fr), pn = u.pn + pn_off, cl = wc * 32 + fq * 8;
        int rows[2][4]; rows8(row0, rows); float rs[2][4];
        { const LAS f32x4* sp = (const LAS f32x4*)epc + (wr * 64 + fr) * 4 + fq; f32x4 v[2][4];
#pragma unroll
            for (int ai = 0; ai < 2; ++ai)
#pragma unroll
                for (int m = 0; m < 4; ++m) v[ai][m] = sp[(ai * 128 + m * 16) * 4];
#pragma unroll
            for (int ai = 0; ai < 2; ++ai)
#pragma unroll
                for (int m = 0; m < 4; ++m) { float s_ = (v[ai][m][0] + v[ai][m][1]) + (v[ai][m][2] + v[ai][m][3]); s_ += __shfl_xor(s_, 16); s_ += __shfl_xor(s_, 32); rs[ai][m] = rsqrtf(s_ * (1.0f / D) + EPS); } }
        const LAS float* cbl = (const LAS float*)(epc + 16384);
        if (pn_off) {
#pragma unroll
            for (int ai = 0; ai < 2; ++ai)
#pragma unroll
                for (int m = 0; m < 4; ++m) rs[ai][m] *= gsc;
        }
        if (pn <= 2) {
            bf16_t* O = Z3 + (size_t)pn * ((size_t)M * 256);
#pragma unroll
            for (int ai = 0; ai < 2; ++ai)
#pragma unroll
                for (int m = 0; m < 4; ++m) {
                    const int row = rows[ai][m]; const float r = rs[ai][m]; float sq = 0.f;
#pragma unroll
                    for (int bj = 0; bj < 2; ++bj) {
                        f32x4 a = acc[ai][bj][m][0] * r, b = acc[ai][bj][m][1] * r;
                        if (pn >= 1) {
#pragma unroll
                            for (int j = 0; j < 4; ++j) { a[j] = gelu_t(a[j]); b[j] = gelu_t(b[j]); }
                        }
                        const u32x4 w = pack8(a, b); sq += sqpk(w);
                        *(u32x4*)(O + (size_t)row * 256 + bj * 128 + cl) = w;
                    }
                    if (pn == 2) { sq += __shfl_xor(sq, 16); sq += __shfl_xor(sq, 32); if (fq == 0) ssv[(size_t)row * 4 + wc] = sq; }
                }
        } else if (pn <= 6) {
            const bool isq = pn <= 4; const LAS float* gg = cbl; bf16_t* O = QK + (isq ? (size_t)0 : (size_t)M * 512);
            const int head = 4 * ((pn - 3) & 1) + wc;
            f32x4 gv[2][2];
#pragma unroll
            for (int bj = 0; bj < 2; ++bj)
#pragma unroll
                for (int n = 0; n < 2; ++n) gv[bj][n] = *(const LAS f32x4*)(gg + bj * 32 + fq * 8 + n * 4);
#pragma unroll
            for (int ai = 0; ai < 2; ++ai)
#pragma unroll
                for (int m = 0; m < 4; ++m) {
                    const int row = rows[ai][m]; const float r = rs[ai][m];
                    f32x4 v[2][2]; float sq = 0.f;
#pragma unroll
                    for (int bj = 0; bj < 2; ++bj)
#pragma unroll
                        for (int n = 0; n < 2; ++n) { v[bj][n] = acc[ai][bj][m][n] * r; sq += sq4(v[bj][n]); }
                    sq += __shfl_xor(sq, 16); sq += __shfl_xor(sq, 32);
                    const float ri = rsqrtf(sq * (1.0f / 64.0f) + EPS) * (isq ? C2 : 1.0f);
#pragma unroll
                    for (int bj = 0; bj < 2; ++bj)
                        *(u32x4*)(O + (size_t)row * 512 + head * 64 + bj * 32 + fq * 8) = pack8(v[bj][0] * ri * gv[bj][0], v[bj][1] * ri * gv[bj][1]);
                }
        } else if (pn <= 8) {
#pragma unroll
            for (int ai = 0; ai < 2; ++ai)
#pragma unroll
                for (int m = 0; m < 4; ++m) {
                    const int row = rows[ai][m]; const float r = rs[ai][m];
#pragma unroll
                    for (int bj = 0; bj < 2; ++bj)
                        *(u32x4*)(V + (size_t)row * 512 + (pn - 7) * 256 + bj * 128 + cl) = pack8(acc[ai][bj][m][0] * r, acc[ai][bj][m][1] * r);
                }
        } else {
            const int gc = (pn - 9) * 256, k = (pn - 9) >> 2, pnn = (pn - 9) & 3;
            unsigned char* gp = (unsigned char*)G + gate_off(u.pm, k, pnn, wr * 4 + wc, fq * 16 + fr);
            f32x4 gb[2][2];
#pragma unroll
            for (int bj = 0; bj < 2; ++bj)
#pragma unroll
                for (int n = 0; n < 2; ++n) gb[bj][n] = *(const LAS f32x4*)(cbl + bj * 128 + cl + n * 4);
#pragma unroll
            for (int ai = 0; ai < 2; ++ai)
#pragma unroll
                for (int m = 0; m < 4; ++m) {
                    const float r = rs[ai][m];
#pragma unroll
                    for (int bj = 0; bj < 2; ++bj) {
                        f32x4 a = acc[ai][bj][m][0] * r + gb[bj][0], b = acc[ai][bj][m][1] * r + gb[bj][1];
#pragma unroll
                        for (int j = 0; j < 4; ++j) { a[j] = sigmoid_f(a[j]); b[j] = sigmoid_f(b[j]); }
                        *(u32x2*)(gp + GATE_EL(ai, m, bj)) = pack8_u8(a, b);
                    }
                }
        }
    }
};
struct StoreGemm : g8::DenseBase {
    static constexpr bool PERM = true;
    int nfree, rank, nunits;
    __device__ __forceinline__ bool next(int i, Unit& u) const { if (rank < 0) return false; const int p = i * nfree + rank; if (p >= nunits) return false; u.pm = p >> 2; u.pn = p & 3; return true; }
    __device__ __forceinline__ void epi(Acc& acc, const Unit& u, int wr, int wc, int fr, int fq) const {
        fr = opaque(fr); fq = opaque(fq);
        unsigned long long z_ = 0; asm volatile("" : "+s"(z_)); unsigned char* w_ = ws + z_; unsigned char* d_ = dout + z_;
        bf16_t* O = (l == 0) ? (bf16_t*)(d_ + DO_PY) : (bf16_t*)(w_ + WS_XA); const int ldo = 1024;
        const int row0 = opaque(u.pm * 256 + wr * 64 + fr), cl = u.pn * 256 + wc * 32 + fq * 8;
#pragma unroll
        for (int ai = 0; ai < 2; ++ai)
#pragma unroll
            for (int m = 0; m < 4; ++m) {
                const int row = row0 + ai * 128 + m * 16;
#pragma unroll
                for (int bj = 0; bj < 2; ++bj) *(u32x4*)(O + (size_t)row * ldo + bj * 128 + cl) = pack8(acc[ai][bj][m][0], acc[ai][bj][m][1]);
            }
    }
};
struct BranchGemm : g8::DenseBase {
    static constexpr bool PERM = true;
    __device__ __forceinline__ void mid(Acc& acc, const Unit& u, int kdone, int wr, int wc, int fr, int fq) const {
        if (kdone != 4 && kdone != 8) return;
        fr = opaque(fr); fq = opaque(fq);
        const int k0 = (kdone == 4) ? 0 : 1;
        unsigned long long z_ = 0; asm volatile("" : "+s"(z_)); unsigned char* w_ = ws + z_; unsigned char* d_ = dout + z_;
        const bf16_t* G = (const bf16_t*)(w_ + WS_G);
        const int lane = opaque(fq * 16 + fr);
        const unsigned char* gn = (const unsigned char*)G + gate_off(u.pm, k0, u.pn, wr * 4 + wc, lane); const unsigned char* gd = (const unsigned char*)G + gate_off(u.pm, k0 + 1, u.pn, wr * 4 + wc, lane);
#pragma unroll
        for (int ai = 0; ai < 2; ++ai) {
            u32x2 nv[4][2], dv[4][2];
#pragma unroll
            for (int m = 0; m < 4; ++m)
#pragma unroll
                for (int bj = 0; bj < 2; ++bj) { nv[m][bj] = *(const u32x2*)(gn + GATE_EL(ai, m, bj)); dv[m][bj] = *(const u32x2*)(gd + GATE_EL(ai, m, bj)); }
#pragma unroll
            for (int m = 0; m < 4; ++m)
#pragma unroll
                for (int bj = 0; bj < 2; ++bj) { f32x4 na, nb, da, db; unpack8_u8(nv[m][bj], na, nb); unpack8_u8(dv[m][bj], da, db);
#pragma unroll
                    for (int j = 0; j < 4; ++j) { acc[ai][bj][m][0][j] *= na[j] * fast_rcp(da[j]); acc[ai][bj][m][1][j] *= nb[j] * fast_rcp(db[j]); } }
            asm volatile("" ::: "memory");
        }
    }
    __device__ __forceinline__ void epi(Acc& acc, const Unit& u, int wr, int wc, int fr, int fq) const {
        fr = opaque(fr); fq = opaque(fq);
        unsigned long long z_ = 0; asm volatile("" : "+s"(z_)); unsigned char* w_ = ws + z_; unsigned char* d_ = dout + z_;
        const bf16_t* G = (const bf16_t*)(w_ + WS_G); bf16_t* Mg = (bf16_t*)(w_ + WS_MERGED);
        const int row0 = opaque(u.pm * 256 + wr * 64 + fr), cl = u.pn * 256 + wc * 32 + fq * 8;
        const unsigned char* gc = (const unsigned char*)G + gate_off(u.pm, 2, u.pn, wr * 4 + wc, fq * 16 + fr);
        u32x2 gv[2][4][2];
#pragma unroll
        for (int ai = 0; ai < 2; ++ai)
#pragma unroll
            for (int m = 0; m < 4; ++m)
#pragma unroll
                for (int bj = 0; bj < 2; ++bj) gv[ai][m][bj] = *(const u32x2*)(gc + GATE_EL(ai, m, bj));
#pragma unroll
        for (int ai = 0; ai < 2; ++ai)
#pragma unroll
            for (int m = 0; m < 4; ++m) {
                const int row = row0 + ai * 128 + m * 16;
#pragma unroll
                for (int bj = 0; bj < 2; ++bj) { f32x4 ga, gb; unpack8_u8(gv[ai][m][bj], ga, gb);
                    *(u32x4*)(Mg + (size_t)row * 1024 + bj * 128 + cl) = pack8(acc[ai][bj][m][0] * (ga * (1.0f / 255.0f)), acc[ai][bj][m][1] * (gb * (1.0f / 255.0f))); }
            }
    }
};
struct OutGemm : g8::DenseBase {
    static constexpr bool PERM = true;
    float alpha;
    __device__ __forceinline__ void epi(Acc& acc, const Unit& u, int wr, int wc, int fr, int fq) const {
        fr = opaque(fr); fq = opaque(fq);
        unsigned long long z_ = 0; asm volatile("" : "+s"(z_)); unsigned char* w_ = ws + z_; unsigned char* d_ = dout + z_;
        bf16_t* X = (bf16_t*)(w_ + (l == 0 ? WS_XA : WS_XB)); float* ss = (float*)(w_ + WS_SS1);
        const int row0 = opaque(u.pm * 256 + wr * 64 + fr), cl = u.pn * 256 + wc * 32 + fq * 8;
#pragma unroll
        for (int ai = 0; ai < 2; ++ai) {
            u32x4 xv[4][2];
#pragma unroll
            for (int m = 0; m < 4; ++m)
#pragma unroll
                for (int bj = 0; bj < 2; ++bj) xv[m][bj] = *(const u32x4*)(X + (size_t)(row0 + ai * 128 + m * 16) * 1024 + bj * 128 + cl);
#pragma unroll
            for (int m = 0; m < 4; ++m) {
                const int row = row0 + ai * 128 + m * 16; float sq = 0.f;
#pragma unroll
                for (int bj = 0; bj < 2; ++bj) { f32x4 pa, pb; unpack8(xv[m][bj], pa, pb);
                    const f32x4 na = pa + acc[ai][bj][m][0] * alpha, nb = pb + acc[ai][bj][m][1] * alpha; const u32x4 w = pack8(na, nb); sq += sqpk(w);
                    *(u32x4*)(X + (size_t)row * 1024 + bj * 128 + cl) = w; *(u32x2*)(w_ + WS_X8 + (size_t)row * 1024 + bj * 128 + cl) = pack8_fp8(na, nb, SX8); }
                sq += __shfl_xor(sq, 16); sq += __shfl_xor(sq, 32);
                if (fq == 0) ss[(size_t)row * 16 + u.pn * 4 + wc] = sq;
            }
            asm volatile("" ::: "memory");
        }
    }
};
struct PleGemm : g8::DenseBase {
    static constexpr bool PERM = true;
    int lastl; float gsc;
    __device__ __forceinline__ void epi(Acc& acc, const Unit& u, int wr, int wc, int fr, int fq) const {
        fr = opaque(fr); fq = opaque(fq);
        unsigned long long z_ = 0; asm volatile("" : "+s"(z_)); unsigned char* w_ = ws + z_; unsigned char* d_ = dout + z_;
        const bf16_t* X = (const bf16_t*)(w_ + (l == 0 ? WS_XA : WS_XB)); bf16_t* Xn = (bf16_t*)(w_ + (l == 0 ? WS_XB : WS_XA)); const bf16_t* Pp = (l == 0) ? (const bf16_t*)(d_ + DO_PY) : (const bf16_t*)(w_ + WS_XA);
        const float* ss2 = (const float*)(w_ + WS_SS2); float* ssn = (float*)(w_ + WS_SSX); float* out = (float*)d_; unsigned char* X8n = w_ + WS_X8;
        const int row0 = opaque(u.pm * 256 + wr * 64 + fr), cl = u.pn * 256 + wc * 32 + fq * 8;
        int rows[2][4]; rows8(row0, rows); float rs[2][4]; rstd8(ss2, rows, fq, rs);
#pragma unroll
        for (int ai = 0; ai < 2; ++ai)
#pragma unroll
            for (int m = 0; m < 4; ++m) rs[ai][m] *= gsc;
#pragma unroll
        for (int ai = 0; ai < 2; ++ai)
#pragma unroll
            for (int mp = 0; mp < 2; ++mp) {
                u32x4 xv[2][2], pv[2][2];
#pragma unroll
                for (int mm = 0; mm < 2; ++mm)
#pragma unroll
                    for (int bj = 0; bj < 2; ++bj) { const size_t off = (size_t)rows[ai][mp * 2 + mm] * 1024 + bj * 128 + cl; xv[mm][bj] = *(const u32x4*)(X + off); pv[mm][bj] = *(const u32x4*)(Pp + off); }
#pragma unroll
                for (int mm = 0; mm < 2; ++mm) {
                    const int m = mp * 2 + mm; const int row = rows[ai][m]; const float r = rs[ai][m]; float sq = 0.f;
#pragma unroll
                    for (int bj = 0; bj < 2; ++bj) {
                        const size_t off = (size_t)row * 1024 + bj * 128 + cl;
                        f32x4 xa, xb, pa, pb; unpack8(xv[mm][bj], xa, xb); unpack8(pv[mm][bj], pa, pb);
                        f32x4 a = acc[ai][bj][m][0] * r, b = acc[ai][bj][m][1] * r;
#pragma unroll
                        for (int j = 0; j < 4; ++j) { a[j] = xa[j] + pa[j] * sigmoid_f(a[j]); b[j] = xb[j] + pb[j] * sigmoid_f(b[j]); }
                        if (lastl) { *(f32x4*)(out + off) = a; *(f32x4*)(out + off + 4) = b; }
                        else { const u32x4 w = pack8(a, b); sq += sqpk(w); *(u32x4*)(Xn + off) = w; *(u32x2*)(X8n + off) = pack8_fp8(a, b, SX8); }
                    }
                    if (!lastl) { sq += __shfl_xor(sq, 16); sq += __shfl_xor(sq, 32); if (fq == 0) ssn[(size_t)row * 16 + u.pn * 4 + wc] = sq; }
                }
                asm volatile("" ::: "memory");
            }
    }
};

#define XB_TMO      128
#define XB_XCNT(j)  (256  + 64 * (j))
#define XB_XSUB(j)  (1280 + 64 * (j))
#define XB_XGEN(j)  (2304 + 64 * (j))
#define XB_TOP      3328
#define XB_TOPGEN   3392
#define XCD_BAR_WORDS 3456
#define XB_SPIN_CAP (1u << 18)

__device__ __forceinline__ unsigned xb_ld(unsigned* p)              { return __hip_atomic_load(p, __ATOMIC_RELAXED, __HIP_MEMORY_SCOPE_AGENT); }
__device__ __forceinline__ unsigned xb_add(unsigned* p, unsigned v) { return __hip_atomic_fetch_add(p, v, __ATOMIC_RELAXED, __HIP_MEMORY_SCOPE_AGENT); }
__device__ __forceinline__ unsigned xb_xcc_id() { return (unsigned)__builtin_amdgcn_s_getreg((3 << 11) | 20) & 0xFu; }
#define XB_SPIN(cond, bar) do { unsigned _sp = 0; while (cond) { __builtin_amdgcn_s_sleep(1); \
    if ((++_sp & 255u) == 0u) { if (xb_ld(&(bar)[XB_TMO])) break; if (_sp > XB_SPIN_CAP) { atomicAdd(&(bar)[XB_TMO], 1u); break; } } } } while (0)

struct XcdBarrier {
    unsigned* bar; unsigned x; int wave;
    volatile LAS unsigned* st;
};

__device__ __forceinline__ XcdBarrier xcd_barrier_post(unsigned* bar, volatile LAS unsigned* st, int wave) {
    XcdBarrier b; b.bar = bar; b.x = xb_xcc_id(); b.st = st; b.wave = wave;
    if (wave == 0 && hw_lane() == 0) (void)xb_add(&bar[XB_XCNT(b.x)], 1u);
    return b;
}
__device__ __forceinline__ void xcd_barrier_complete(unsigned* bar, unsigned x, unsigned& nloc, unsigned& nx) {
    const unsigned G = gridDim.x * gridDim.y * gridDim.z;
    unsigned sum, cnt, mine, sp = 0u;
    for (;;) {
        sum = 0u; cnt = 0u; mine = 0u;
#pragma unroll
        for (unsigned j = 0; j < 16; ++j) { const unsigned c = xb_ld(&bar[XB_XCNT(j)]); sum += c; cnt += (c > 0u) ? 1u : 0u; mine = (j == x) ? c : mine; }
        if (sum == G) break;
        __builtin_amdgcn_s_sleep(1);
        if ((++sp & 255u) == 0u) { if (xb_ld(&bar[XB_TMO])) break; if (sp > XB_SPIN_CAP) { atomicAdd(&bar[XB_TMO], 1u); break; } }
    }
    nloc = mine > 0u ? mine : 1u; nx = cnt > 0u ? cnt : 1u;
}

__device__ __forceinline__ void xcd_barrier(const XcdBarrier& b) {
    asm volatile("s_waitcnt vmcnt(0)" ::: "memory");
    __syncthreads();
    if (b.wave == 0 && opaque(hw_lane()) == 0) {
        unsigned long long zb_ = 0; unsigned bx = b.x; asm volatile("" : "+s"(zb_), "+s"(bx)); unsigned* bar = b.bar + zb_;
        __builtin_amdgcn_s_waitcnt(0);
        unsigned nloc = b.st[0], nx = b.st[1];
        if (nloc == 0u) { xcd_barrier_complete(bar, bx, nloc, nx); b.st[0] = nloc; b.st[1] = nx; }
        const unsigned old = xb_add(&bar[XB_XSUB(bx)], 1u);
        const unsigned gen = old / nloc;
        if (old + 1u == (gen + 1u) * nloc) {
            __builtin_amdgcn_fence(__ATOMIC_RELEASE, "agent");
            asm volatile("s_waitcnt vmcnt(0)" ::: "memory");
            const unsigned og = xb_add(&bar[XB_TOP], 1u);
            const unsigned tg = og / nx;
            if (og + 1u == (tg + 1u) * nx) xb_add(&bar[XB_TOPGEN], 1u);
            else XB_SPIN(xb_ld(&bar[XB_TOPGEN]) == tg, bar);
            __builtin_amdgcn_fence(__ATOMIC_ACQUIRE, "agent");
            xb_add(&bar[XB_XGEN(bx)], 1u);
            asm volatile("s_waitcnt vmcnt(0)" ::: "memory");
        } else {
            XB_SPIN(xb_ld(&bar[XB_XGEN(bx)]) == gen, bar);
            __builtin_amdgcn_fence(__ATOMIC_ACQUIRE, "agent");
            asm volatile("s_waitcnt vmcnt(0)" ::: "memory");
        }
    }
    __syncthreads();
}

struct Args { const float* in[27]; float* out; unsigned char* ws; int rep_n, pad; };
struct Frame {
    LAS unsigned char* lds; gu32* ctl; unsigned char* ws; unsigned char* dout;
    int tid, lane, wave, G, gw, NGW, bx;
    inptr_t in;
};

__device__ __forceinline__ void transpose_item(const float* src, int src_ld, int k0, int src_col0, bf16_t* dst, int dst_ld, int dst_row0, int dst_k0, const float* kscale, LAS float* scr, int lane, float fp8s = 0.f) {
#pragma unroll 8
    for (int i = 0; i < 32; ++i) { const int kk = 2 * i + (lane >> 5); float v = src[(size_t)(k0 + kk) * src_ld + src_col0 + (lane & 31)]; if (kscale) v *= kscale[k0 + kk]; scr[kk * 33 + (lane & 31)] = v; }
    asm volatile("s_waitcnt lgkmcnt(0)" ::: "memory");
    const int c = lane & 7;
#pragma unroll
    for (int j = 0; j < 4; ++j) { const int n = (lane >> 3) + 8 * j; const LAS float* s = scr + (8 * c) * 33 + n;
        if (fp8s != 0.f) { const f32x4 a = {s[0 * 33], s[1 * 33], s[2 * 33], s[3 * 33]}, b = {s[4 * 33], s[5 * 33], s[6 * 33], s[7 * 33]};
            *(u32x2*)((unsigned char*)dst + (size_t)(dst_row0 + n) * dst_ld + dst_k0 + k0 + 8 * c) = pack8_fp8(a, b, fp8s); continue; }
        u32x4 o; o.x = cvt_pk_bf16(s[0 * 33], s[1 * 33]); o.y = cvt_pk_bf16(s[2 * 33], s[3 * 33]); o.z = cvt_pk_bf16(s[4 * 33], s[5 * 33]); o.w = cvt_pk_bf16(s[6 * 33], s[7 * 33]);
        *(u32x4*)(dst + (size_t)(dst_row0 + n) * dst_ld + dst_k0 + k0 + 8 * c) = o; }
    asm volatile("s_waitcnt lgkmcnt(0)" ::: "memory");
}
__device__ __forceinline__ void transpose_item64(const float* src, int src_ld, int k0, int col0a, int col0b, bf16_t* dst, int dst_ld, int dst_row0, int dst_k0, const float* kscale, LAS float* scr, int lane, float fp8s = 0.f) {
    const int cq = lane & 15, kr = lane >> 4; const int scol = (cq < 8) ? col0a + 4 * cq : col0b + 4 * (cq - 8);
    f32x4 v[16];
#pragma unroll
    for (int i = 0; i < 16; ++i) v[i] = *(const f32x4*)(src + (size_t)(k0 + kr + 4 * i) * src_ld + scol);
    if (kscale) {
#pragma unroll
        for (int i = 0; i < 16; ++i) v[i] = v[i] * kscale[k0 + kr + 4 * i];
    }
#pragma unroll
    for (int i = 0; i < 16; ++i) { LAS float* p = scr + (4 * cq) * 65 + kr + 4 * i; p[0] = v[i][0]; p[65] = v[i][1]; p[130] = v[i][2]; p[195] = v[i][3]; }
    asm volatile("s_waitcnt lgkmcnt(0)" ::: "memory");
    const int c = lane & 7;
#pragma unroll
    for (int j = 0; j < 8; ++j) { const int n = (lane >> 3) + 8 * j; const LAS float* q = scr + n * 65 + 8 * c;
        const f32x4 a = {q[0], q[1], q[2], q[3]}, b = {q[4], q[5], q[6], q[7]};
        if (fp8s != 0.f) *(u32x2*)((unsigned char*)dst + (size_t)(dst_row0 + n) * dst_ld + dst_k0 + k0 + 8 * c) = pack8_fp8(a, b, fp8s);
        else *(u32x4*)(dst + (size_t)(dst_row0 + n) * dst_ld + dst_k0 + k0 + 8 * c) = pack8(a, b); }
    asm volatile("s_waitcnt lgkmcnt(0)" ::: "memory");
}
__device__ __forceinline__ int win_src_col(int n) {
    const int pn = n >> 8, c = n & 255;
    if (pn >= 3 && pn <= 6) { const int bj = c >> 7, wcc = (c >> 5) & 3; const int base = (pn <= 4) ? 768 : 1280; return base + (4 * ((pn - 3) & 1) + wcc) * 64 + 32 * bj; }
    return n;
}
__device__ __forceinline__ void prep_layer(Frame& Fr, int l) {
    Frame F = Fr; F.lane = opaque(hw_lane()); F.gw = F.bx * 8 + F.wave;
    LAS float* scr = (LAS float*)(F.lds + F.wave * 16896);
    const float* mixg = F.in[2] + (size_t)l * D; const float* w_in = F.in[3] + (size_t)l * D * NIN;
    const float* pool_w = F.in[4] + (size_t)l * 4 * 64 * 64; const float* pool_s = F.in[5] + (size_t)l * 256;
    const float* wba = F.in[13] + (size_t)l * 256 * D; const float* wbb = F.in[14] + (size_t)l * 256 * D; const float* wbc = F.in[15] + (size_t)l * 512 * D;
    const float* wout = F.in[16] + (size_t)l * D * D; const float* ffng = F.in[17] + (size_t)l * D;
    const float* wein = F.in[22] + (size_t)l * NEXP * D * 256; const float* weout = F.in[23] + (size_t)l * NEXP * DEXP * D;
    bf16_t* Win_t = (bf16_t*)(F.ws + WS_WIN); bf16_t* Wbr_t = (bf16_t*)(F.ws + WS_WBR); bf16_t* Wout_t = (bf16_t*)(F.ws + WS_WOUT);
    bf16_t* Wein_t = (bf16_t*)(F.ws + WS_WEIN); bf16_t* Weout_t = (bf16_t*)(F.ws + WS_WEOUT);
    constexpr int I_IN = 16 * 80, I_POOL = 1024, I_BA = 4 * 16, I_BC = 8 * 16, I_OUT = 16 * 16, I_EIN = NEXP * 16 * 4, I_EOUT = NEXP * 2 * 16;
    constexpr int NITEMS = I_IN + I_POOL + 2 * I_BA + I_BC + I_OUT + I_EIN + I_EOUT;
    for (int it = F.gw; it < NITEMS; it += F.NGW) {
        int r = it;
        if (r < I_IN) { const int kb = r / 80, nb = r % 80 + 4;
            if (nb < 12) transpose_item64(w_in, NIN, 64 * kb, 64 * nb, 64 * nb + 32, Win_t, D, 64 * nb, 0, mixg, scr, F.lane);
            else transpose_item64(w_in, NIN, 64 * kb, win_src_col(64 * nb), win_src_col(64 * nb + 32), (bf16_t*)(F.ws + WS_WIN8), D, 64 * nb - 768, 0, mixg, scr, F.lane, SW8);
            continue; } r -= I_IN;
        if (r < I_POOL) {
            const int nb = r & 7, kb = r >> 3, g = nb >> 1, d0 = (nb & 1) * 32, nn = F.lane & 31, kh = F.lane >> 5, kbase = kb * 8 + kh * 4;
            float a[4] = {0.f, 0.f, 0.f, 0.f};
#pragma unroll 8
            for (int c = 0; c < 64; ++c) { const float pw = pool_w[(size_t)g * 4096 + c * 64 + d0 + nn];
#pragma unroll
                for (int j = 0; j < 4; ++j) a[j] += w_in[(size_t)(kbase + j) * NIN + g * 64 + c] * pw; }
            const float sc = pool_s[g * 64 + d0 + nn];
            u32x2 o; o.x = cvt_pk_bf16(a[0] * sc * mixg[kbase], a[1] * sc * mixg[kbase + 1]); o.y = cvt_pk_bf16(a[2] * sc * mixg[kbase + 2], a[3] * sc * mixg[kbase + 3]);
            *(u32x2*)(Win_t + (size_t)(g * 64 + d0 + nn) * D + kbase) = o; continue; } r -= I_POOL;
        if (r < I_BA) { transpose_item64(wba, D, 64 * (r / 16), 64 * (r % 16), 64 * (r % 16) + 32, Wbr_t, D, 64 * (r % 16), 0, nullptr, scr, F.lane); continue; } r -= I_BA;
        if (r < I_BA) { transpose_item64(wbb, D, 64 * (r / 16), 64 * (r % 16), 64 * (r % 16) + 32, Wbr_t, D, 64 * (r % 16), 256, nullptr, scr, F.lane); continue; } r -= I_BA;
        if (r < I_BC) { transpose_item64(wbc, D, 64 * (r / 16), 64 * (r % 16), 64 * (r % 16) + 32, Wbr_t, D, 64 * (r % 16), 512, nullptr, scr, F.lane); continue; } r -= I_BC;
        if (r < I_OUT) { transpose_item64(wout, D, 64 * (r / 16), 64 * (r % 16), 64 * (r % 16) + 32, Wout_t, D, 64 * (r % 16), 0, nullptr, scr, F.lane); continue; } r -= I_OUT;
        if (r < I_EIN) { const int e = r / 64, q = r % 64; transpose_item64(wein + (size_t)e * D * 256, 256, 64 * (q / 4), 64 * (q % 4), 64 * (q % 4) + 32, (bf16_t*)((unsigned char*)Wein_t + (size_t)e * 256 * D), D, 64 * (q % 4), 0, ffng, scr, F.lane, SW8); continue; } r -= I_EIN;
        { const int e = r / 32, q = r % 32; transpose_item64(weout + (size_t)e * DEXP * D, D, 64 * (q / 16), 64 * (q % 16), 64 * (q % 16) + 32, Weout_t + (size_t)e * D * DEXP, DEXP, 64 * (q % 16), 0, nullptr, scr, F.lane); }
    }
    const float* p = F.in[1] + (size_t)l * M * PLE; bf16_t* pb = (bf16_t*)(F.ws + WS_PB);
#pragma unroll 4
    for (size_t i = (size_t)F.gw * 64 + F.lane; i < (size_t)M * PLE / 8; i += (size_t)F.NGW * 64) {
        const f32x4 a = *(const f32x4*)(p + i * 8), b = *(const f32x4*)(p + i * 8 + 4); *(u32x4*)(pb + i * 8) = pack8(a, b); }
}
__device__ __forceinline__ void prologue(Frame& Fr) {
    Frame F = Fr; F.lane = opaque(hw_lane()); F.gw = F.bx * 8 + F.wave;
    LAS float* scr = (LAS float*)(F.lds + F.wave * 16896);
    constexpr int I_G = 16 * 16, I_P = 4 * 16;
    for (int it = F.gw; it < DEPTH * (I_G + I_P); it += F.NGW) {
        const int l = it / (I_G + I_P); int r = it % (I_G + I_P);
        if (r < I_G) { transpose_item64(F.in[26] + (size_t)l * D * D, D, 64 * (r / 16), 64 * (r % 16), 64 * (r % 16) + 32, (bf16_t*)(F.ws + WS_WGATE + (size_t)l * 2 * MiB), D, 64 * (r % 16), 0, F.in[24] + (size_t)l * D, scr, F.lane, SW8); continue; } r -= I_G;
        transpose_item64(F.in[25] + (size_t)l * PLE * D, D, 64 * (r / 16), 64 * (r % 16), 64 * (r % 16) + 32, (bf16_t*)(F.ws + WS_WPLE) + (size_t)l * (512 * 1024), PLE, 64 * (r % 16), 0, nullptr, scr, F.lane);
    }
    for (int i = F.gw * 64 + F.lane; i < DEPTH * 96 * D; i += F.NGW * 64) {
        const int l = i / (96 * D), o = (i / D) % 96, k = i % D; bf16_t r = 0;
        if (o < 72) { const int oo = o < 36 ? o : o - 36;
            const float w = ((oo < 4) ? F.in[18][((size_t)l * D + k) * 4 + oo] : F.in[20][((size_t)l * D + k) * 32 + (oo - 4)]) * F.in[17][(size_t)l * D + k];
            const bf16_t h = f2bf(w); r = (o < 36) ? h : f2bf(w - bf2f(h)); }
        ((bf16_t*)(F.ws + WS_WR))[i] = r;
    }
    if (F.gw == 0) { for (int i = F.lane; i < DEPTH * 36; i += 64) { const int l = i / 36, o = i % 36; ((float*)(F.ws + WS_WR + WR_BIAS))[i] = (o < 4) ? F.in[19][l * 4 + o] : F.in[21][l * 32 + o - 4]; } }
    if (F.gw == 1) { for (int i = F.lane; i < DEPTH * 128; i += 64) { const int l = i >> 7, j = i & 127; ((float*)(F.ws + WS_MISC + MISC_GQK))[i] = (j < 64) ? F.in[9][l * 64 + j] : F.in[10][l * 64 + j - 64]; } }
    for (int i = F.gw * 64 + F.lane; i < DEPTH * 4 * 128 * 128; i += F.NGW * 64) { const int ii = (i >> 7) & 127, jj = i & 127; ((bf16_t*)(F.ws + WS_MISC + MISC_WM))[i] = ((jj >> 6) <= (ii >> 6)) ? f2bf(F.in[7][i]) : (bf16_t)0; }
    for (int i = F.gw * 64 + F.lane; i < DEPTH * 8 * 256; i += F.NGW * 64) { const int lh = i >> 8, ii = i & 255; const int idx = ii + 65 > 256 ? 256 : ii + 65; ((float*)(F.ws + WS_MISC + MISC_TB))[i] = F.in[11][(size_t)lh * 257 + idx] * LOG2E; }
    if (F.gw < DEPTH * 8) {
        const int l = F.gw >> 3; float mq = fabsf(F.in[9][l * 64 + F.lane]), mk = fabsf(F.in[10][l * 64 + F.lane]), mb = -1e30f;
        for (int i = F.lane; i < 257; i += 64) mb = fmaxf(mb, F.in[11][(size_t)F.gw * 257 + i]);
#pragma unroll
        for (int o = 1; o < 64; o <<= 1) { mq = fmaxf(mq, __shfl_xor(mq, o)); mk = fmaxf(mk, __shfl_xor(mk, o)); mb = fmaxf(mb, __shfl_xor(mb, o)); }
        if (F.lane == 0) ((float*)(F.ws + WS_MISC + MISC_ATTM))[F.gw] = (8.0f * mq * mk + mb) * LOG2E;
    }
    bf16_t* XA = (bf16_t*)(F.ws + WS_XA); float* ssx = (float*)(F.ws + WS_SSX);
    for (int m0 = F.gw * 4; m0 < M; m0 += F.NGW * 4) {
        f32x4 v[4][4];
#pragma unroll
        for (int q = 0; q < 4; ++q)
#pragma unroll
            for (int j = 0; j < 4; ++j) v[q][j] = ((const f32x4*)(F.in[0] + (size_t)(m0 + q) * D) + F.lane)[64 * j];
#pragma unroll
        for (int q = 0; q < 4; ++q) { const int m = m0 + q; float s = 0.f;
#pragma unroll
            for (int j = 0; j < 4; ++j) { const f32x4 x = v[q][j]; u32x2 w; w.x = cvt_pk_bf16(x[0], x[1]); w.y = cvt_pk_bf16(x[2], x[3]);
                const float a0 = bflo(w.x), a1 = bfhi(w.x), a2 = bflo(w.y), a3 = bfhi(w.y); s += (a0 * a0 + a1 * a1) + (a2 * a2 + a3 * a3);
                *(u32x2*)(XA + (size_t)m * D + 256 * j + 4 * F.lane) = w;
                { int p8 = __builtin_amdgcn_cvt_pk_fp8_f32(x[0] * SX8, x[1] * SX8, 0, false); p8 = __builtin_amdgcn_cvt_pk_fp8_f32(x[2] * SX8, x[3] * SX8, p8, true); *(int*)(F.ws + WS_X8 + (size_t)m * D + 256 * j + 4 * F.lane) = p8; } }
            s = wave_sum(s);
            if (F.lane < 16) ssx[(size_t)m * 16 + F.lane] = (F.lane == 0) ? s : 0.f; }
    }
}

__device__ __forceinline__ void router_phase(Frame& Fr, int l, const bf16_t* X, const float* ss1, bool dry) {
    typedef float f32x16 __attribute__((ext_vector_type(16)));
    Frame F = Fr; F.lane = opaque(hw_lane()); F.tid = F.wave * 64 + F.lane; F.gw = F.bx * 8 + F.wave;
    const int lane = F.lane, r16 = lane & 15, kq = lane >> 4;
    const bf16_t* Wt = (const bf16_t*)(F.ws + WS_WR) + (size_t)l * 96 * D; const float* br = (const float*)(F.ws + WS_WR + WR_BIAS) + l * 36;
    LAS float* lg;
    int* tok_e = (int*)(F.ws + WS_MISC + MISC_TOKE); float* tok_w = (float*)(F.ws + WS_MISC + MISC_TOKW);
    int* elist = (int*)(F.ws + WS_ELIST); int* plist = (int*)(F.ws + WS_PLIST);
    gu32* cnt = F.ctl + CW_CNT + (size_t)l * 160 * 64;
    LAS unsigned char* tb = F.lds; constexpr int TPITCH = 272, TBUF = 80 * TPITCH;
    lg = (LAS float*)(F.lds + 45056) + F.wave * (16 * 81);
    const int tid = F.tid;
    for (int wt = F.bx; wt < M / 128; wt += F.G) {
        const int tok0 = wt * 128 + F.wave * 16;
        const bf16_t* xr = X + (size_t)(tok0 + r16) * D + kq * 8;
        u32x4 tr[3]; bf16x8 xc[4], xn[4];
#define RT_LOADT(c) do { _Pragma("unroll") for (int p_ = 0; p_ < 3; ++p_) { const int pc_ = tid + 512 * p_; if (pc_ < 1280) tr[p_] = *(const u32x4*)(Wt + (size_t)(pc_ >> 4) * D + (c) * 128 + (pc_ & 15) * 8); } } while (0)
#define RT_STORET(b) do { _Pragma("unroll") for (int p_ = 0; p_ < 3; ++p_) { const int pc_ = tid + 512 * p_; if (pc_ < 1280) *(LAS u32x4*)(tb + (b) * TBUF + (pc_ >> 4) * TPITCH + (pc_ & 15) * 16) = tr[p_]; } } while (0)
        RT_LOADT(0);
#pragma unroll
        for (int s4 = 0; s4 < 4; ++s4) xc[s4] = *(const bf16x8*)(xr + 32 * s4);
        asm volatile("s_waitcnt lgkmcnt(0)\n\ts_barrier" ::: "memory");
        RT_STORET(0);
        f32x4 a0 = {0.f, 0.f, 0.f, 0.f}, a1 = a0, a2 = a0, a3 = a0, a4 = a0;
#pragma unroll 1
        for (int c = 0; c < 8; ++c) {
            if (c + 1 < 8) { RT_LOADT(c + 1);
#pragma unroll
                for (int s4 = 0; s4 < 4; ++s4) xn[s4] = *(const bf16x8*)(xr + 128 * (c + 1) + 32 * s4); }
            asm volatile("s_waitcnt lgkmcnt(0)\n\ts_barrier" ::: "memory");
            const LAS unsigned char* bb = tb + (c & 1) * TBUF + r16 * TPITCH + kq * 16;
#pragma unroll
            for (int s4 = 0; s4 < 4; ++s4) {
                const bf16x8 b0 = *(const LAS bf16x8*)(bb + s4 * 64), b1 = *(const LAS bf16x8*)(bb + 16 * TPITCH + s4 * 64), b2 = *(const LAS bf16x8*)(bb + 32 * TPITCH + s4 * 64),
                             b3 = *(const LAS bf16x8*)(bb + 48 * TPITCH + s4 * 64), b4 = *(const LAS bf16x8*)(bb + 64 * TPITCH + s4 * 64);
                a0 = __builtin_amdgcn_mfma_f32_16x16x32_bf16(xc[s4], b0, a0, 0, 0, 0); a1 = __builtin_amdgcn_mfma_f32_16x16x32_bf16(xc[s4], b1, a1, 0, 0, 0); a2 = __builtin_amdgcn_mfma_f32_16x16x32_bf16(xc[s4], b2, a2, 0, 0, 0);
                a3 = __builtin_amdgcn_mfma_f32_16x16x32_bf16(xc[s4], b3, a3, 0, 0, 0); a4 = __builtin_amdgcn_mfma_f32_16x16x32_bf16(xc[s4], b4, a4, 0, 0, 0);
            }
            if (c + 1 < 8) { RT_STORET((c + 1) & 1);
#pragma unroll
                for (int s4 = 0; s4 < 4; ++s4) xc[s4] = xn[s4]; }
        }
#undef RT_LOADT
#undef RT_STORET
#pragma unroll
        for (int r = 0; r < 4; ++r) { LAS float* p = lg + (4 * kq + r) * 81 + r16; p[0] = a0[r]; p[16] = a1[r]; p[32] = a2[r]; p[48] = a3[r]; p[64] = a4[r]; }
        asm volatile("s_waitcnt lgkmcnt(0)" ::: "memory");
        if (lane < 16) {
            const int tok = tok0 + lane; const LAS float* q = lg + lane * 81;
            const f32x4* sp = (const f32x4*)(ss1 + (size_t)tok * 16); const f32x4 s0 = sp[0], s1 = sp[1], s2 = sp[2], s3 = sp[3];
            const float ssum = (((s0[0] + s0[1]) + (s0[2] + s0[3])) + ((s1[0] + s1[1]) + (s1[2] + s1[3]))) + (((s2[0] + s2[1]) + (s2[2] + s2[3])) + ((s3[0] + s3[1]) + (s3[2] + s3[3])));
            const float rstd = rsqrtf(ssum * (1.0f / D) + EPS);
#define RLOGIT(o) ((q[(o)] + q[36 + (o)]) * rstd + br[(o)])
            int g = 0; float gm = RLOGIT(0); float gl[4]; gl[0] = gm;
#pragma unroll
            for (int j = 1; j < 4; ++j) { gl[j] = RLOGIT(j); if (gl[j] > gm) { gm = gl[j]; g = j; } }
            float gs = 0.f;
#pragma unroll
            for (int j = 0; j < 4; ++j) gs += __expf(gl[j] - gm);
            const float gp = 1.0f / gs;
            int i1 = 0, i2 = -1; float m1 = -3.0e38f, m2 = -3.0e38f;
            for (int j = 0; j < 8; ++j) { const float v = RLOGIT(4 + 8 * g + j); if (v > m1) { m2 = m1; i2 = i1; m1 = v; i1 = j; } else if (v > m2) { m2 = v; i2 = j; } }
#undef RLOGIT
            const float e2 = __expf(m2 - m1), w1 = gp / (1.0f + e2), w2 = gp * e2 / (1.0f + e2);
            const int a = i1 < i2 ? i1 : i2, b = i1 < i2 ? i2 : i1; const float wlo = i1 < i2 ? w1 : w2, whi = i1 < i2 ? w2 : w1;
            const int lo = g * 8 + a, hh = g * 8 + b, pc = g * 28 + (a * 8 - (a * (a + 1)) / 2) + (b - a - 1);
            tok_e[tok] = lo | (hh << 8) | (pc << 16); tok_w[2 * tok] = wlo; tok_w[2 * tok + 1] = whi;
            if (!dry) {
            const unsigned p0 = __hip_atomic_fetch_add(cnt + 64 * lo, 1u, __ATOMIC_RELAXED, __HIP_MEMORY_SCOPE_AGENT); elist[(size_t)lo * CAP + p0] = tok * 2;
            const unsigned p1 = __hip_atomic_fetch_add(cnt + 64 * hh, 1u, __ATOMIC_RELAXED, __HIP_MEMORY_SCOPE_AGENT); elist[(size_t)hh * CAP + p1] = tok * 2 + 1;
            const unsigned p2 = __hip_atomic_fetch_add(cnt + 64 * (32 + pc), 1u, __ATOMIC_RELAXED, __HIP_MEMORY_SCOPE_AGENT); plist[(size_t)pc * CAP + p2] = tok; }
        }
    }
    __syncthreads();
}

constexpr int LT_PRE = LDSCTL_OFF + 64, LT_CNT = LT_PRE + 116 * 4;
__device__ __forceinline__ void build_class_tables(Frame& F, gu32* cnt, int ncls) {
    LAS int* tpre = (LAS int*)(F.lds + LT_PRE); LAS int* ccnt = (LAS int*)(F.lds + LT_CNT);
    __syncthreads();
    const int tid = F.wave * 64 + opaque(hw_lane());
    if (tid < ncls) ccnt[tid] = (int)__hip_atomic_load(cnt + 64 * tid, __ATOMIC_RELAXED, __HIP_MEMORY_SCOPE_AGENT);
    __syncthreads();
    if (tid <= ncls) { int a = 0;
#pragma unroll 8
        for (int c = 0; c < tid; ++c) a += (ccnt[c] + 255) >> 8;
        tpre[tid] = a; }
    __syncthreads();
}
struct Moe1Gemm {
    struct Unit { int pm, pn, e, cnt; };
    static constexpr bool PERM = true, GATHER = true;
    const char* a_base; unsigned lda; const char* b_base; unsigned ldb; int nt; int G, c;
    unsigned char* ws; unsigned char* dout; const LAS int* tpre; const LAS int* ccnt;
    __device__ __forceinline__ bool next(int i, Unit& u) const {
        const int L = i * G + c; if (L >= tpre[NEXP]) return false;
        int e = 0;
#pragma unroll
        for (int st = 16; st >= 1; st >>= 1) { if (tpre[e + st] <= L) e += st; }
        u.e = e; u.pm = L - tpre[e]; u.pn = 0; u.cnt = ccnt[e]; return true;
    }
    __device__ __forceinline__ void a_off(const Unit& u, const int (&R)[2], const int (&C)[2], unsigned (&o)[2][2]) const {
        unsigned long long z_ = 0; asm volatile("" : "+s"(z_)); unsigned char* w_ = ws + z_; unsigned char* d_ = dout + z_;
        const int* elist = (const int*)(w_ + WS_ELIST);
#pragma unroll
        for (int h = 0; h < 2; ++h)
#pragma unroll
            for (int i = 0; i < 2; ++i) { const int r = u.pm * 256 + h * 128 + R[i]; const int ent = (r < u.cnt) ? elist[(size_t)u.e * CAP + r] : 0; o[h][i] = (unsigned)(ent >> 1) * lda + (unsigned)C[i] * 2u; }
    }
    static constexpr bool EPC = false;
    __device__ __forceinline__ void epc_issue(const Unit&, LAS unsigned char*, int, int) const {}
    __device__ __forceinline__ const char* a_tile(const Unit&) const { return a_base; }
    __device__ __forceinline__ const char* b_tile(const Unit& u, int kt) const { return b_base + (size_t)u.e * 256 * ldb + (size_t)kt * 128; }
    __device__ __forceinline__ void mid(Acc&, const Unit&, int, int, int, int, int) const {}
    __device__ __forceinline__ void epi(Acc& acc, const Unit& u, int wr, int wc, int fr, int fq) const {
        fr = opaque(fr); fq = opaque(fq);
        unsigned long long z_ = 0; asm volatile("" : "+s"(z_)); unsigned char* w_ = ws + z_; unsigned char* d_ = dout + z_;
        const int* elist = (const int*)(w_ + WS_ELIST); const float* tok_w = (const float*)(w_ + WS_MISC + MISC_TOKW); const float* ss1 = (const float*)(w_ + WS_SS1); bf16_t* H = (bf16_t*)(w_ + WS_H);
        const int r0 = opaque(u.pm * 256 + wr * 64 + fr);
        int ent[2][4], rows[2][4]; float rs[2][4], w[2][4];
#pragma unroll
        for (int ai = 0; ai < 2; ++ai)
#pragma unroll
            for (int m = 0; m < 4; ++m) { const int r = r0 + ai * 128 + m * 16; ent[ai][m] = (r < u.cnt) ? elist[(size_t)u.e * CAP + r] : -1; }
#pragma unroll
        for (int ai = 0; ai < 2; ++ai)
#pragma unroll
            for (int m = 0; m < 4; ++m) { const int e0 = ent[ai][m] < 0 ? 0 : ent[ai][m]; rows[ai][m] = e0 >> 1; w[ai][m] = tok_w[e0]; }
        rstd8(ss1, rows, fq, rs);
#pragma unroll
        for (int ai = 0; ai < 2; ++ai)
#pragma unroll
            for (int m = 0; m < 4; ++m) {
                const float r = rs[ai][m] * INV_S8, ww = w[ai][m]; f32x4 a, b;
#pragma unroll
                for (int j = 0; j < 4; ++j) { a[j] = silu_f(acc[ai][0][m][0][j] * r) * (acc[ai][1][m][0][j] * r) * ww; b[j] = silu_f(acc[ai][0][m][1][j] * r) * (acc[ai][1][m][1][j] * r) * ww; }
                if (ent[ai][m] >= 0) *(u32x4*)(H + (size_t)rows[ai][m] * 256 + (ent[ai][m] & 1) * 128 + wc * 32 + fq * 8) = pack8(a, b);
            }
    }
};
struct Moe2Gemm {
    struct Unit { int pm, pn, lo, hi, cnt, pc; };
    static constexpr bool PERM = true, GATHER = true;
    const char* a_base; unsigned lda; const char* b_base; unsigned ldb; int nt; int G, c;
    unsigned char* ws; unsigned char* dout; int l; const LAS int* tpre; const LAS int* ccnt; float alpha;
    __device__ __forceinline__ bool next(int i, Unit& u) const {
        const int L = i * G + c, T = L >> 2; if (T >= tpre[NPAIR]) return false;
        int pc = 0;
#pragma unroll
        for (int st = 64; st >= 1; st >>= 1) { if (pc + st <= NPAIR && tpre[pc + st] <= T) pc += st; }
        u.pc = pc; u.pm = T - tpre[pc]; u.pn = L & 3; u.cnt = ccnt[pc];
        const int g = pc / 28; int pi = pc - g * 28, a = 0; while (pi >= 7 - a) { pi -= 7 - a; ++a; }
        u.lo = g * 8 + a; u.hi = g * 8 + a + 1 + pi; return true;
    }
    __device__ __forceinline__ void a_off(const Unit& u, const int (&R)[2], const int (&C)[2], unsigned (&o)[2][2]) const {
        unsigned long long z_ = 0; asm volatile("" : "+s"(z_)); unsigned char* w_ = ws + z_; unsigned char* d_ = dout + z_;
        const int* plist = (const int*)(w_ + WS_PLIST);
#pragma unroll
        for (int h = 0; h < 2; ++h)
#pragma unroll
            for (int i = 0; i < 2; ++i) { const int r = u.pm * 256 + h * 128 + R[i]; const int tok = (r < u.cnt) ? plist[(size_t)u.pc * CAP + r] : 0; o[h][i] = (unsigned)tok * lda + (unsigned)C[i] * 2u; }
    }
    static constexpr bool EPC = false;
    __device__ __forceinline__ void epc_issue(const Unit&, LAS unsigned char*, int, int) const {}
    __device__ __forceinline__ const char* a_tile(const Unit&) const { return a_base; }
    __device__ __forceinline__ const char* b_tile(const Unit& u, int kt) const { return b_base + (size_t)(kt < 2 ? u.lo : u.hi) * D * ldb + (size_t)u.pn * 256 * ldb + (size_t)(kt & 1) * 128; }
    __device__ __forceinline__ void mid(Acc&, const Unit&, int, int, int, int, int) const {}
    __device__ __forceinline__ void epi(Acc& acc, const Unit& u, int wr, int wc, int fr, int fq) const {
        fr = opaque(fr); fq = opaque(fq);
        unsigned long long z_ = 0; asm volatile("" : "+s"(z_)); unsigned char* w_ = ws + z_; unsigned char* d_ = dout + z_;
        const int* plist = (const int*)(w_ + WS_PLIST); bf16_t* X = (bf16_t*)(w_ + (l == 0 ? WS_XA : WS_XB)); float* ss = (float*)(w_ + WS_SS2); unsigned char* X8p = w_ + WS_X8P;
        const int r0 = opaque(u.pm * 256 + wr * 64 + fr), cl = u.pn * 256 + wc * 32 + fq * 8;
        int tok[2][4];
#pragma unroll
        for (int ai = 0; ai < 2; ++ai)
#pragma unroll
            for (int m = 0; m < 4; ++m) { const int r = r0 + ai * 128 + m * 16; tok[ai][m] = (r < u.cnt) ? plist[(size_t)u.pc * CAP + r] : -1; }
#pragma unroll
        for (int ai = 0; ai < 2; ++ai) {
            u32x4 xv[4][2];
#pragma unroll
            for (int m = 0; m < 4; ++m)
#pragma unroll
                for (int bj = 0; bj < 2; ++bj) xv[m][bj] = *(const u32x4*)(X + (size_t)(tok[ai][m] < 0 ? 0 : tok[ai][m]) * 1024 + bj * 128 + cl);
#pragma unroll
            for (int m = 0; m < 4; ++m) {
                const bool ok = tok[ai][m] >= 0; const size_t t = ok ? tok[ai][m] : 0; float sq = 0.f;
#pragma unroll
                for (int bj = 0; bj < 2; ++bj) { f32x4 pa, pb; unpack8(xv[m][bj], pa, pb);
                    const f32x4 na = pa + acc[ai][bj][m][0] * alpha, nb = pb + acc[ai][bj][m][1] * alpha; const u32x4 w = pack8(na, nb); sq += sqpk(w);
                    if (ok) { *(u32x4*)(X + t * 1024 + bj * 128 + cl) = w; *(u32x2*)(X8p + t * 1024 + bj * 128 + cl) = pack8_fp8(na, nb, SX8); } }
                sq += __shfl_xor(sq, 16); sq += __shfl_xor(sq, 32);
                if (ok && fq == 0) ss[t * 16 + u.pn * 4 + wc] = sq;
            }
            asm volatile("" ::: "memory");
        }
    }
};

namespace att {
typedef float f32x16 __attribute__((ext_vector_type(16)));
typedef short s16x4 __attribute__((ext_vector_type(4)));
constexpr int LK = 0, LV = 24576, LWS = 49152, LOST = 51200, LTB = 83968, LDS_NEED = 84992;
__device__ __forceinline__ int crow(int r, int hi) { return (r & 3) + 8 * (r >> 2) + 4 * hi; }
__device__ __forceinline__ void glds16(const void* gsrc, unsigned lds_dst) { unsigned keep;
    asm volatile("s_mov_b32 %0, m0\n\ts_mov_b32 m0, %2\n\ts_nop 0\n\tglobal_load_lds_dwordx4 %1, off\n\ts_mov_b32 m0, %0" : "=&s"(keep) : "v"(gsrc), "s"(lds_dst) : "memory"); }
__device__ __forceinline__ void attn_unit(int b, int cq, int h, const bf16_t* Q, const bf16_t* K, const bf16_t* V, bf16_t* Y, LAS unsigned char* lds, const float* tbg, float negM, const int wv) {
    const int wid = wv, lane = opaque(hw_lane()), tid = wid * 64 + lane, r32 = lane & 31, hi = lane >> 5;
    const long rowbase = (long)b * SEQ; const int q0 = cq * 256;
    const bf16_t* Qw = Q + (rowbase + q0 + wid * 32) * 512 + h * 64;
    const bf16_t* Kh = K + rowbase * 512 + h * 64; const bf16_t* Vh = V + rowbase * 512 + h * 64;
    const unsigned lds0 = (unsigned)(uintptr_t)lds;
    LAS float* wsf = (LAS float*)(lds + LWS) + wid * 64; LAS float* tbl = (LAS float*)(lds + LTB);
    if (tid < 256) tbl[tid] = tbg[tid];
    const float negMfar = negM + tbg[255];
    const bf16_t* ksrc = Kh + (long)lane * 512 + wid * 8;
    const bf16_t* vsrc = Vh + (long)(16 * (wid & 3) + (lane >> 2)) * 512 + (wid >> 2) * 32 + (lane & 3) * 8;
    const unsigned kdst = lds0 + LK + wid * 1024, vdst = lds0 + LV + wid * 1024;
    bf16x8 qr[4];
#pragma unroll
    for (int d0 = 0; d0 < 4; ++d0) qr[d0] = *(const bf16x8*)(Qw + (long)r32 * 512 + d0 * 16 + hi * 8);
    f32x16 o0 = {}, o1 = {}; float lsum = 0.f;
    const int ci = wid >> 1, jfirst = (cq >= 2) ? 0 : 8 - 4 * cq;
#define ATT_DMA(j, sl) do { const long ko_ = (long)(4 * cq - 8 + (j)) * 64 * 512; glds16(ksrc + ko_, (unsigned)__builtin_amdgcn_readfirstlane(kdst + (sl) * 8192)); glds16(vsrc + ko_, (unsigned)__builtin_amdgcn_readfirstlane(vdst + (sl) * 8192)); } while (0)
    ATT_DMA(jfirst, 0);
    if (jfirst + 1 < 12) ATT_DMA(jfirst + 1, 1);
    int slot = 0;
    for (int j = jfirst; j < 12; ++j) {
        if (j + 1 < 12) asm volatile("s_waitcnt vmcnt(2) lgkmcnt(0)\n\ts_barrier" ::: "memory"); else asm volatile("s_waitcnt vmcnt(0) lgkmcnt(0)\n\ts_barrier" ::: "memory");
        if (j + 2 < 12) ATT_DMA(j + 2, (slot + 2) % 3);
        if (j >= ci && j <= ci + 8) {
            const int delta = ci + 8 - j;
            const float cv = delta >= 3 ? negMfar : negM;
            f32x16 cin;
#pragma unroll
            for (int r = 0; r < 16; ++r) cin[r] = cv;
            f32x16 p0, p1;
            const LAS unsigned char* kb = lds + LK + slot * 8192 + hi * 1024 + r32 * 16;
#pragma unroll
            for (int d0 = 0; d0 < 4; ++d0) {
                const bf16x8 b0 = *(const LAS bf16x8*)(kb + d0 * 2048), b1 = *(const LAS bf16x8*)(kb + d0 * 2048 + 512);
                if (d0 == 0) { p0 = __builtin_amdgcn_mfma_f32_32x32x16_bf16(b0, qr[0], cin, 0, 0, 0); p1 = __builtin_amdgcn_mfma_f32_32x32x16_bf16(b1, qr[0], cin, 0, 0, 0); }
                else { p0 = __builtin_amdgcn_mfma_f32_32x32x16_bf16(b0, qr[d0], p0, 0, 0, 0); p1 = __builtin_amdgcn_mfma_f32_32x32x16_bf16(b1, qr[d0], p1, 0, 0, 0); }
            }
            if (delta < 3) {
                const LAS float* tb = tbl + (32 * (wid & 1) + r32 + 64 * delta + 63 - 4 * hi);
#pragma unroll
                for (int r = 0; r < 16; ++r) { const int cr = (r & 3) + 8 * (r >> 2); p0[r] += tb[-cr]; p1[r] += tb[-cr - 32]; }
            }
            float sacc = 0.f;
#pragma unroll
            for (int r = 0; r < 16; ++r) { p0[r] = fast_exp2(p0[r]); p1[r] = fast_exp2(p1[r]); sacc += p0[r] + p1[r]; }
            lsum += sacc;
            u32x4 pw0, pw1, pw2, pw3;
            pw0 = (u32x4){cvt_pk_bf16(p0[0], p0[1]), cvt_pk_bf16(p0[2], p0[3]), cvt_pk_bf16(p0[4], p0[5]), cvt_pk_bf16(p0[6], p0[7])};
            pw1 = (u32x4){cvt_pk_bf16(p0[8], p0[9]), cvt_pk_bf16(p0[10], p0[11]), cvt_pk_bf16(p0[12], p0[13]), cvt_pk_bf16(p0[14], p0[15])};
            pw2 = (u32x4){cvt_pk_bf16(p1[0], p1[1]), cvt_pk_bf16(p1[2], p1[3]), cvt_pk_bf16(p1[4], p1[5]), cvt_pk_bf16(p1[6], p1[7])};
            pw3 = (u32x4){cvt_pk_bf16(p1[8], p1[9]), cvt_pk_bf16(p1[10], p1[11]), cvt_pk_bf16(p1[12], p1[13]), cvt_pk_bf16(p1[14], p1[15])};
            const int vb = (int)(lds0 + LV + slot * 8192) + ((lane >> 4) & 1) * 32 + (lane & 3) * 8 + (4 * hi + ((lane & 15) >> 2)) * 64;
#pragma unroll
            for (int d0 = 0; d0 < 2; ++d0) { s16x4 vlo[4], vhi[4];
#pragma unroll
                for (int ks = 0; ks < 4; ++ks) {
                    asm volatile("ds_read_b64_tr_b16 %0,%1 offset:%c2" : "=&v"(vlo[ks]) : "v"(vb), "i"(d0 * 4096 + ks * 1024) : "memory");
                    asm volatile("ds_read_b64_tr_b16 %0,%1 offset:%c2" : "=&v"(vhi[ks]) : "v"(vb), "i"(d0 * 4096 + ks * 1024 + 512) : "memory"); }
                asm volatile("s_waitcnt lgkmcnt(0)" ::: "memory"); __builtin_amdgcn_sched_barrier(0);
#define ATT_PK(k) (bf16x8){vlo[k][0], vlo[k][1], vlo[k][2], vlo[k][3], vhi[k][0], vhi[k][1], vhi[k][2], vhi[k][3]}
                f32x16 oo = d0 == 0 ? o0 : o1;
                oo = __builtin_amdgcn_mfma_f32_32x32x16_bf16(__builtin_bit_cast(bf16x8, pw0), ATT_PK(0), oo, 0, 0, 0);
                oo = __builtin_amdgcn_mfma_f32_32x32x16_bf16(__builtin_bit_cast(bf16x8, pw1), ATT_PK(1), oo, 0, 0, 0);
                oo = __builtin_amdgcn_mfma_f32_32x32x16_bf16(__builtin_bit_cast(bf16x8, pw2), ATT_PK(2), oo, 0, 0, 0);
                oo = __builtin_amdgcn_mfma_f32_32x32x16_bf16(__builtin_bit_cast(bf16x8, pw3), ATT_PK(3), oo, 0, 0, 0);
#undef ATT_PK
                if (d0 == 0) o0 = oo; else o1 = oo;
            }
        }
        slot = (slot + 1) % 3;
    }
#undef ATT_DMA
    { auto rr = __builtin_amdgcn_permlane32_swap(__float_as_uint(lsum), __float_as_uint(lsum), false, false); lsum = __uint_as_float(rr[0]) + __uint_as_float(rr[1]); }
    if (hi == 0) wsf[32 + r32] = lsum;
    asm volatile("s_waitcnt lgkmcnt(0)" ::: "memory");
    bf16_t* Ow = Y + (rowbase + q0 + wid * 32) * 1024 + 512 + h * 64;
    LAS bf16_t* stg = (LAS bf16_t*)(lds + LOST) + wid * 2048;
#pragma unroll
    for (int r = 0; r < 16; ++r) { const int orow = crow(r, hi); const float rl = fast_rcp(wsf[32 + orow]);
        stg[orow * 64 + r32] = f2bf(o0[r] * rl); stg[orow * 64 + 32 + r32] = f2bf(o1[r] * rl); }
    asm volatile("s_waitcnt lgkmcnt(0)" ::: "memory");
#pragma unroll
    for (int i = 0; i < 4; ++i) { const int row = i * 8 + (lane >> 3), ch = lane & 7; const u32x4 v = *(const LAS u32x4*)(stg + row * 64 + ch * 8); *(u32x4*)(Ow + (long)row * 1024 + ch * 8) = v; }
    asm volatile("s_waitcnt lgkmcnt(0)\n\ts_barrier" ::: "memory");
}
__device__ __forceinline__ void attn_phase(Frame& F, int l, bf16_t* Y) {
    const bf16_t* Q = (const bf16_t*)(F.dout + DO_Q); const bf16_t* K = (const bf16_t*)(F.dout + DO_K); const bf16_t* V = (const bf16_t*)(F.ws + WS_V);
    const float* tb = (const float*)(F.ws + WS_MISC + MISC_TB) + (size_t)l * 8 * 256; const float* am = (const float*)(F.ws + WS_MISC + MISC_ATTM) + l * 8;
    for (int u = F.bx; u < 4 * 32 * 8; u += F.G) {
        const int h = u & 7, cq = (u >> 3) & 31, b = u >> 8;
        const float negM = -__hip_atomic_load(am + h, __ATOMIC_RELAXED, __HIP_MEMORY_SCOPE_AGENT);
        attn_unit(b, cq, h, Q, K, V, Y, F.lds, tb + h * 256, negM, F.wave);
    }
}
}

__device__ __forceinline__ void sgu_unit(Frame& F, int l, int blk, int gp, bf16_t* Y) {
    using namespace att;
    const int wid = F.wave, lane = opaque(hw_lane()), tid = wid * 64 + lane, r32 = lane & 31, hi = lane >> 5;
    LAS unsigned char* lds = F.lds; const unsigned lds0 = (unsigned)(uintptr_t)lds;
    const bf16_t* Zu = (const bf16_t*)(F.ws + WS_ZU); const bf16_t* Zv = (const bf16_t*)(F.ws + WS_ZV); const float* ssv = (const float*)(F.ws + WS_SSV);
    const bf16_t* Wm = (const bf16_t*)(F.ws + WS_MISC + MISC_WM) + (size_t)l * 4 * 16384;
    const float* gn = F.in[6] + l * 256; const float* b_s = F.in[8] + l * 512;
    const long t0 = (long)blk * 128; const int rb = wid & 3, gi = wid >> 2, g = 2 * gp + gi;
    LAS float* rst = (LAS float*)(lds + 32768); LAS float* stg = (LAS float*)(lds + 34816) + wid * 2048;
#pragma unroll
    for (int sl = 0; sl < 4; ++sl) { const int jt = sl & 1, gg = 2 * gp + (sl >> 1);
        const bf16_t* vsrc = Zv + (t0 + 64 * jt + 16 * (wid & 3) + (lane >> 2)) * 256 + gg * 64 + (wid >> 2) * 32 + (lane & 3) * 8;
        glds16(vsrc, (unsigned)__builtin_amdgcn_readfirstlane(lds0 + sl * 8192 + wid * 1024)); }
    if (tid < 128) { const f32x4 v = *(const f32x4*)(ssv + (t0 + tid) * 4); rst[tid] = rsqrtf(((v[0] + v[1]) + (v[2] + v[3])) * (1.0f / 256.0f) + EPS); }
    asm volatile("s_waitcnt vmcnt(0) lgkmcnt(0)\n\ts_barrier" ::: "memory");
    f32x16 o0 = {}, o1 = {};
    const int njt = rb < 2 ? 1 : 2;
    for (int jt = 0; jt < njt; ++jt) {
        const bf16_t* wrow = Wm + (size_t)g * 16384 + (size_t)(32 * rb + r32) * 128 + 64 * jt + 4 * hi;
        float p0[16], p1[16];
#pragma unroll
        for (int rg = 0; rg < 4; ++rg) {
            const u32x2 w0 = *(const u32x2*)(wrow + 8 * rg), w1 = *(const u32x2*)(wrow + 8 * rg + 32);
            const f32x4 r0 = *(const LAS f32x4*)(rst + 64 * jt + 8 * rg + 4 * hi), r1 = *(const LAS f32x4*)(rst + 64 * jt + 8 * rg + 4 * hi + 32);
            p0[4 * rg] = bflo(w0.x) * r0[0]; p0[4 * rg + 1] = bfhi(w0.x) * r0[1]; p0[4 * rg + 2] = bflo(w0.y) * r0[2]; p0[4 * rg + 3] = bfhi(w0.y) * r0[3];
            p1[4 * rg] = bflo(w1.x) * r1[0]; p1[4 * rg + 1] = bfhi(w1.x) * r1[1]; p1[4 * rg + 2] = bflo(w1.y) * r1[2]; p1[4 * rg + 3] = bfhi(w1.y) * r1[3];
        }
        u32x4 pw0, pw1, pw2, pw3;
        pw0 = (u32x4){cvt_pk_bf16(p0[0], p0[1]), cvt_pk_bf16(p0[2], p0[3]), cvt_pk_bf16(p0[4], p0[5]), cvt_pk_bf16(p0[6], p0[7])};
        pw1 = (u32x4){cvt_pk_bf16(p0[8], p0[9]), cvt_pk_bf16(p0[10], p0[11]), cvt_pk_bf16(p0[12], p0[13]), cvt_pk_bf16(p0[14], p0[15])};
        pw2 = (u32x4){cvt_pk_bf16(p1[0], p1[1]), cvt_pk_bf16(p1[2], p1[3]), cvt_pk_bf16(p1[4], p1[5]), cvt_pk_bf16(p1[6], p1[7])};
        pw3 = (u32x4){cvt_pk_bf16(p1[8], p1[9]), cvt_pk_bf16(p1[10], p1[11]), cvt_pk_bf16(p1[12], p1[13]), cvt_pk_bf16(p1[14], p1[15])};
        const int vb = (int)(lds0 + (gi * 2 + jt) * 8192) + ((lane >> 4) & 1) * 32 + (lane & 3) * 8 + (4 * hi + ((lane & 15) >> 2)) * 64;
#pragma unroll
        for (int d0 = 0; d0 < 2; ++d0) { s16x4 vlo[4], vhi[4];
#pragma unroll
            for (int ks = 0; ks < 4; ++ks) {
                asm volatile("ds_read_b64_tr_b16 %0,%1 offset:%c2" : "=&v"(vlo[ks]) : "v"(vb), "i"(d0 * 4096 + ks * 1024) : "memory");
                asm volatile("ds_read_b64_tr_b16 %0,%1 offset:%c2" : "=&v"(vhi[ks]) : "v"(vb), "i"(d0 * 4096 + ks * 1024 + 512) : "memory"); }
            asm volatile("s_waitcnt lgkmcnt(0)" ::: "memory"); __builtin_amdgcn_sched_barrier(0);
#define SGU_PK(k) (bf16x8){vlo[k][0], vlo[k][1], vlo[k][2], vlo[k][3], vhi[k][0], vhi[k][1], vhi[k][2], vhi[k][3]}
            f32x16 oo = d0 == 0 ? o0 : o1;
            oo = __builtin_amdgcn_mfma_f32_32x32x16_bf16(__builtin_bit_cast(bf16x8, pw0), SGU_PK(0), oo, 0, 0, 0);
            oo = __builtin_amdgcn_mfma_f32_32x32x16_bf16(__builtin_bit_cast(bf16x8, pw1), SGU_PK(1), oo, 0, 0, 0);
            oo = __builtin_amdgcn_mfma_f32_32x32x16_bf16(__builtin_bit_cast(bf16x8, pw2), SGU_PK(2), oo, 0, 0, 0);
            oo = __builtin_amdgcn_mfma_f32_32x32x16_bf16(__builtin_bit_cast(bf16x8, pw3), SGU_PK(3), oo, 0, 0, 0);
#undef SGU_PK
            if (d0 == 0) o0 = oo; else o1 = oo;
        }
    }
    const float g0 = gn[g * 64 + r32], g1 = gn[g * 64 + 32 + r32];
#pragma unroll
    for (int r = 0; r < 16; ++r) { const int orow = crow(r, hi); const float bb = b_s[g * 128 + 32 * rb + orow];
        stg[orow * 64 + r32] = o0[r] * g0 + bb; stg[orow * 64 + 32 + r32] = o1[r] * g1 + bb; }
    asm volatile("s_waitcnt lgkmcnt(0)" ::: "memory");
#pragma unroll
    for (int i = 0; i < 4; ++i) { const int row = i * 8 + (lane >> 3), ch = lane & 7; const long t = t0 + 32 * rb + row;
        const f32x4 m0 = *(const LAS f32x4*)(stg + row * 64 + ch * 8), m1 = *(const LAS f32x4*)(stg + row * 64 + ch * 8 + 4);
        f32x4 ua, ub; unpack8(*(const u32x4*)(Zu + t * 256 + g * 64 + ch * 8), ua, ub);
        *(u32x4*)(Y + t * 1024 + 256 + g * 64 + ch * 8) = pack8(ua * m0, ub * m1); }
    asm volatile("s_waitcnt lgkmcnt(0)\n\ts_barrier" ::: "memory");
}
__device__ __forceinline__ void sgu_pool_phase(Frame& F, int l, bf16_t* Y) {
    for (int u = F.bx; u < 4 * 64 * 2; u += F.G) sgu_unit(F, l, u >> 1, u & 1, Y);
    const bf16_t* Za = (const bf16_t*)(F.ws + WS_ZA);
    for (int it = F.bx * 512 + F.wave * 64 + opaque(hw_lane()); it < (M / 16) * 32; it += F.G * 512) {
        const int ch = it & 31, t0 = (it >> 5) * 16, w = 2 << (ch >> 3), s0 = t0 & (SEQ - 1);
        const bf16_t* zp = Za + (size_t)t0 * 256 + ch * 8;
        f32x4 sa = {0.f, 0.f, 0.f, 0.f}, sb = sa;
#pragma unroll
        for (int j = 1; j < 16; ++j) { if (j < w && j <= s0) { f32x4 a, b; unpack8(*(const u32x4*)(zp - (size_t)j * 256), a, b); sa += a; sb += b; } }
#pragma unroll
        for (int i = 0; i < 16; ++i) {
            f32x4 a, b; unpack8(*(const u32x4*)(zp + (size_t)i * 256), a, b); sa += a; sb += b;
            const int s = s0 + i; const int cnt = (s + 1 < w) ? s + 1 : w; const float ic = 1.0f / (float)cnt;
            *(u32x4*)(Y + (size_t)(t0 + i) * 1024 + ch * 8) = pack8(sa * ic - a, sb * ic - b);
            if (s + 1 >= w) { f32x4 oa, ob; unpack8(*(const u32x4*)(zp + ((ptrdiff_t)i + 1 - w) * 256), oa, ob); sa -= oa; sb -= ob; }
        }
    }
}

constexpr int NPH = 1 + 8 * DEPTH;
#ifndef PROBE_PHASE
#define PROBE_PHASE 0
#define PROBE_N 1
#endif
#ifndef PHMASK
#define PHMASK 0xFFFF
#endif
#define EN(b) ((PHMASK >> (b)) & 1)
__global__ void __launch_bounds__(512, 2) fwd(Args args) {
    extern __shared__ __attribute__((aligned(16))) unsigned char lds_raw[];
    Frame F;
    F.lds = (LAS unsigned char*)lds_raw; F.ws = args.ws; F.dout = (unsigned char*)args.out; F.ctl = (gu32*)(args.ws + WS_CTL); F.in = (inptr_t)__builtin_amdgcn_kernarg_segment_ptr();
    F.tid = -1; F.lane = -1; F.wave = __builtin_amdgcn_readfirstlane(threadIdx.x >> 6); F.G = gridDim.x;
    F.bx = blockIdx.x; F.gw = F.bx * 8 + F.wave; F.NGW = F.G * 8;
    for (int u = threadIdx.x; u < (LDS_BYTES - LDSCTL_OFF) / 4; u += 512) ((LAS unsigned*)(F.lds + LDSCTL_OFF))[u] = 0u;
    __syncthreads();
    XcdBarrier bar = xcd_barrier_post((unsigned*)(F.ctl + CW_BAR), (volatile LAS unsigned*)(F.lds + LDSCTL_OFF), F.wave);
#define IN(k) true
#define SEAM(k) xcd_barrier(bar)
    for (int rp_ = 0, nr_ = (PROBE_PHASE == 9 ? args.rep_n : 1); rp_ < nr_; ++rp_) { if (rp_) xcd_barrier(bar);
    if (EN(0) && IN(0)) { prologue(F); prep_layer(F, 0); } }
    SEAM(0);
    unsigned char* const ws0 = F.ws; unsigned char* const do0 = F.dout; const inptr_t in0 = (inptr_t)__builtin_amdgcn_kernarg_segment_ptr(); const int bx0 = blockIdx.x, G0 = gridDim.x;
    for (int l = 0; l < DEPTH; ++l) {
        const int pb = 1 + 8 * l;
#define OPQ() unsigned long long zq_ = 0; inptr_t inq = in0; asm volatile("" : "+s"(zq_), "+s"(inq)); unsigned char* ws = ws0 + zq_; unsigned char* dout = do0 + zq_; F.ws = ws; F.dout = dout; F.in = inq; \
        int bx_ = bx0, G_ = G0; asm volatile("" : "+s"(bx_), "+s"(G_)); F.bx = bx_; F.G = G_; F.gw = bx_ * 8 + F.wave; F.NGW = G_ * 8; \
        bf16_t* Xc = (bf16_t*)(ws + (l == 0 ? WS_XA : WS_XB)); bf16_t* Xo = (bf16_t*)(ws + (l == 0 ? WS_XB : WS_XA)); \
        bf16_t* Y = (l == 0) ? Xo : (bf16_t*)(dout + DO_PY); float* ss1 = (float*)(ws + WS_SS1); \
        (void)Xc; (void)Xo; (void)Y; (void)ss1;
#define SETB(S) do { (S).ws = ws; (S).dout = dout; (S).l = l; } while (0)
        for (int rp_ = 0, nr_ = (PROBE_PHASE == 1 ? args.rep_n : 1); rp_ < nr_; ++rp_) { if (rp_) xcd_barrier(bar);
        if (EN(1) && IN(pb + 0)) { OPQ();
            InGemm S; SETB(S); S.inq = inq; S.a_base = (const char*)Xc; S.lda = 2048; S.b_base = (const char*)(ws + WS_WIN); S.ldb = 2048; S.nt = 16; S.ord.init(M, 768, F.G, bx_); S.pn_off = 0; S.gsc = 1.f; S.epc = F.lds + g8::STAGE_BYTES;
            g8::gemm_phase(F.lds, S, F.wave);
            S.a_base = (const char*)(ws + WS_X8); S.lda = 1024; S.b_base = (const char*)(ws + WS_WIN8); S.ldb = 1024; S.nt = 8; S.ord.init(M, 4608, F.G, bx_); S.pn_off = 3; S.gsc = INV_S8;
            g8::gemm_phase<InGemm, false, true>(F.lds, S, F.wave);
        }
        }
        SEAM(pb + 0);
        for (int rp_ = 0, nr_ = (PROBE_PHASE == 2 ? args.rep_n : 1); rp_ < nr_; ++rp_) { if (rp_) xcd_barrier(bar);
        if (EN(2) && IN(pb + 1)) { OPQ(); att::attn_phase(F, l, Y); sgu_pool_phase(F, l, Y); }
        }
        SEAM(pb + 1);
        for (int rp_ = 0, nr_ = (PROBE_PHASE == 3 ? args.rep_n : 1); rp_ < nr_; ++rp_) { if (rp_) xcd_barrier(bar);
        if (EN(3) && IN(pb + 2)) { OPQ();
            BranchGemm S; SETB(S); S.a_base = (const char*)Y; S.lda = 2048; S.b_base = (const char*)(ws + WS_WBR); S.ldb = 2048; S.nt = 16; S.ord.init(M, D, F.G, bx_);
            g8::gemm_phase<BranchGemm, true>(F.lds, S, F.wave);
        }
        }
        SEAM(pb + 2);
        for (int rp_ = 0, nr_ = (PROBE_PHASE == 4 ? args.rep_n : 1); rp_ < nr_; ++rp_) { if (rp_) xcd_barrier(bar);
        if (EN(4) && IN(pb + 3)) { OPQ();
            OutGemm S; SETB(S); S.a_base = (const char*)(ws + WS_MERGED); S.lda = 2048; S.b_base = (const char*)(ws + WS_WOUT); S.ldb = 2048; S.nt = 16; S.ord.init(M, D, F.G, bx_);
            S.alpha = rp_ ? 0.f : 1.f; g8::gemm_phase(F.lds, S, F.wave);
        }
        }
        SEAM(pb + 3);
        for (int rp_ = 0, nr_ = (PROBE_PHASE == 5 ? args.rep_n : 1); rp_ < nr_; ++rp_) { if (rp_) xcd_barrier(bar);
        if (EN(5) && IN(pb + 4)) { OPQ(); router_phase(F, l, Xc, ss1, rp_ > 0); }
        }
        SEAM(pb + 4);
        for (int rp_ = 0, nr_ = (PROBE_PHASE == 6 ? args.rep_n : 1); rp_ < nr_; ++rp_) { if (rp_) xcd_barrier(bar);
        if (EN(6) && IN(pb + 5)) { OPQ();
            gu32* cnt = (gu32*)(ws + WS_CTL) + CW_CNT + (size_t)l * 160 * 64;
            build_class_tables(F, cnt, NEXP);
            Moe1Gemm S; S.ws = ws; S.dout = dout; S.a_base = (const char*)(ws + WS_X8); S.lda = 1024; S.b_base = (const char*)(ws + WS_WEIN); S.ldb = 1024; S.nt = 8; S.G = F.G; S.c = bx_;
            S.tpre = (const LAS int*)(F.lds + LT_PRE); S.ccnt = (const LAS int*)(F.lds + LT_CNT);
            const int tot1 = S.tpre[NEXP];
            g8::gemm_phase<Moe1Gemm, false, true>(F.lds, S, F.wave);
            StoreGemm P; SETB(P); P.a_base = (const char*)(ws + WS_PB); P.lda = 512; P.b_base = (const char*)(ws + WS_WPLE + (size_t)l * MiB); P.ldb = 512; P.nt = 4;
            { const int extra = (tot1 > F.G && tot1 < 2 * F.G) ? tot1 - F.G : 0; P.nfree = F.G - extra; P.rank = (int)bx_ - extra; P.nunits = (M / 256) * 4; }
            g8::gemm_phase(F.lds, P, F.wave);
        }
        }
        SEAM(pb + 5);
        for (int rp_ = 0, nr_ = (PROBE_PHASE == 7 ? args.rep_n : 1); rp_ < nr_; ++rp_) { if (rp_) xcd_barrier(bar);
        if (EN(7) && IN(pb + 6)) { OPQ();
            gu32* cnt = (gu32*)(ws + WS_CTL) + CW_CNT + (size_t)l * 160 * 64 + 32 * 64;
            build_class_tables(F, cnt, NPAIR);
            Moe2Gemm S; S.ws = ws; S.dout = dout; S.l = l; S.a_base = (const char*)(ws + WS_H); S.lda = 512; S.b_base = (const char*)(ws + WS_WEOUT); S.ldb = 256; S.nt = 4; S.G = F.G; S.c = bx_;
            S.alpha = rp_ ? 0.f : 1.f;
            S.tpre = (const LAS int*)(F.lds + LT_PRE); S.ccnt = (const LAS int*)(F.lds + LT_CNT);
            g8::gemm_phase(F.lds, S, F.wave);
        }
        }
        SEAM(pb + 6);
        for (int rp_ = 0, nr_ = (PROBE_PHASE == 8 ? args.rep_n : 1); rp_ < nr_; ++rp_) { if (rp_) xcd_barrier(bar);
        if (EN(8) && IN(pb + 7)) { OPQ();
            if (l + 1 < DEPTH) { prep_layer(F, l + 1); __syncthreads(); }
            PleGemm S; SETB(S); S.a_base = (const char*)(ws + WS_X8P); S.lda = 1024; S.b_base = (const char*)(ws + WS_WGATE + (size_t)l * 2 * MiB); S.ldb = 1024; S.nt = 8; S.ord.init(M, D, F.G, bx_);
            S.lastl = (l == DEPTH - 1); S.gsc = INV_S8;
            g8::gemm_phase<PleGemm, false, true>(F.lds, S, F.wave);
        }
        }
        if (l + 1 < DEPTH) SEAM(pb + 7);
    }
#undef SETB
#undef OPQ
#undef IN
#undef SEAM
}

#ifndef N_LAUNCHES
#define N_LAUNCHES 1
#endif
extern "C" void kernel_launch(void* const* d_in, const int* in_sizes, int n_in, void* d_out, int out_size, void* d_ws, size_t ws_size, hipStream_t stream) {
    static int grid = 0;
    if (grid == 0) {
        if (n_in != 27 || out_size != M * D || ws_size < WS_END) { fprintf(stderr, "kernel_launch: unexpected shapes (n_in %d out %d ws %zu)\n", n_in, out_size, ws_size); grid = -1; return; }
        int dev = 0, cus = 0;
        if (hipGetDevice(&dev) != hipSuccess || hipDeviceGetAttribute(&cus, hipDeviceAttributeMultiprocessorCount, dev) != hipSuccess) { grid = -1; return; }
        if (hipFuncSetAttribute((const void*)fwd, hipFuncAttributeMaxDynamicSharedMemorySize, LDS_BYTES) != hipSuccess) { fprintf(stderr, "kernel_launch: hipFuncSetAttribute failed\n"); grid = -1; return; }
        int per_cu = 0;
        if (hipOccupancyMaxActiveBlocksPerMultiprocessor(&per_cu, (const void*)fwd, 512, LDS_BYTES) != hipSuccess || per_cu < 1) fprintf(stderr, "kernel_launch: occupancy query says %d\n", per_cu);
        (void)hipGetLastError();
        grid = cus;
    }
    if (grid < 0) return;
    (void)hipMemsetAsync((char*)d_ws + WS_CTL, 0, CTL_ZERO_BYTES, stream);
    Args a{};
    for (int i = 0; i < 27; ++i) a.in[i] = (const float*)d_in[i];
    a.out = (float*)d_out; a.ws = (unsigned char*)d_ws; a.rep_n = PROBE_N;
    hipLaunchKernelGGL(fwd, dim3(grid), dim3(512), LDS_BYTES, stream, a);
}
```

```cpp
#include <hip/hip_runtime.h>
#include <cstdio>
#include <cstdint>

#define LAS __attribute__((address_space(3)))
#define GAS __attribute__((address_space(1)))
typedef unsigned short bf16_t;
typedef short bf16x8 __attribute__((ext_vector_type(8)));
typedef float f32x4 __attribute__((ext_vector_type(4)));
typedef float f32x2 __attribute__((ext_vector_type(2)));
typedef unsigned u32x4 __attribute__((ext_vector_type(4)));
typedef unsigned u32x2 __attribute__((ext_vector_type(2)));
typedef GAS unsigned gu32;
typedef const float* const __attribute__((address_space(4)))* inptr_t;

constexpr int M = 32768, D = 1024, SEQ = 8192, NIN = 5376, DEPTH = 2, PLE = 256;
constexpr int NEXP = 32, DEXP = 128, NPAIR = 112, CAP = 32768;
constexpr float EPS = 1e-6f;
constexpr float LOG2E = 1.4426950408889634f;
constexpr float C2 = 0.125f * LOG2E;

constexpr size_t MiB = 1u << 20;
constexpr size_t WS_CTL = 0, CTL_ZERO_BYTES = 1 * MiB;
constexpr size_t WS_MISC = 1 * MiB;
constexpr size_t MISC_ATTM = 0, MISC_GQK = 1024, MISC_TB = 4096, MISC_TOKE = 32768, MISC_TOKW = 196608, MISC_WM = 524288;
constexpr size_t WS_WR = 2 * MiB, WR_BIAS = 896 * 1024;
constexpr size_t WS_SSX = 3 * MiB, WS_SS1 = 5 * MiB, WS_SS2 = 7 * MiB, WS_SSV = 9 * MiB;
constexpr size_t WS_WGATE = 10 * MiB, WS_WPLE = 14 * MiB;
constexpr size_t WS_WIN = 16 * MiB, WS_WBR = 27 * MiB, WS_WOUT = 29 * MiB, WS_WEIN = 31 * MiB, WS_WEOUT = 47 * MiB;
constexpr size_t WS_PB = 58 * MiB;
constexpr size_t WS_XA = 74 * MiB, WS_XB = 138 * MiB;
constexpr size_t WS_ZA = 202 * MiB, WS_ZU = 218 * MiB, WS_ZV = 234 * MiB, WS_V = 250 * MiB, WS_G = 282 * MiB;
constexpr size_t WS_MERGED = 202 * MiB, WS_H = 202 * MiB, WS_ELIST = 218 * MiB, WS_PLIST = 222 * MiB;
constexpr size_t WS_WIN8 = 21 * MiB;
constexpr size_t WS_X8 = 474 * MiB, WS_X8P = 236 * MiB;
constexpr size_t WS_END = 506 * MiB;
constexpr float SX8 = 8.0f, SW8 = 64.0f, INV_S8 = 1.0f / (8.0f * 64.0f);
constexpr size_t DO_PY = 0, DO_Q = 64 * MiB, DO_K = 96 * MiB;
constexpr int CW_TMO = 0, CW_BAR = 4096, CW_CNT = 16384;

constexpr int LDS_BYTES = 152576;
constexpr int LDSCTL_OFF = 152576 - 2048;

__device__ __forceinline__ float bflo(unsigned w) { return __uint_as_float(w << 16); }
__device__ __forceinline__ float bfhi(unsigned w) { return __uint_as_float(w & 0xffff0000u); }
__device__ __forceinline__ float bf2f(bf16_t h) { return __uint_as_float((unsigned)h << 16); }
typedef __bf16 bf16x2_t __attribute__((ext_vector_type(2)));
__device__ __forceinline__ unsigned cvt_pk_bf16(float lo, float hi) { const f32x2 v = {lo, hi}; const bf16x2_t b = __builtin_convertvector(v, bf16x2_t); return __builtin_bit_cast(unsigned, b); }
__device__ __forceinline__ bf16_t f2bf(float f) { return (bf16_t)(cvt_pk_bf16(f, 0.f) & 0xffffu); }
__device__ __forceinline__ u32x2 pack8_fp8(f32x4 a, f32x4 b, float sc) {
    int lo = __builtin_amdgcn_cvt_pk_fp8_f32(a[0] * sc, a[1] * sc, 0, false); lo = __builtin_amdgcn_cvt_pk_fp8_f32(a[2] * sc, a[3] * sc, lo, true);
    int hi = __builtin_amdgcn_cvt_pk_fp8_f32(b[0] * sc, b[1] * sc, 0, false); hi = __builtin_amdgcn_cvt_pk_fp8_f32(b[2] * sc, b[3] * sc, hi, true);
    return (u32x2){(unsigned)lo, (unsigned)hi}; }
__device__ __forceinline__ float fast_rcp(float x) { return __builtin_amdgcn_rcpf(x); }
__device__ __forceinline__ float fast_exp2(float x) { return __builtin_amdgcn_exp2f(x); }
__device__ __forceinline__ float gelu_t(float x) { const float u = x + 0.044715f * x * x * x; return x * fast_rcp(1.f + fast_exp2(-2.302208198f * u)); }
__device__ __forceinline__ float sigmoid_f(float x) { return fast_rcp(1.f + fast_exp2(-LOG2E * x)); }
__device__ __forceinline__ float silu_f(float x) { return x * sigmoid_f(x); }
__device__ __forceinline__ int hw_lane() { return (int)__builtin_amdgcn_mbcnt_hi(~0u, __builtin_amdgcn_mbcnt_lo(~0u, 0u)); }
__device__ __forceinline__ int opaque(int v) { asm volatile("" : "+v"(v)); return v; }
__device__ __forceinline__ float wave_sum(float v) {
#pragma unroll
    for (int o = 1; o < 64; o <<= 1) v += __shfl_xor(v, o);
    return v;
}
__device__ __forceinline__ u32x4 pack8(f32x4 a, f32x4 b) { u32x4 w; w.x = cvt_pk_bf16(a[0], a[1]); w.y = cvt_pk_bf16(a[2], a[3]); w.z = cvt_pk_bf16(b[0], b[1]); w.w = cvt_pk_bf16(b[2], b[3]); return w; }
__device__ __forceinline__ void unpack8(u32x4 w, f32x4& a, f32x4& b) { a = (f32x4){bflo(w.x), bfhi(w.x), bflo(w.y), bfhi(w.y)}; b = (f32x4){bflo(w.z), bfhi(w.z), bflo(w.w), bfhi(w.w)}; }
__device__ __forceinline__ float sq4(f32x4 a) { return (a[0] * a[0] + a[1] * a[1]) + (a[2] * a[2] + a[3] * a[3]); }
__device__ __forceinline__ float sqpk(u32x4 w) { f32x4 a, b; unpack8(w, a, b); return sq4(a) + sq4(b); }

namespace g8 {
constexpr int BM = 256, BK = 64, HALF = 128, HTB = HALF * BK * 2, STAGE_BYTES = 8 * HTB, NXCD = 8, WGM = 8;
__host__ __device__ __forceinline__ int lds_byte(int r, int c) { const int st = (r >> 4) * 2 + (c >> 5), rr = r & 15, cc = c & 31, ob = rr * 64 + cc * 2; return st * 1024 + (ob ^ (((ob >> 9) & 1) << 5)); }
__host__ __device__ __forceinline__ void stage_rc(int b, int& R, int& C) { const int st = b / 1024, sb = b % 1024, swz = sb ^ (((sb >> 9) & 1) << 5); R = (st >> 1) * 16 + swz / 64; C = (st & 1) * 32 + (swz % 64) / 2; }
__host__ __device__ __forceinline__ int perm32(int rho) { const int n = rho >> 4, i = rho & 15; return 8 * (i >> 2) + 4 * n + (i & 3); }

struct Unit { int pm, pn; };
struct StaticOrder {
    int nM, nN, nwg, G, c;
    __device__ void init(int Mr, int N, int G_, int c_) { nM = Mr / BM; nN = N / BM; nwg = nM * nN; G = G_; c = c_; }
    __device__ bool next(int i, Unit& u) const { return map((long)i * G + c, u); }
    __device__ bool map(long L, Unit& u) const {
        if (L >= nwg) return false;
        int wgid = (int)L; { const int q = nwg / NXCD, r = nwg % NXCD, xcd = wgid % NXCD, off = wgid / NXCD; wgid = (xcd < r ? xcd * (q + 1) : r * (q + 1) + (xcd - r) * q) + off; }
        const int nig = WGM * nN, gid = wgid / nig, fm = gid * WGM, gsz = (nM - fm) < WGM ? (nM - fm) : WGM;
        u.pm = fm + ((wgid % nig) % gsz); u.pn = (wgid % nig) / gsz; return true;
    }
};
struct DenseBase {
    typedef g8::Unit Unit;
    const char* a_base; unsigned lda; const char* b_base; unsigned ldb; int nt; StaticOrder ord;
    unsigned char* ws; unsigned char* dout; inptr_t inq; int l;
    __device__ __forceinline__ bool next(int i, Unit& u) const { return ord.next(i, u); }
    static constexpr bool GATHER = false;
    __device__ __forceinline__ void a_off(const Unit&, const int (&)[2], const int (&)[2], unsigned (&)[2][2]) const {}
    __device__ __forceinline__ const char* a_tile(const Unit& u) const { return a_base + (size_t)u.pm * BM * lda; }
    __device__ __forceinline__ const char* b_tile(const Unit& u, int kt) const { return b_base + (size_t)u.pn * BM * ldb + (size_t)kt * (BK * 2); }
    __device__ __forceinline__ void mid(f32x4 (&)[2][2][4][2], const Unit&, int, int, int, int, int) const {}
    static constexpr bool EPC = false;
    __device__ __forceinline__ void epc_issue(const Unit&, LAS unsigned char*, int, int) const {}
};

template <class P, bool HOOK = false, bool FP8 = false>
__device__ __forceinline__ void gemm_phase(LAS unsigned char* lds, const P& S, const int wv  ) {
    typedef int v8i __attribute__((ext_vector_type(8))); typedef int v4i __attribute__((ext_vector_type(4)));
    typedef typename P::Unit Unit;
    int wid = wv; asm volatile("" : "+s"(wid));
    const int lane = opaque(hw_lane()), tid = wid * 64 + lane, wr = wid >> 2, wc = wid & 3, fr = lane & 15, fq = lane >> 4;
    const int nt = S.nt;
    int R[2], C[2]; unsigned voffB[2];
#pragma unroll
    for (int i = 0; i < 2; ++i) { stage_rc(tid * 16 + i * 8192, R[i], C[i]); const int Rb = P::PERM ? ((R[i] & ~31) + perm32(R[i] & 31)) : R[i]; voffB[i] = (unsigned)Rb * S.ldb + (unsigned)C[i] * 2u; }
    const size_t hstepB = (size_t)HALF * S.ldb;
    unsigned voffA[2] = {0u, 0u}; size_t hstepA = 0;
    if constexpr (!P::GATHER) { hstepA = (size_t)HALF * S.lda;
#pragma unroll
        for (int i = 0; i < 2; ++i) voffA[i] = (unsigned)R[i] * S.lda + (unsigned)C[i] * 2u; }
    const unsigned ldsw = (unsigned)wid * 1024u;
    const int aoff = lds_byte(wr * 64 + fr, fq * 8), boff = lds_byte(wc * 32 + fr, fq * 8);
    const char* const Ab = S.a_base;
#define G8_SA(b, h) (((b) * 2 + (h)) * HTB)
#define G8_SB(b, h) ((4 + (b) * 2 + (h)) * HTB)
#define G8_STAGE_A(bufoff, sel, h, kt) do { if constexpr (P::GATHER) { _Pragma("unroll") for (int _i = 0; _i < 2; ++_i) \
        __builtin_amdgcn_global_load_lds((const unsigned*)(Ab + (size_t)((sel) ? no[h][_i] : co[h][_i]) + (size_t)(kt) * (BK * 2)), (LAS unsigned*)(lds + (bufoff) + ldsw + _i * 8192), 16, 0, 0); } \
      else { const char* _g = ((sel) ? nA : cA) + (size_t)(h) * hstepA + (size_t)(kt) * (BK * 2); _Pragma("unroll") for (int _i = 0; _i < 2; ++_i) \
        __builtin_amdgcn_global_load_lds((const unsigned*)(_g + voffA[_i]), (LAS unsigned*)(lds + (bufoff) + ldsw + _i * 8192), 16, 0, 0); } } while (0)
#define G8_STAGE_B(bufoff, gbase) do { _Pragma("unroll") for (int _i = 0; _i < 2; ++_i) \
        __builtin_amdgcn_global_load_lds((const unsigned*)((const char*)(gbase) + voffB[_i]), (LAS unsigned*)(lds + (bufoff) + ldsw + _i * 8192), 16, 0, 0); } while (0)
#define G8_LDA(dst, b, h) do { if constexpr (FP8) { _Pragma("unroll") for (int m = 0; m < 4; ++m) { dst##8[m].lo = *(const LAS v4i*)(lds + G8_SA(b, h) + aoff + m * 2048); dst##8[m].hi = *(const LAS v4i*)(lds + G8_SA(b, h) + aoff + m * 2048 + 1024); } } \
      else { _Pragma("unroll") for (int m = 0; m < 4; ++m) _Pragma("unroll") for (int k = 0; k < 2; ++k) dst[m][k] = *(const LAS bf16x8*)(lds + G8_SA(b, h) + aoff + m * 2048 + k * 1024); } } while (0)
#define G8_LDB(dst, b, h) do { if constexpr (FP8) { _Pragma("unroll") for (int n = 0; n < 2; ++n) { dst##8[n].lo = *(const LAS v4i*)(lds + G8_SB(b, h) + boff + n * 2048); dst##8[n].hi = *(const LAS v4i*)(lds + G8_SB(b, h) + boff + n * 2048 + 1024); } } \
      else { _Pragma("unroll") for (int n = 0; n < 2; ++n) _Pragma("unroll") for (int k = 0; k < 2; ++k) dst[n][k] = *(const LAS bf16x8*)(lds + G8_SB(b, h) + boff + n * 2048 + k * 1024); } } while (0)
#define G8_MMA(ai, bj, At, Bt) do { __builtin_amdgcn_s_setprio(1); if constexpr (FP8) { _Pragma("unroll") for (int m = 0; m < 4; ++m) _Pragma("unroll") for (int n = 0; n < 2; ++n) \
        asm volatile("v_mfma_f32_16x16x128_f8f6f4 %0, %1, %2, %0" : "+v"(acc[ai][bj][m][n]) : "v"(Bt##8[n]), "v"(At##8[m])); } \
      else { _Pragma("unroll") for (int m = 0; m < 4; ++m) _Pragma("unroll") for (int n = 0; n < 2; ++n) _Pragma("unroll") for (int k = 0; k < 2; ++k) \
        acc[ai][bj][m][n] = __builtin_amdgcn_mfma_f32_16x16x32_bf16(Bt[n][k], At[m][k], acc[ai][bj][m][n], 0, 0, 0); } __builtin_amdgcn_s_setprio(0); } while (0)
#define G8_WAIT_V(n) asm volatile("s_waitcnt vmcnt(" #n ")" ::: "memory")
#define G8_WAIT_L(n) asm volatile("s_waitcnt lgkmcnt(" #n ")" ::: "memory")
#define G8_BAR __builtin_amdgcn_s_barrier()
#define G8_SCHED __builtin_amdgcn_sched_barrier(0)
    Unit cur, nxt; int ui = 0;
    if (!S.next(0, cur)) return;
    unsigned co[2][2], no[2][2];
    S.a_off(cur, R, C, co);
    const char* cA = nullptr; const char* nA = nullptr;
    if constexpr (!P::GATHER) { cA = S.a_tile(cur); nA = cA; }
    f32x4 acc[2][2][4][2];
#pragma unroll
    for (int a = 0; a < 2; ++a)
#pragma unroll
        for (int b = 0; b < 2; ++b)
#pragma unroll
            for (int m = 0; m < 4; ++m)
#pragma unroll
                for (int n = 0; n < 2; ++n) acc[a][b][m][n] = (f32x4){0.f, 0.f, 0.f, 0.f};
    bf16x8 At[4][2], B0[2][2], B1[2][2]; v8i At8[4], B08[2], B18[2];
    {
        const char* b0 = S.b_tile(cur, 0); const char* b1 = S.b_tile(cur, 1);
        G8_STAGE_B(G8_SB(0, 0), b0); G8_STAGE_B(G8_SB(0, 1), b0 + hstepB); G8_STAGE_A(G8_SA(0, 0), false, 0, 0); G8_STAGE_A(G8_SA(0, 1), false, 1, 0);
        if (wr == 1) G8_BAR;
        G8_WAIT_V(2); G8_BAR;
        G8_STAGE_B(G8_SB(1, 0), b1); G8_STAGE_A(G8_SA(1, 0), false, 0, 1); G8_STAGE_B(G8_SB(1, 1), b1 + hstepB);
        G8_WAIT_V(6); G8_BAR;
    }
    for (;;) {
        const bool has_next = S.next(ui + 1, nxt);
        if (!has_next) nxt = cur;
        S.a_off(nxt, R, C, no);
        if constexpr (!P::GATHER) nA = S.a_tile(nxt);
        for (int t = 0; t < nt; t += 2) {
            const bool last = (t == nt - 2);
            if constexpr (P::EPC) { if (last) S.epc_issue(cur, lds + STAGE_BYTES, wid, lane); }
            const int k2 = last ? 0 : t + 2, k3 = k2 + 1;
            const char* b2 = last ? S.b_tile(nxt, 0) : S.b_tile(cur, t + 2);
            const char* b3 = last ? S.b_tile(nxt, 1) : S.b_tile(cur, t + 3);
            G8_LDB(B0, 0, 0); G8_LDB(B1, 0, 1); G8_SCHED; G8_LDA(At, 0, 0); G8_STAGE_A(G8_SA(1, 1), false, 1, t + 1);
            G8_WAIT_V(8); G8_WAIT_L(0); G8_BAR; G8_MMA(0, 0, At, B0); G8_MMA(0, 1, At, B1); G8_BAR; G8_SCHED;
            G8_LDA(At, 0, 1); G8_STAGE_B(G8_SB(0, 0), b2); G8_STAGE_B(G8_SB(0, 1), b2 + hstepB); G8_STAGE_A(G8_SA(0, 0), last, 0, k2);
            G8_WAIT_V(8); G8_WAIT_L(0); G8_BAR; G8_MMA(1, 0, At, B0); G8_MMA(1, 1, At, B1); G8_BAR; G8_SCHED;
            G8_LDB(B0, 1, 0); G8_LDB(B1, 1, 1); G8_SCHED; G8_LDA(At, 1, 0); G8_STAGE_A(G8_SA(0, 1), last, 1, k2);
            G8_WAIT_V(8); G8_WAIT_L(0); G8_BAR; G8_MMA(0, 0, At, B0); G8_MMA(0, 1, At, B1); G8_BAR; G8_SCHED;
            G8_LDA(At, 1, 1); G8_STAGE_B(G8_SB(1, 0), b3); G8_STAGE_B(G8_SB(1, 1), b3 + hstepB); G8_STAGE_A(G8_SA(1, 0), last, 0, k3);
            G8_WAIT_V(8); G8_WAIT_L(0); G8_BAR; G8_MMA(1, 0, At, B0); G8_MMA(1, 1, At, B1); G8_BAR; G8_SCHED;
            if constexpr (HOOK) { if (!last) S.mid(acc, cur, t + 2, wr, wc, fr, fq); }
        }
        if constexpr (FP8) asm volatile("s_nop 15\n\ts_nop 15" ::: "memory");
        if (wr == 0) G8_BAR;
        if constexpr (P::EPC) G8_BAR;
        S.epi(acc, cur, wr, wc, fr, fq);
        if (!has_next) break;
#pragma unroll
        for (int a = 0; a < 2; ++a)
#pragma unroll
            for (int b = 0; b < 2; ++b)
#pragma unroll
                for (int m = 0; m < 4; ++m)
#pragma unroll
                    for (int n = 0; n < 2; ++n) acc[a][b][m][n] = (f32x4){0.f, 0.f, 0.f, 0.f};
        cur = nxt; cA = nA;
#pragma unroll
        for (int h = 0; h < 2; ++h)
#pragma unroll
            for (int i = 0; i < 2; ++i) co[h][i] = no[h][i];
        ++ui;
        if (wr == 1) G8_BAR;
    }
    G8_WAIT_V(0);
    G8_BAR;
#undef G8_SA
#undef G8_SB
#undef G8_STAGE_A
#undef G8_STAGE_B
#undef G8_LDA
#undef G8_LDB
#undef G8_MMA
#undef G8_WAIT_V
#undef G8_WAIT_L
#undef G8_BAR
#undef G8_SCHED
}
}

__device__ __forceinline__ float rstd_from(const float* ss, int row, int fq) {
    const f32x4 v = *(const f32x4*)(ss + (size_t)row * 16 + fq * 4);
    float s = (v[0] + v[1]) + (v[2] + v[3]); s += __shfl_xor(s, 16); s += __shfl_xor(s, 32);
    return rsqrtf(s * (1.0f / D) + EPS);
}
__device__ __forceinline__ void rstd8(const float* ss, const int (&rows)[2][4], int fq, float (&rs)[2][4]) {
    f32x4 v[2][4];
#pragma unroll
    for (int ai = 0; ai < 2; ++ai)
#pragma unroll
        for (int m = 0; m < 4; ++m) v[ai][m] = *(const f32x4*)(ss + (size_t)rows[ai][m] * 16 + fq * 4);
#pragma unroll
    for (int ai = 0; ai < 2; ++ai)
#pragma unroll
        for (int m = 0; m < 4; ++m) { float s = (v[ai][m][0] + v[ai][m][1]) + (v[ai][m][2] + v[ai][m][3]); s += __shfl_xor(s, 16); s += __shfl_xor(s, 32); rs[ai][m] = rsqrtf(s * (1.0f / D) + EPS); }
}
__device__ __forceinline__ void rows8(int row0, int (&rows)[2][4]) {
#pragma unroll
    for (int ai = 0; ai < 2; ++ai)
#pragma unroll
        for (int m = 0; m < 4; ++m) rows[ai][m] = row0 + ai * 128 + m * 16;
}
__device__ __forceinline__ size_t gate_off(int pm, int k, int pn, int wid, int lane) { return ((((size_t)pm * 3 + k) * 4 + pn) * 8 + wid) * 8192 + (size_t)lane * 8; }
#define GATE_EL(ai, m, bj) ((((ai) * 4 + (m)) * 2 + (bj)) * 512)
__device__ __forceinline__ u32x2 pack8_u8(f32x4 a, f32x4 b) {
    unsigned lo = 0, hi = 0;
#pragma unroll
    for (int j = 0; j < 4; ++j) { lo = __builtin_amdgcn_cvt_pk_u8_f32(fmaxf(__builtin_rintf(a[j] * 255.0f), 1.0f), j, lo); hi = __builtin_amdgcn_cvt_pk_u8_f32(fmaxf(__builtin_rintf(b[j] * 255.0f), 1.0f), j, hi); }
    return (u32x2){lo, hi}; }
__device__ __forceinline__ void unpack8_u8(u32x2 w, f32x4& a, f32x4& b) {
    a = (f32x4){(float)(w.x & 255u), (float)((w.x >> 8) & 255u), (float)((w.x >> 16) & 255u), (float)(w.x >> 24)};
    b = (f32x4){(float)(w.y & 255u), (float)((w.y >> 8) & 255u), (float)((w.y >> 16) & 255u), (float)(w.y >> 24)}; }

typedef f32x4 Acc[2][2][4][2];
struct InGemm : g8::DenseBase {
    static constexpr bool PERM = true, EPC = true;
    __device__ __forceinline__ void epc_issue(const Unit& u, LAS unsigned char* epc, int wid, int lane) const {
        unsigned long long z_ = 0; asm volatile("" : "+s"(z_)); unsigned char* w_ = ws + z_;
        const float* ssx = (const float*)(w_ + WS_SSX) + (size_t)u.pm * 256 * 16;
#pragma unroll
        for (int i = 0; i < 2; ++i) __builtin_amdgcn_global_load_lds((const unsigned*)(ssx + ((wid * 2 + i) * 64 + lane) * 4), (LAS unsigned*)(epc + (wid * 2 + i) * 1024), 16, 0, 0);
        if (wid == 0) { const int pn = u.pn + pn_off; const float* cb;
            if (pn >= 9) { inptr_t in_ = inq; asm volatile("" : "+s"(in_)); cb = in_[12] + (size_t)l * 3072 + (pn - 9) * 256; }
            else cb = (const float*)(w_ + WS_MISC + MISC_GQK) + l * 128 + ((pn >= 5) ? 64 : 0);
            __builtin_amdgcn_global_load_lds((const unsigned*)(cb + lane * 4), (LAS unsigned*)(epc + 16384), 16, 0, 0); }
    }
    LAS unsigned char* epc;
    int pn_off; float gsc;
    __device__ __forceinline__ bool next(int i, Unit& u) const {
        if (pn_off == 0 || ord.G != 256) return ord.next(i, u);
        if (i < 8) return ord.map((long)i * 256 + ord.c, u);
        if (ord.c >= 128 && i < 10) return ord.map(2048 + (long)(ord.c - 128) * 2 + (i - 8), u);
        return false;
    }
    __device__ __forceinline__ void epi(Acc& acc, const Unit& u, int wr, int wc, int fr, int fq) const {
        fr = opaque(fr); fq = opaque(fq);
        unsigned long long z_ = 0; asm volatile("" : "+s"(z_)); unsigned char* w_ = ws + z_; unsigned char* d_ = dout + z_;
        bf16_t* Z3 = (bf16_t*)(w_ + WS_ZA); bf16_t* QK = (bf16_t*)(d_ + DO_Q); bf16_t* V = (bf16_t*)(w_ + WS_V); bf16_t* G = (bf16_t*)(w_ + WS_G);
        float* ssv = (float*)(w_ + WS_SSV);
        const int row0 = opaque(u.pm * 256 + wr * 64 + fr), pn = u.pn + pn_off, cl = wc * 32 + fq * 8;
        int rows[2][4]; rows8(row0, rows); float rs[2][4];
        { const LAS f32x4* sp = (const LAS f32x4*)epc + (wr * 64 + fr) * 4 + fq; f32x4 v[2][4];
#pragma unroll
            for (int ai = 0; ai < 2; ++ai)
#pragma unroll
                for (int m = 0; m < 4; ++m) v[ai][m] = sp[(ai * 128 + m * 16) * 4];
#pragma unroll
            for (int ai = 0; ai < 2; ++ai)
#pragma unroll
                for (int m = 0; m < 4; ++m) { float s_ = (v[ai][m][0] + v[ai][m][1]) + (v[ai][m][2] + v[ai][m][3]); s_ += __shfl_xor(s_, 16); s_ += __shfl_xor(s_, 32); rs[ai][m] = rsqrtf(s_ * (1.0f / D) + EPS); } }
        const LAS float* cbl = (const LAS float*)(epc + 16384);
        if (pn_off) {
#pragma unroll
            for (int ai = 0; ai < 2; ++ai)
#pragma unroll
                for (int m = 0; m < 4; ++m) rs[ai][m] *= gsc;
        }
        if (pn <= 2) {
            bf16_t* O = Z3 + (size_t)pn * ((size_t)M * 256);
#pragma unroll
            for (int ai = 0; ai < 2; ++ai)
#pragma unroll
                for (int m = 0; m < 4; ++m) {
                    const int row = rows[ai][m]; const float r = rs[ai][m]; float sq = 0.f;
#pragma unroll
                    for (int bj = 0; bj < 2; ++bj) {
                        f32x4 a = acc[ai][bj][m][0] * r, b = acc[ai][bj][m][1] * r;
                        if (pn >= 1) {
#pragma unroll
                            for (int j = 0; j < 4; ++j) { a[j] = gelu_t(a[j]); b[j] = gelu_t(b[j]); }
                        }
                        const u32x4 w = pack8(a, b); sq += sqpk(w);
                        *(u32x4*)(O + (size_t)row * 256 + bj * 128 + cl) = w;
                    }
                    if (pn == 2) { sq += __shfl_xor(sq, 16); sq += __shfl_xor(sq, 32); if (fq == 0) ssv[(size_t)row * 4 + wc] = sq; }
                }
        } else if (pn <= 6) {
            const bool isq = pn <= 4; const LAS float* gg = cbl; bf16_t* O = QK + (isq ? (size_t)0 : (size_t)M * 512);
            const int head = 4 * ((pn - 3) & 1) + wc;
            f32x4 gv[2][2];
#pragma unroll
            for (int bj = 0; bj < 2; ++bj)
#pragma unroll
                for (int n = 0; n < 2; ++n) gv[bj][n] = *(const LAS f32x4*)(gg + bj * 32 + fq * 8 + n * 4);
#pragma unroll
            for (int ai = 0; ai < 2; ++ai)
#pragma unroll
                for (int m = 0; m < 4; ++m) {
                    const int row = rows[ai][m]; const float r = rs[ai][m];
                    f32x4 v[2][2]; float sq = 0.f;
#pragma unroll
                    for (int bj = 0; bj < 2; ++bj)
#pragma unroll
                        for (int n = 0; n < 2; ++n) { v[bj][n] = acc[ai][bj][m][n] * r; sq += sq4(v[bj][n]); }
                    sq += __shfl_xor(sq, 16); sq += __shfl_xor(sq, 32);
                    const float ri = rsqrtf(sq * (1.0f / 64.0f) + EPS) * (isq ? C2 : 1.0f);
#pragma unroll
                    for (int bj = 0; bj < 2; ++bj)
                        *(u32x4*)(O + (size_t)row * 512 + head * 64 + bj * 32 + fq * 8) = pack8(v[bj][0] * ri * gv[bj][0], v[bj][1] * ri * gv[bj][1]);
                }
        } else if (pn <= 8) {
#pragma unroll
            for (int ai = 0; ai < 2; ++ai)
#pragma unroll
                for (int m = 0; m < 4; ++m) {
                    const int row = rows[ai][m]; const float r = rs[ai][m];
#pragma unroll
                    for (int bj = 0; bj < 2; ++bj)
                        *(u32x4*)(V + (size_t)row * 512 + (pn - 7) * 256 + bj * 128 + cl) = pack8(acc[ai][bj][m][0] * r, acc[ai][bj][m][1] * r);
                }
        } else {
            const int gc = (pn - 9) * 256, k = (pn - 9) >> 2, pnn = (pn - 9) & 3;
            unsigned char* gp = (unsigned char*)G + gate_off(u.pm, k, pnn, wr * 4 + wc, fq * 16 + fr);
            f32x4 gb[2][2];
#pragma unroll
            for (int bj = 0; bj < 2; ++bj)
#pragma unroll
                for (int n = 0; n < 2; ++n) gb[bj][n] = *(const LAS f32x4*)(cbl + bj * 128 + cl + n * 4);
#pragma unroll
            for (int ai = 0; ai < 2; ++ai)
#pragma unroll
                for (int m = 0; m < 4; ++m) {
                    const float r = rs[ai][m];
#pragma unroll
                    for (int bj = 0; bj < 2; ++bj) {
                        f32x4 a = acc[ai][bj][m][0] * r + gb[bj][0], b = acc[ai][bj][m][1] * r + gb[bj][1];
#pragma unroll
                        for (int j = 0; j < 4; ++j) { a[j] = sigmoid_f(a[j]); b[j] = sigmoid_f(b[j]); }
                        *(u32x2*)(gp + GATE_EL(ai, m, bj)) = pack8_u8(a, b);
                    }
                }
        }
    }
};
struct StoreGemm : g8::DenseBase {
    static constexpr bool PERM = true;
    int nfree, rank, nunits;
    __device__ __forceinline__ bool next(int i, Unit& u) const { if (rank < 0) return false; const int p = i * nfree + rank; if (p >= nunits) return false; u.pm = p >> 2; u.pn = p & 3; return true; }
    __device__ __forceinline__ void epi(Acc& acc, const Unit& u, int wr, int wc, int fr, int fq) const {
        fr = opaque(fr); fq = opaque(fq);
        unsigned long long z_ = 0; asm volatile("" : "+s"(z_)); unsigned char* w_ = ws + z_; unsigned char* d_ = dout + z_;
        bf16_t* O = (l == 0) ? (bf16_t*)(d_ + DO_PY) : (bf16_t*)(w_ + WS_XA); const int ldo = 1024;
        const int row0 = opaque(u.pm * 256 + wr * 64 + fr), cl = u.pn * 256 + wc * 32 + fq * 8;
#pragma unroll
        for (int ai = 0; ai < 2; ++ai)
#pragma unroll
            for (int m = 0; m < 4; ++m) {
                const int row = row0 + ai * 128 + m * 16;
#pragma unroll
                for (int bj = 0; bj < 2; ++bj) *(u32x4*)(O + (size_t)row * ldo + bj * 128 + cl) = pack8(acc[ai][bj][m][0], acc[ai][bj][m][1]);
            }
    }
};
struct BranchGemm : g8::DenseBase {
    static constexpr bool PERM = true;
    __device__ __forceinline__ void mid(Acc& acc, const Unit& u, int kdone, int wr, int wc, int fr, int fq) const {
        if (kdone != 4 && kdone != 8) return;
        fr = opaque(fr); fq = opaque(fq);
        const int k0 = (kdone == 4) ? 0 : 1;
        unsigned long long z_ = 0; asm volatile("" : "+s"(z_)); unsigned char* w_ = ws + z_; unsigned char* d_ = dout + z_;
        const bf16_t* G = (const bf16_t*)(w_ + WS_G);
        const int lane = opaque(fq * 16 + fr);
        const unsigned char* gn = (const unsigned char*)G + gate_off(u.pm, k0, u.pn, wr * 4 + wc, lane); const unsigned char* gd = (const unsigned char*)G + gate_off(u.pm, k0 + 1, u.pn, wr * 4 + wc, lane);
#pragma unroll
        for (int ai = 0; ai < 2; ++ai) {
            u32x2 nv[4][2], dv[4][2];
#pragma unroll
            for (int m = 0; m < 4; ++m)
#pragma unroll
                for (int bj = 0; bj < 2; ++bj) { nv[m][bj] = *(const u32x2*)(gn + GATE_EL(ai, m, bj)); dv[m][bj] = *(const u32x2*)(gd + GATE_EL(ai, m, bj)); }
#pragma unroll
            for (int m = 0; m < 4; ++m)
#pragma unroll
                for (int bj = 0; bj < 2; ++bj) { f32x4 na, nb, da, db; unpack8_u8(nv[m][bj], na, nb); unpack8_u8(dv[m][bj], da, db);
#pragma unroll
                    for (int j = 0; j < 4; ++j) { acc[ai][bj][m][0][j] *= na[j] * fast_rcp(da[j]); acc[ai][bj][m][1][j] *= nb[j] * fast_rcp(db[j]); } }
            asm volatile("" ::: "memory");
        }
    }
    __device__ __forceinline__ void epi(Acc& acc, const Unit& u, int wr, int wc, int fr, int fq) const {
        fr = opaque(fr); fq = opaque(fq);
        unsigned long long z_ = 0; asm volatile("" : "+s"(z_)); unsigned char* w_ = ws + z_; unsigned char* d_ = dout + z_;
        const bf16_t* G = (const bf16_t*)(w_ + WS_G); bf16_t* Mg = (bf16_t*)(w_ + WS_MERGED);
        const int row0 = opaque(u.pm * 256 + wr * 64 + fr), cl = u.pn * 256 + wc * 32 + fq * 8;
        const unsigned char* gc = (const unsigned char*)G + gate_off(u.pm, 2, u.pn, wr * 4 + wc, fq * 16 + fr);
        u32x2 gv[2][4][2];
#pragma unroll
        for (int ai = 0; ai < 2; ++ai)
#pragma unroll
            for (int m = 0; m < 4; ++m)
#pragma unroll
                for (int bj = 0; bj < 2; ++bj) gv[ai][m][bj] = *(const u32x2*)(gc + GATE_EL(ai, m, bj));
#pragma unroll
        for (int ai = 0; ai < 2; ++ai)
#pragma unroll
            for (int m = 0; m < 4; ++m) {
                const int row = row0 + ai * 128 + m * 16;
#pragma unroll
                for (int bj = 0; bj < 2; ++bj) { f32x4 ga, gb; unpack8_u8(gv[ai][m][bj], ga, gb);
                    *(u32x4*)(Mg + (size_t)row * 1024 + bj * 128 + cl) = pack8(acc[ai][bj][m][0] * (ga * (1.0f / 255.0f)), acc[ai][bj][m][1] * (gb * (1.0f / 255.0f))); }
            }
    }
};
struct OutGemm : g8::DenseBase {
    static constexpr bool PERM = true;
    float alpha;
    __device__ __forceinline__ void epi(Acc& acc, const Unit& u, int wr, int wc, int fr, int fq) const {
        fr = opaque(fr); fq = opaque(fq);
        unsigned long long z_ = 0; asm volatile("" : "+s"(z_)); unsigned char* w_ = ws + z_; unsigned char* d_ = dout + z_;
        bf16_t* X = (bf16_t*)(w_ + (l == 0 ? WS_XA : WS_XB)); float* ss = (float*)(w_ + WS_SS1);
        const int row0 = opaque(u.pm * 256 + wr * 64 + fr), cl = u.pn * 256 + wc * 32 + fq * 8;
#pragma unroll
        for (int ai = 0; ai < 2; ++ai) {
            u32x4 xv[4][2];
#pragma unroll
            for (int m = 0; m < 4; ++m)
#pragma unroll
                for (int bj = 0; bj < 2; ++bj) xv[m][bj] = *(const u32x4*)(X + (size_t)(row0 + ai * 128 + m * 16) * 1024 + bj * 128 + cl);
#pragma unroll
            for (int m = 0; m < 4; ++m) {
                const int row = row0 + ai * 128 + m * 16; float sq = 0.f;
#pragma unroll
                for (int bj = 0; bj < 2; ++bj) { f32x4 pa, pb; unpack8(xv[m][bj], pa, pb);
                    const f32x4 na = pa + acc[ai][bj][m][0] * alpha, nb = pb + acc[ai][bj][m][1] * alpha; const u32x4 w = pack8(na, nb); sq += sqpk(w);
                    *(u32x4*)(X + (size_t)row * 1024 + bj * 128 + cl) = w; *(u32x2*)(w_ + WS_X8 + (size_t)row * 1024 + bj * 128 + cl) = pack8_fp8(na, nb, SX8); }
                sq += __shfl_xor(sq, 16); sq += __shfl_xor(sq, 32);
                if (fq == 0) ss[(size_t)row * 16 + u.pn * 4 + wc] = sq;
            }
            asm volatile("" ::: "memory");
        }
    }
};
struct PleGemm : g8::DenseBase {
    static constexpr bool PERM = true;
    int lastl; float gsc;
    __device__ __forceinline__ void epi(Acc& acc, const Unit& u, int wr, int wc, int fr, int fq) const {
        fr = opaque(fr); fq = opaque(fq);
        unsigned long long z_ = 0; asm volatile("" : "+s"(z_)); unsigned char* w_ = ws + z_; unsigned char* d_ = dout + z_;
        const bf16_t* X = (const bf16_t*)(w_ + (l == 0 ? WS_XA : WS_XB)); bf16_t* Xn = (bf16_t*)(w_ + (l == 0 ? WS_XB : WS_XA)); const bf16_t* Pp = (l == 0) ? (const bf16_t*)(d_ + DO_PY) : (const bf16_t*)(w_ + WS_XA);
        const float* ss2 = (const float*)(w_ + WS_SS2); float* ssn = (float*)(w_ + WS_SSX); float* out = (float*)d_; unsigned char* X8n = w_ + WS_X8;
        const int row0 = opaque(u.pm * 256 + wr * 64 + fr), cl = u.pn * 256 + wc * 32 + fq * 8;
        int rows[2][4]; rows8(row0, rows); float rs[2][4]; rstd8(ss2, rows, fq, rs);
#pragma unroll
        for (int ai = 0; ai < 2; ++ai)
#pragma unroll
            for (int m = 0; m < 4; ++m) rs[ai][m] *= gsc;
#pragma unroll
        for (int ai = 0; ai < 2; ++ai)
#pragma unroll
            for (int mp = 0; mp < 2; ++mp) {
                u32x4 xv[2][2], pv[2][2];
#pragma unroll
                for (int mm = 0; mm < 2; ++mm)
#pragma unroll
                    for (int bj = 0; bj < 2; ++bj) { const size_t off = (size_t)rows[ai][mp * 2 + mm] * 1024 + bj * 128 + cl; xv[mm][bj] = *(const u32x4*)(X + off); pv[mm][bj] = *(const u32x4*)(Pp + off); }
#pragma unroll
                for (int mm = 0; mm < 2; ++mm) {
                    const int m = mp * 2 + mm; const int row = rows[ai][m]; const float r = rs[ai][m]; float sq = 0.f;
#pragma unroll
                    for (int bj = 0; bj < 2; ++bj) {
                        const size_t off = (size_t)row * 1024 + bj * 128 + cl;
                        f32x4 xa, xb, pa, pb; unpack8(xv[mm][bj], xa, xb); unpack8(pv[mm][bj], pa, pb);
                        f32x4 a = acc[ai][bj][m][0] * r, b = acc[ai][bj][m][1] * r;
#pragma unroll
                        for (int j = 0; j < 4; ++j) { a[j] = xa[j] + pa[j] * sigmoid_f(a[j]); b[j] = xb[j] + pb[j] * sigmoid_f(b[j]); }
                        if (lastl) { *(f32x4*)(out + off) = a; *(f32x4*)(out + off + 4) = b; }
                        else { const u32x4 w = pack8(a, b); sq += sqpk(w); *(u32x4*)(Xn + off) = w; *(u32x2*)(X8n + off) = pack8_fp8(a, b, SX8); }
                    }
                    if (!lastl) { sq += __shfl_xor(sq, 16); sq += __shfl_xor(sq, 32); if (fq == 0) ssn[(size_t)row * 16 + u.pn * 4 + wc] = sq; }
                }
                asm volatile("" ::: "memory");
            }
    }
};

#define XB_TMO      128
#define XB_XCNT(j)  (256  + 64 * (j))
#define XB_XSUB(j)  (1280 + 64 * (j))
#define XB_XGEN(j)  (2304 + 64 * (j))
#define XB_TOP      3328
#define XB_TOPGEN   3392
#define XCD_BAR_WORDS 3456
#define XB_SPIN_CAP (1u << 18)

__device__ __forceinline__ unsigned xb_ld(unsigned* p)              { return __hip_atomic_load(p, __ATOMIC_RELAXED, __HIP_MEMORY_SCOPE_AGENT); }
__device__ __forceinline__ unsigned xb_add(unsigned* p, unsigned v) { return __hip_atomic_fetch_add(p, v, __ATOMIC_RELAXED, __HIP_MEMORY_SCOPE_AGENT); }
__device__ __forceinline__ unsigned xb_xcc_id() { return (unsigned)__builtin_amdgcn_s_getreg((3 << 11) | 20) & 0xFu; }
#define XB_SPIN(cond, bar) do { unsigned _sp = 0; while (cond) { __builtin_amdgcn_s_sleep(1); \
    if ((++_sp & 255u) == 0u) { if (xb_ld(&(bar)[XB_TMO])) break; if (_sp > XB_SPIN_CAP) { atomicAdd(&(bar)[XB_TMO], 1u); break; } } } } while (0)

struct XcdBarrier {
    unsigned* bar; unsigned x; int wave;
    volatile LAS unsigned* st;
};

__device__ __forceinline__ XcdBarrier xcd_barrier_post(unsigned* bar, volatile LAS unsigned* st, int wave) {
    XcdBarrier b; b.bar = bar; b.x = xb_xcc_id(); b.st = st; b.wave = wave;
    if (wave == 0 && hw_lane() == 0) (void)xb_add(&bar[XB_XCNT(b.x)], 1u);
    return b;
}
__device__ __forceinline__ void xcd_barrier_complete(unsigned* bar, unsigned x, unsigned& nloc, unsigned& nx) {
    const unsigned G = gridDim.x * gridDim.y * gridDim.z;
    unsigned sum, cnt, mine, sp = 0u;
    for (;;) {
        sum = 0u; cnt = 0u; mine = 0u;
#pragma unroll
        for (unsigned j = 0; j < 16; ++j) { const unsigned c = xb_ld(&bar[XB_XCNT(j)]); sum += c; cnt += (c > 0u) ? 1u : 0u; mine = (j == x) ? c : mine; }
        if (sum == G) break;
        __builtin_amdgcn_s_sleep(1);
        if ((++sp & 255u) == 0u) { if (xb_ld(&bar[XB_TMO])) break; if (sp > XB_SPIN_CAP) { atomicAdd(&bar[XB_TMO], 1u); break; } }
    }
    nloc = mine > 0u ? mine : 1u; nx = cnt > 0u ? cnt : 1u;
}

__device__ __forceinline__ void xcd_barrier(const XcdBarrier& b) {
    asm volatile("s_waitcnt vmcnt(0)" ::: "memory");
    __syncthreads();
    if (b.wave == 0 && opaque(hw_lane()) == 0) {
        unsigned long long zb_ = 0; unsigned bx = b.x; asm volatile("" : "+s"(zb_), "+s"(bx)); unsigned* bar = b.bar + zb_;
        __builtin_amdgcn_s_waitcnt(0);
        unsigned nloc = b.st[0], nx = b.st[1];
        if (nloc == 0u) { xcd_barrier_complete(bar, bx, nloc, nx); b.st[0] = nloc; b.st[1] = nx; }
        const unsigned old = xb_add(&bar[XB_XSUB(bx)], 1u);
        const unsigned gen = old / nloc;
        if (old + 1u == (gen + 1u) * nloc) {
            __builtin_amdgcn_fence(__ATOMIC_RELEASE, "agent");
            asm volatile("s_waitcnt vmcnt(0)" ::: "memory");
            const unsigned og = xb_add(&bar[XB_TOP], 1u);
            const unsigned tg = og / nx;
            if (og + 1u == (tg + 1u) * nx) xb_add(&bar[XB_TOPGEN], 1u);
            else XB_SPIN(xb_ld(&bar[XB_TOPGEN]) == tg, bar);
            __builtin_amdgcn_fence(__ATOMIC_ACQUIRE, "agent");
            xb_add(&bar[XB_XGEN(bx)], 1u);
            asm volatile("s_waitcnt vmcnt(0)" ::: "memory");
        } else {
            XB_SPIN(xb_ld(&bar[XB_XGEN(bx)]) == gen, bar);
            __builtin_amdgcn_fence(__ATOMIC_ACQUIRE, "agent");
            asm volatile("s_waitcnt vmcnt(0)" ::: "memory");
        }
    }
    __syncthreads();
}

struct Args { const float* in[27]; float* out; unsigned char* ws; int rep_n, pad; };
struct Frame {
    LAS unsigned char* lds; gu32* ctl; unsigned char* ws; unsigned char* dout;
    int tid, lane, wave, G, gw, NGW, bx;
    inptr_t in;
};

__device__ __forceinline__ void transpose_item(const float* src, int src_ld, int k0, int src_col0, bf16_t* dst, int dst_ld, int dst_row0, int dst_k0, const float* kscale, LAS float* scr, int lane, float fp8s = 0.f) {
#pragma unroll 8
    for (int i = 0; i < 32; ++i) { const int kk = 2 * i + (lane >> 5); float v = src[(size_t)(k0 + kk) * src_ld + src_col0 + (lane & 31)]; if (kscale) v *= kscale[k0 + kk]; scr[kk * 33 + (lane & 31)] = v; }
    asm volatile("s_waitcnt lgkmcnt(0)" ::: "memory");
    const int c = lane & 7;
#pragma unroll
    for (int j = 0; j < 4; ++j) { const int n = (lane >> 3) + 8 * j; const LAS float* s = scr + (8 * c) * 33 + n;
        if (fp8s != 0.f) { const f32x4 a = {s[0 * 33], s[1 * 33], s[2 * 33], s[3 * 33]}, b = {s[4 * 33], s[5 * 33], s[6 * 33], s[7 * 33]};
            *(u32x2*)((unsigned char*)dst + (size_t)(dst_row0 + n) * dst_ld + dst_k0 + k0 + 8 * c) = pack8_fp8(a, b, fp8s); continue; }
        u32x4 o; o.x = cvt_pk_bf16(s[0 * 33], s[1 * 33]); o.y = cvt_pk_bf16(s[2 * 33], s[3 * 33]); o.z = cvt_pk_bf16(s[4 * 33], s[5 * 33]); o.w = cvt_pk_bf16(s[6 * 33], s[7 * 33]);
        *(u32x4*)(dst + (size_t)(dst_row0 + n) * dst_ld + dst_k0 + k0 + 8 * c) = o; }
    asm volatile("s_waitcnt lgkmcnt(0)" ::: "memory");
}
__device__ __forceinline__ void transpose_item64(const float* src, int src_ld, int k0, int col0a, int col0b, bf16_t* dst, int dst_ld, int dst_row0, int dst_k0, const float* kscale, LAS float* scr, int lane, float fp8s = 0.f) {
    const int cq = lane & 15, kr = lane >> 4; const int scol = (cq < 8) ? col0a + 4 * cq : col0b + 4 * (cq - 8);
    f32x4 v[16];
#pragma unroll
    for (int i = 0; i < 16; ++i) v[i] = *(const f32x4*)(src + (size_t)(k0 + kr + 4 * i) * src_ld + scol);
    if (kscale) {
#pragma unroll
        for (int i = 0; i < 16; ++i) v[i] = v[i] * kscale[k0 + kr + 4 * i];
    }
#pragma unroll
    for (int i = 0; i < 16; ++i) { LAS float* p = scr + (4 * cq) * 65 + kr + 4 * i; p[0] = v[i][0]; p[65] = v[i][1]; p[130] = v[i][2]; p[195] = v[i][3]; }
    asm volatile("s_waitcnt lgkmcnt(0)" ::: "memory");
    const int c = lane & 7;
#pragma unroll
    for (int j = 0; j < 8; ++j) { const int n = (lane >> 3) + 8 * j; const LAS float* q = scr + n * 65 + 8 * c;
        const f32x4 a = {q[0], q[1], q[2], q[3]}, b = {q[4], q[5], q[6], q[7]};
        if (fp8s != 0.f) *(u32x2*)((unsigned char*)dst + (size_t)(dst_row0 + n) * dst_ld + dst_k0 + k0 + 8 * c) = pack8_fp8(a, b, fp8s);
        else *(u32x4*)(dst + (size_t)(dst_row0 + n) * dst_ld + dst_k0 + k0 + 8 * c) = pack8(a, b); }
    asm volatile("s_waitcnt lgkmcnt(0)" ::: "memory");
}
__device__ __forceinline__ int win_src_col(int n) {
    const int pn = n >> 8, c = n & 255;
    if (pn >= 3 && pn <= 6) { const int bj = c >> 7, wcc = (c >> 5) & 3; const int base = (pn <= 4) ? 768 : 1280; return base + (4 * ((pn - 3) & 1) + wcc) * 64 + 32 * bj; }
    return n;
}
__device__ __forceinline__ void prep_layer(Frame& Fr, int l) {
    Frame F = Fr; F.lane = opaque(hw_lane()); F.gw = F.bx * 8 + F.wave;
    LAS float* scr = (LAS float*)(F.lds + F.wave * 16896);
    const float* mixg = F.in[2] + (size_t)l * D; const float* w_in = F.in[3] + (size_t)l * D * NIN;
    const float* pool_w = F.in[4] + (size_t)l * 4 * 64 * 64; const float* pool_s = F.in[5] + (size_t)l * 256;
    const float* wba = F.in[13] + (size_t)l * 256 * D; const float* wbb = F.in[14] + (size_t)l * 256 * D; const float* wbc = F.in[15] + (size_t)l * 512 * D;
    const float* wout = F.in[16] + (size_t)l * D * D; const float* ffng = F.in[17] + (size_t)l * D;
    const float* wein = F.in[22] + (size_t)l * NEXP * D * 256; const float* weout = F.in[23] + (size_t)l * NEXP * DEXP * D;
    bf16_t* Win_t = (bf16_t*)(F.ws + WS_WIN); bf16_t* Wbr_t = (bf16_t*)(F.ws + WS_WBR); bf16_t* Wout_t = (bf16_t*)(F.ws + WS_WOUT);
    bf16_t* Wein_t = (bf16_t*)(F.ws + WS_WEIN); bf16_t* Weout_t = (bf16_t*)(F.ws + WS_WEOUT);
    constexpr int I_IN = 16 * 80, I_POOL = 1024, I_BA = 4 * 16, I_BC = 8 * 16, I_OUT = 16 * 16, I_EIN = NEXP * 16 * 4, I_EOUT = NEXP * 2 * 16;
    constexpr int NITEMS = I_IN + I_POOL + 2 * I_BA + I_BC + I_OUT + I_EIN + I_EOUT;
    for (int it = F.gw; it < NITEMS; it += F.NGW) {
        int r = it;
        if (r < I_IN) { const int kb = r / 80, nb = r % 80 + 4;
            if (nb < 12) transpose_item64(w_in, NIN, 64 * kb, 64 * nb, 64 * nb + 32, Win_t, D, 64 * nb, 0, mixg, scr, F.lane);
            else transpose_item64(w_in, NIN, 64 * kb, win_src_col(64 * nb), win_src_col(64 * nb + 32), (bf16_t*)(F.ws + WS_WIN8), D, 64 * nb - 768, 0, mixg, scr, F.lane, SW8);
            continue; } r -= I_IN;
        if (r < I_POOL) {
            const int nb = r & 7, kb = r >> 3, g = nb >> 1, d0 = (nb & 1) * 32, nn = F.lane & 31, kh = F.lane >> 5, kbase = kb * 8 + kh * 4;
            float a[4] = {0.f, 0.f, 0.f, 0.f};
#pragma unroll 8
            for (int c = 0; c < 64; ++c) { const float pw = pool_w[(size_t)g * 4096 + c * 64 + d0 + nn];
#pragma unroll
                for (int j = 0; j < 4; ++j) a[j] += w_in[(size_t)(kbase + j) * NIN + g * 64 + c] * pw; }
            const float sc = pool_s[g * 64 + d0 + nn];
            u32x2 o; o.x = cvt_pk_bf16(a[0] * sc * mixg[kbase], a[1] * sc * mixg[kbase + 1]); o.y = cvt_pk_bf16(a[2] * sc * mixg[kbase + 2], a[3] * sc * mixg[kbase + 3]);
            *(u32x2*)(Win_t + (size_t)(g * 64 + d0 + nn) * D + kbase) = o; continue; } r -= I_POOL;
        if (r < I_BA) { transpose_item64(wba, D, 64 * (r / 16), 64 * (r % 16), 64 * (r % 16) + 32, Wbr_t, D, 64 * (r % 16), 0, nullptr, scr, F.lane); continue; } r -= I_BA;
        if (r < I_BA) { transpose_item64(wbb, D, 64 * (r / 16), 64 * (r % 16), 64 * (r % 16) + 32, Wbr_t, D, 64 * (r % 16), 256, nullptr, scr, F.lane); continue; } r -= I_BA;
        if (r < I_BC) { transpose_item64(wbc, D, 64 * (r / 16), 64 * (r % 16), 64 * (r % 16) + 32, Wbr_t, D, 64 * (r % 16), 512, nullptr, scr, F.lane); continue; } r -= I_BC;
        if (r < I_OUT) { transpose_item64(wout, D, 64 * (r / 16), 64 * (r % 16), 64 * (r % 16) + 32, Wout_t, D, 64 * (r % 16), 0, nullptr, scr, F.lane); continue; } r -= I_OUT;
        if (r < I_EIN) { const int e = r / 64, q = r % 64; transpose_item64(wein + (size_t)e * D * 256, 256, 64 * (q / 4), 64 * (q % 4), 64 * (q % 4) + 32, (bf16_t*)((unsigned char*)Wein_t + (size_t)e * 256 * D), D, 64 * (q % 4), 0, ffng, scr, F.lane, SW8); continue; } r -= I_EIN;
        { const int e = r / 32, q = r % 32; transpose_item64(weout + (size_t)e * DEXP * D, D, 64 * (q / 16), 64 * (q % 16), 64 * (q % 16) + 32, Weout_t + (size_t)e * D * DEXP, DEXP, 64 * (q % 16), 0, nullptr, scr, F.lane); }
    }
    const float* p = F.in[1] + (size_t)l * M * PLE; bf16_t* pb = (bf16_t*)(F.ws + WS_PB);
#pragma unroll 4
    for (size_t i = (size_t)F.gw * 64 + F.lane; i < (size_t)M * PLE / 8; i += (size_t)F.NGW * 64) {
        const f32x4 a = *(const f32x4*)(p + i * 8), b = *(const f32x4*)(p + i * 8 + 4); *(u32x4*)(pb + i * 8) = pack8(a, b); }
}
__device__ __forceinline__ void prologue(Frame& Fr) {
    Frame F = Fr; F.lane = opaque(hw_lane()); F.gw = F.bx * 8 + F.wave;
    LAS float* scr = (LAS float*)(F.lds + F.wave * 16896);
    constexpr int I_G = 16 * 16, I_P = 4 * 16;
    for (int it = F.gw; it < DEPTH * (I_G + I_P); it += F.NGW) {
        const int l = it / (I_G + I_P); int r = it % (I_G + I_P);
        if (r < I_G) { transpose_item64(F.in[26] + (size_t)l * D * D, D, 64 * (r / 16), 64 * (r % 16), 64 * (r % 16) + 32, (bf16_t*)(F.ws + WS_WGATE + (size_t)l * 2 * MiB), D, 64 * (r % 16), 0, F.in[24] + (size_t)l * D, scr, F.lane, SW8); continue; } r -= I_G;
        transpose_item64(F.in[25] + (size_t)l * PLE * D, D, 64 * (r / 16), 64 * (r % 16), 64 * (r % 16) + 32, (bf16_t*)(F.ws + WS_WPLE) + (size_t)l * (512 * 1024), PLE, 64 * (r % 16), 0, nullptr, scr, F.lane);
    }
    for (int i = F.gw * 64 + F.lane; i < DEPTH * 96 * D; i += F.NGW * 64) {
        const int l = i / (96 * D), o = (i / D) % 96, k = i % D; bf16_t r = 0;
        if (o < 72) { const int oo = o < 36 ? o : o - 36;
            const float w = ((oo < 4) ? F.in[18][((size_t)l * D + k) * 4 + oo] : F.in[20][((size_t)l * D + k) * 32 + (oo - 4)]) * F.in[17][(size_t)l * D + k];
            const bf16_t h = f2bf(w); r = (o < 36) ? h : f2bf(w - bf2f(h)); }
        ((bf16_t*)(F.ws + WS_WR))[i] = r;
    }
    if (F.gw == 0) { for (int i = F.lane; i < DEPTH * 36; i += 64) { const int l = i / 36, o = i % 36; ((float*)(F.ws + WS_WR + WR_BIAS))[i] = (o < 4) ? F.in[19][l * 4 + o] : F.in[21][l * 32 + o - 4]; } }
    if (F.gw == 1) { for (int i = F.lane; i < DEPTH * 128; i += 64) { const int l = i >> 7, j = i & 127; ((float*)(F.ws + WS_MISC + MISC_GQK))[i] = (j < 64) ? F.in[9][l * 64 + j] : F.in[10][l * 64 + j - 64]; } }
    for (int i = F.gw * 64 + F.lane; i < DEPTH * 4 * 128 * 128; i += F.NGW * 64) { const int ii = (i >> 7) & 127, jj = i & 127; ((bf16_t*)(F.ws + WS_MISC + MISC_WM))[i] = ((jj >> 6) <= (ii >> 6)) ? f2bf(F.in[7][i]) : (bf16_t)0; }
    for (int i = F.gw * 64 + F.lane; i < DEPTH * 8 * 256; i += F.NGW * 64) { const int lh = i >> 8, ii = i & 255; const int idx = ii + 65 > 256 ? 256 : ii + 65; ((float*)(F.ws + WS_MISC + MISC_TB))[i] = F.in[11][(size_t)lh * 257 + idx] * LOG2E; }
    if (F.gw < DEPTH * 8) {
        const int l = F.gw >> 3; float mq = fabsf(F.in[9][l * 64 + F.lane]), mk = fabsf(F.in[10][l * 64 + F.lane]), mb = -1e30f;
        for (int i = F.lane; i < 257; i += 64) mb = fmaxf(mb, F.in[11][(size_t)F.gw * 257 + i]);
#pragma unroll
        for (int o = 1; o < 64; o <<= 1) { mq = fmaxf(mq, __shfl_xor(mq, o)); mk = fmaxf(mk, __shfl_xor(mk, o)); mb = fmaxf(mb, __shfl_xor(mb, o)); }
        if (F.lane == 0) ((float*)(F.ws + WS_MISC + MISC_ATTM))[F.gw] = (8.0f * mq * mk + mb) * LOG2E;
    }
    bf16_t* XA = (bf16_t*)(F.ws + WS_XA); float* ssx = (float*)(F.ws + WS_SSX);
    for (int m0 = F.gw * 4; m0 < M; m0 += F.NGW * 4) {
        f32x4 v[4][4];
#pragma unroll
        for (int q = 0; q < 4; ++q)
#pragma unroll
            for (int j = 0; j < 4; ++j) v[q][j] = ((const f32x4*)(F.in[0] + (size_t)(m0 + q) * D) + F.lane)[64 * j];
#pragma unroll
        for (int q = 0; q < 4; ++q) { const int m = m0 + q; float s = 0.f;
#pragma unroll
            for (int j = 0; j < 4; ++j) { const f32x4 x = v[q][j]; u32x2 w; w.x = cvt_pk_bf16(x[0], x[1]); w.y = cvt_pk_bf16(x[2], x[3]);
                const float a0 = bflo(w.x), a1 = bfhi(w.x), a2 = bflo(w.y), a3 = bfhi(w.y); s += (a0 * a0 + a1 * a1) + (a2 * a2 + a3 * a3);
                *(u32x2*)(XA + (size_t)m * D + 256 * j + 4 * F.lane) = w;
                { int p8 = __builtin_amdgcn_cvt_pk_fp8_f32(x[0] * SX8, x[1] * SX8, 0, false); p8 = __builtin_amdgcn_cvt_pk_fp8_f32(x[2] * SX8, x[3] * SX8, p8, true); *(int*)(F.ws + WS_X8 + (size_t)m * D + 256 * j + 4 * F.lane) = p8; } }
            s = wave_sum(s);
            if (F.lane < 16) ssx[(size_t)m * 16 + F.lane] = (F.lane == 0) ? s : 0.f; }
    }
}

__device__ __forceinline__ void router_phase(Frame& Fr, int l, const bf16_t* X, const float* ss1, bool dry) {
    typedef float f32x16 __attribute__((ext_vector_type(16)));
    Frame F = Fr; F.lane = opaque(hw_lane()); F.tid = F.wave * 64 + F.lane; F.gw = F.bx * 8 + F.wave;
    const int lane = F.lane, r16 = lane & 15, kq = lane >> 4;
    const bf16_t* Wt = (const bf16_t*)(F.ws + WS_WR) + (size_t)l * 96 * D; const float* br = (const float*)(F.ws + WS_WR + WR_BIAS) + l * 36;
    LAS float* lg;
    int* tok_e = (int*)(F.ws + WS_MISC + MISC_TOKE); float* tok_w = (float*)(F.ws + WS_MISC + MISC_TOKW);
    int* elist = (int*)(F.ws + WS_ELIST); int* plist = (int*)(F.ws + WS_PLIST);
    gu32* cnt = F.ctl + CW_CNT + (size_t)l * 160 * 64;
    LAS unsigned char* tb = F.lds; constexpr int TPITCH = 272, TBUF = 80 * TPITCH;
    lg = (LAS float*)(F.lds + 45056) + F.wave * (16 * 81);
    const int tid = F.tid;
    for (int wt = F.bx; wt < M / 128; wt += F.G) {
        const int tok0 = wt * 128 + F.wave * 16;
        const bf16_t* xr = X + (size_t)(tok0 + r16) * D + kq * 8;
        u32x4 tr[3]; bf16x8 xc[4], xn[4];
#define RT_LOADT(c) do { _Pragma("unroll") for (int p_ = 0; p_ < 3; ++p_) { const int pc_ = tid + 512 * p_; if (pc_ < 1280) tr[p_] = *(const u32x4*)(Wt + (size_t)(pc_ >> 4) * D + (c) * 128 + (pc_ & 15) * 8); } } while (0)
#define RT_STORET(b) do { _Pragma("unroll") for (int p_ = 0; p_ < 3; ++p_) { const int pc_ = tid + 512 * p_; if (pc_ < 1280) *(LAS u32x4*)(tb + (b) * TBUF + (pc_ >> 4) * TPITCH + (pc_ & 15) * 16) = tr[p_]; } } while (0)
        RT_LOADT(0);
#pragma unroll
        for (int s4 = 0; s4 < 4; ++s4) xc[s4] = *(const bf16x8*)(xr + 32 * s4);
        asm volatile("s_waitcnt lgkmcnt(0)\n\ts_barrier" ::: "memory");
        RT_STORET(0);
        f32x4 a0 = {0.f, 0.f, 0.f, 0.f}, a1 = a0, a2 = a0, a3 = a0, a4 = a0;
#pragma unroll 1
        for (int c = 0; c < 8; ++c) {
            if (c + 1 < 8) { RT_LOADT(c + 1);
#pragma unroll
                for (int s4 = 0; s4 < 4; ++s4) xn[s4] = *(const bf16x8*)(xr + 128 * (c + 1) + 32 * s4); }
            asm volatile("s_waitcnt lgkmcnt(0)\n\ts_barrier" ::: "memory");
            const LAS unsigned char* bb = tb + (c & 1) * TBUF + r16 * TPITCH + kq * 16;
#pragma unroll
            for (int s4 = 0; s4 < 4; ++s4) {
                const bf16x8 b0 = *(const LAS bf16x8*)(bb + s4 * 64), b1 = *(const LAS bf16x8*)(bb + 16 * TPITCH + s4 * 64), b2 = *(const LAS bf16x8*)(bb + 32 * TPITCH + s4 * 64),
                             b3 = *(const LAS bf16x8*)(bb + 48 * TPITCH + s4 * 64), b4 = *(const LAS bf16x8*)(bb + 64 * TPITCH + s4 * 64);
                a0 = __builtin_amdgcn_mfma_f32_16x16x32_bf16(xc[s4], b0, a0, 0, 0, 0); a1 = __builtin_amdgcn_mfma_f32_16x16x32_bf16(xc[s4], b1, a1, 0, 0, 0); a2 = __builtin_amdgcn_mfma_f32_16x16x32_bf16(xc[s4], b2, a2, 0, 0, 0);
                a3 = __builtin_amdgcn_mfma_f32_16x16x32_bf16(xc[s4], b3, a3, 0, 0, 0); a4 = __builtin_amdgcn_mfma_f32_16x16x32_bf16(xc[s4], b4, a4, 0, 0, 0);
            }
            if (c + 1 < 8) { RT_STORET((c + 1) & 1);
#pragma unroll
                for (int s4 = 0; s4 < 4; ++s4) xc[s4] = xn[s4]; }
        }
#undef RT_LOADT
#undef RT_STORET
#pragma unroll
        for (int r = 0; r < 4; ++r) { LAS float* p = lg + (4 * kq + r) * 81 + r16; p[0] = a0[r]; p[16] = a1[r]; p[32] = a2[r]; p[48] = a3[r]; p[64] = a4[r]; }
        asm volatile("s_waitcnt lgkmcnt(0)" ::: "memory");
        if (lane < 16) {
            const int tok = tok0 + lane; const LAS float* q = lg + lane * 81;
            const f32x4* sp = (const f32x4*)(ss1 + (size_t)tok * 16); const f32x4 s0 = sp[0], s1 = sp[1], s2 = sp[2], s3 = sp[3];
            const float ssum = (((s0[0] + s0[1]) + (s0[2] + s0[3])) + ((s1[0] + s1[1]) + (s1[2] + s1[3]))) + (((s2[0] + s2[1]) + (s2[2] + s2[3])) + ((s3[0] + s3[1]) + (s3[2] + s3[3])));
            const float rstd = rsqrtf(ssum * (1.0f / D) + EPS);
#define RLOGIT(o) ((q[(o)] + q[36 + (o)]) * rstd + br[(o)])
            int g = 0; float gm = RLOGIT(0); float gl[4]; gl[0] = gm;
#pragma unroll
            for (int j = 1; j < 4; ++j) { gl[j] = RLOGIT(j); if (gl[j] > gm) { gm = gl[j]; g = j; } }
            float gs = 0.f;
#pragma unroll
            for (int j = 0; j < 4; ++j) gs += __expf(gl[j] - gm);
            const float gp = 1.0f / gs;
            int i1 = 0, i2 = -1; float m1 = -3.0e38f, m2 = -3.0e38f;
            for (int j = 0; j < 8; ++j) { const float v = RLOGIT(4 + 8 * g + j); if (v > m1) { m2 = m1; i2 = i1; m1 = v; i1 = j; } else if (v > m2) { m2 = v; i2 = j; } }
#undef RLOGIT
            const float e2 = __expf(m2 - m1), w1 = gp / (1.0f + e2), w2 = gp * e2 / (1.0f + e2);
            const int a = i1 < i2 ? i1 : i2, b = i1 < i2 ? i2 : i1; const float wlo = i1 < i2 ? w1 : w2, whi = i1 < i2 ? w2 : w1;
            const int lo = g * 8 + a, hh = g * 8 + b, pc = g * 28 + (a * 8 - (a * (a + 1)) / 2) + (b - a - 1);
            tok_e[tok] = lo | (hh << 8) | (pc << 16); tok_w[2 * tok] = wlo; tok_w[2 * tok + 1] = whi;
            if (!dry) {
            const unsigned p0 = __hip_atomic_fetch_add(cnt + 64 * lo, 1u, __ATOMIC_RELAXED, __HIP_MEMORY_SCOPE_AGENT); elist[(size_t)lo * CAP + p0] = tok * 2;
            const unsigned p1 = __hip_atomic_fetch_add(cnt + 64 * hh, 1u, __ATOMIC_RELAXED, __HIP_MEMORY_SCOPE_AGENT); elist[(size_t)hh * CAP + p1] = tok * 2 + 1;
            const unsigned p2 = __hip_atomic_fetch_add(cnt + 64 * (32 + pc), 1u, __ATOMIC_RELAXED, __HIP_MEMORY_SCOPE_AGENT); plist[(size_t)pc * CAP + p2] = tok; }
        }
    }
    __syncthreads();
}

constexpr int LT_PRE = LDSCTL_OFF + 64, LT_CNT = LT_PRE + 116 * 4;
__device__ __forceinline__ void build_class_tables(Frame& F, gu32* cnt, int ncls) {
    LAS int* tpre = (LAS int*)(F.lds + LT_PRE); LAS int* ccnt = (LAS int*)(F.lds + LT_CNT);
    __syncthreads();
    const int tid = F.wave * 64 + opaque(hw_lane());
    if (tid < ncls) ccnt[tid] = (int)__hip_atomic_load(cnt + 64 * tid, __ATOMIC_RELAXED, __HIP_MEMORY_SCOPE_AGENT);
    __syncthreads();
    if (tid <= ncls) { int a = 0;
#pragma unroll 8
        for (int c = 0; c < tid; ++c) a += (ccnt[c] + 255) >> 8;
        tpre[tid] = a; }
    __syncthreads();
}
struct Moe1Gemm {
    struct Unit { int pm, pn, e, cnt; };
    static constexpr bool PERM = true, GATHER = true;
    const char* a_base; unsigned lda; const char* b_base; unsigned ldb; int nt; int G, c;
    unsigned char* ws; unsigned char* dout; const LAS int* tpre; const LAS int* ccnt;
    __device__ __forceinline__ bool next(int i, Unit& u) const {
        const int L = i * G + c; if (L >= tpre[NEXP]) return false;
        int e = 0;
#pragma unroll
        for (int st = 16; st >= 1; st >>= 1) { if (tpre[e + st] <= L) e += st; }
        u.e = e; u.pm = L - tpre[e]; u.pn = 0; u.cnt = ccnt[e]; return true;
    }
    __device__ __forceinline__ void a_off(const Unit& u, const int (&R)[2], const int (&C)[2], unsigned (&o)[2][2]) const {
        unsigned long long z_ = 0; asm volatile("" : "+s"(z_)); unsigned char* w_ = ws + z_; unsigned char* d_ = dout + z_;
        const int* elist = (const int*)(w_ + WS_ELIST);
#pragma unroll
        for (int h = 0; h < 2; ++h)
#pragma unroll
            for (int i = 0; i < 2; ++i) { const int r = u.pm * 256 + h * 128 + R[i]; const int ent = (r < u.cnt) ? elist[(size_t)u.e * CAP + r] : 0; o[h][i] = (unsigned)(ent >> 1) * lda + (unsigned)C[i] * 2u; }
    }
    static constexpr bool EPC = false;
    __device__ __forceinline__ void epc_issue(const Unit&, LAS unsigned char*, int, int) const {}
    __device__ __forceinline__ const char* a_tile(const Unit&) const { return a_base; }
    __device__ __forceinline__ const char* b_tile(const Unit& u, int kt) const { return b_base + (size_t)u.e * 256 * ldb + (size_t)kt * 128; }
    __device__ __forceinline__ void mid(Acc&, const Unit&, int, int, int, int, int) const {}
    __device__ __forceinline__ void epi(Acc& acc, const Unit& u, int wr, int wc, int fr, int fq) const {
        fr = opaque(fr); fq = opaque(fq);
        unsigned long long z_ = 0; asm volatile("" : "+s"(z_)); unsigned char* w_ = ws + z_; unsigned char* d_ = dout + z_;
        const int* elist = (const int*)(w_ + WS_ELIST); const float* tok_w = (const float*)(w_ + WS_MISC + MISC_TOKW); const float* ss1 = (const float*)(w_ + WS_SS1); bf16_t* H = (bf16_t*)(w_ + WS_H);
        const int r0 = opaque(u.pm * 256 + wr * 64 + fr);
        int ent[2][4], rows[2][4]; float rs[2][4], w[2][4];
#pragma unroll
        for (int ai = 0; ai < 2; ++ai)
#pragma unroll
            for (int m = 0; m < 4; ++m) { const int r = r0 + ai * 128 + m * 16; ent[ai][m] = (r < u.cnt) ? elist[(size_t)u.e * CAP + r] : -1; }
#pragma unroll
        for (int ai = 0; ai < 2; ++ai)
#pragma unroll
            for (int m = 0; m < 4; ++m) { const int e0 = ent[ai][m] < 0 ? 0 : ent[ai][m]; rows[ai][m] = e0 >> 1; w[ai][m] = tok_w[e0]; }
        rstd8(ss1, rows, fq, rs);
#pragma unroll
        for (int ai = 0; ai < 2; ++ai)
#pragma unroll
            for (int m = 0; m < 4; ++m) {
                const float r = rs[ai][m] * INV_S8, ww = w[ai][m]; f32x4 a, b;
#pragma unroll
                for (int j = 0; j < 4; ++j) { a[j] = silu_f(acc[ai][0][m][0][j] * r) * (acc[ai][1][m][0][j] * r) * ww; b[j] = silu_f(acc[ai][0][m][1][j] * r) * (acc[ai][1][m][1][j] * r) * ww; }
                if (ent[ai][m] >= 0) *(u32x4*)(H + (size_t)rows[ai][m] * 256 + (ent[ai][m] & 1) * 128 + wc * 32 + fq * 8) = pack8(a, b);
            }
    }
};
struct Moe2Gemm {
    struct Unit { int pm, pn, lo, hi, cnt, pc; };
    static constexpr bool PERM = true, GATHER = true;
    const char* a_base; unsigned lda; const char* b_base; unsigned ldb; int nt; int G, c;
    unsigned char* ws; unsigned char* dout; int l; const LAS int* tpre; const LAS int* ccnt; float alpha;
    __device__ __forceinline__ bool next(int i, Unit& u) const {
        const int L = i * G + c, T = L >> 2; if (T >= tpre[NPAIR]) return false;
        int pc = 0;
#pragma unroll
        for (int st = 64; st >= 1; st >>= 1) { if (pc + st <= NPAIR && tpre[pc + st] <= T) pc += st; }
        u.pc = pc; u.pm = T - tpre[pc]; u.pn = L & 3; u.cnt = ccnt[pc];
        const int g = pc / 28; int pi = pc - g * 28, a = 0; while (pi >= 7 - a) { pi -= 7 - a; ++a; }
        u.lo = g * 8 + a; u.hi = g * 8 + a + 1 + pi; return true;
    }
    __device__ __forceinline__ void a_off(const Unit& u, const int (&R)[2], const int (&C)[2], unsigned (&o)[2][2]) const {
        unsigned long long z_ = 0; asm volatile("" : "+s"(z_)); unsigned char* w_ = ws + z_; unsigned char* d_ = dout + z_;
        const int* plist = (const int*)(w_ + WS_PLIST);
#pragma unroll
        for (int h = 0; h < 2; ++h)
#pragma unroll
            for (int i = 0; i < 2; ++i) { const int r = u.pm * 256 + h * 128 + R[i]; const int tok = (r < u.cnt) ? plist[(size_t)u.pc * CAP + r] : 0; o[h][i] = (unsigned)tok * lda + (unsigned)C[i] * 2u; }
    }
    static constexpr bool EPC = false;
    __device__ __forceinline__ void epc_issue(const Unit&, LAS unsigned char*, int, int) const {}
    __device__ __forceinline__ const char* a_tile(const Unit&) const { return a_base; }
    __device__ __forceinline__ const char* b_tile(const Unit& u, int kt) const { return b_base + (size_t)(kt < 2 ? u.lo : u.hi) * D * ldb + (size_t)u.pn * 256 * ldb + (size_t)(kt & 1) * 128; }
    __device__ __forceinline__ void mid(Acc&, const Unit&, int, int, int, int, int) const {}
    __device__ __forceinline__ void epi(Acc& acc, const Unit& u, int wr, int wc, int fr, int fq) const {
        fr = opaque(fr); fq = opaque(fq);
        unsigned long long z_ = 0; asm volatile("" : "+s"(z_)); unsigned char* w_ = ws + z_; unsigned char* d_ = dout + z_;
        const int* plist = (const int*)(w_ + WS_PLIST); bf16_t* X = (bf16_t*)(w_ + (l == 0 ? WS_XA : WS_XB)); float* ss = (float*)(w_ + WS_SS2); unsigned char* X8p = w_ + WS_X8P;
        const int r0 = opaque(u.pm * 256 + wr * 64 + fr), cl = u.pn * 256 + wc * 32 + fq * 8;
        int tok[2][4];
#pragma unroll
        for (int ai = 0; ai < 2; ++ai)
#pragma unroll
            for (int m = 0; m < 4; ++m) { const int r = r0 + ai * 128 + m * 16; tok[ai][m] = (r < u.cnt) ? plist[(size_t)u.pc * CAP + r] : -1; }
#pragma unroll
        for (int ai = 0; ai < 2; ++ai) {
            u32x4 xv[4][2];
#pragma unroll
            for (int m = 0; m < 4; ++m)
#pragma unroll
                for (int bj = 0; bj < 2; ++bj) xv[m][bj] = *(const u32x4*)(X + (size_t)(tok[ai][m] < 0 ? 0 : tok[ai][m]) * 1024 + bj * 128 + cl);
#pragma unroll
            for (int m = 0; m < 4; ++m) {
                const bool ok = tok[ai][m] >= 0; const size_t t = ok ? tok[ai][m] : 0; float sq = 0.f;
#pragma unroll
                for (int bj = 0; bj < 2; ++bj) { f32x4 pa, pb; unpack8(xv[m][bj], pa, pb);
                    const f32x4 na = pa + acc[ai][bj][m][0] * alpha, nb = pb + acc[ai][bj][m][1] * alpha; const u32x4 w = pack8(na, nb); sq += sqpk(w);
                    if (ok) { *(u32x4*)(X + t * 1024 + bj * 128 + cl) = w; *(u32x2*)(X8p + t * 1024 + bj * 128 + cl) = pack8_fp8(na, nb, SX8); } }
                sq += __shfl_xor(sq, 16); sq += __shfl_xor(sq, 32);
                if (ok && fq == 0) ss[t * 16 + u.pn * 4 + wc] = sq;
            }
            asm volatile("" ::: "memory");
        }
    }
};

namespace att {
typedef float f32x16 __attribute__((ext_vector_type(16)));
typedef short s16x4 __attribute__((ext_vector_type(4)));
constexpr int LK = 0, LV = 24576, LWS = 49152, LOST = 51200, LTB = 83968, LDS_NEED = 84992;
__device__ __forceinline__ int crow(int r, int hi) { return (r & 3) + 8 * (r >> 2) + 4 * hi; }
__device__ __forceinline__ void glds16(const void* gsrc, unsigned lds_dst) { unsigned keep;
    asm volatile("s_mov_b32 %0, m0\n\ts_mov_b32 m0, %2\n\ts_nop 0\n\tglobal_load_lds_dwordx4 %1, off\n\ts_mov_b32 m0, %0" : "=&s"(keep) : "v"(gsrc), "s"(lds_dst) : "memory"); }
__device__ __forceinline__ void attn_unit(int b, int cq, int h, const bf16_t* Q, const bf16_t* K, const bf16_t* V, bf16_t* Y, LAS unsigned char* lds, const float* tbg, float negM, const int wv) {
    const int wid = wv, lane = opaque(hw_lane()), tid = wid * 64 + lane, r32 = lane & 31, hi = lane >> 5;
    const long rowbase = (long)b * SEQ; const int q0 = cq * 256;
    const bf16_t* Qw = Q + (rowbase + q0 + wid * 32) * 512 + h * 64;
    const bf16_t* Kh = K + rowbase * 512 + h * 64; const bf16_t* Vh = V + rowbase * 512 + h * 64;
    const unsigned lds0 = (unsigned)(uintptr_t)lds;
    LAS float* tbl = (LAS float*)(lds + LTB);
    const bf16_t* ksrc = Kh + (long)lane * 512 + wid * 8;
    const bf16_t* vsrc = Vh + (long)(16 * (wid & 3) + (lane >> 2)) * 512 + (wid >> 2) * 32 + (lane & 3) * 8;
    const unsigned kdst = lds0 + LK + wid * 1024, vdst = lds0 + LV + wid * 1024;
    const int ci = wid >> 1, jfirst = (cq >= 2) ? 0 : 8 - 4 * cq;
#define ATT_DMA(j, sl) do { const long ko_ = (long)(4 * cq - 8 + (j)) * 64 * 512; glds16(ksrc + ko_, (unsigned)__builtin_amdgcn_readfirstlane(kdst + (sl) * 8192)); glds16(vsrc + ko_, (unsigned)__builtin_amdgcn_readfirstlane(vdst + (sl) * 8192)); } while (0)
    ATT_DMA(jfirst, 0);
    if (jfirst + 1 < 12) ATT_DMA(jfirst + 1, 1);
    const float tfar = tbg[255]; float tv = 0.f; if (tid < 256) tv = tbg[tid];
    bf16x8 qr[4];
#pragma unroll
    for (int d0 = 0; d0 < 4; ++d0) qr[d0] = *(const bf16x8*)(Qw + (long)r32 * 512 + d0 * 16 + hi * 8);
    if (tid < 256) tbl[tid] = tv + negM;
    const float negMfar = negM + tfar;
    asm volatile("" : "+v"(qr[0]), "+v"(qr[1]), "+v"(qr[2]), "+v"(qr[3]));
    f32x16 cfar;
#pragma unroll
    for (int r = 0; r < 16; ++r) cfar[r] = negMfar;
    asm volatile("" : "+v"(cfar));
    const u32x4 ones = {0x3f803f80u, 0x3f803f80u, 0x3f803f80u, 0x3f803f80u};
    f32x16 o0 = {}, o1 = {}, ol = {};
    int slot = 0, j = jfirst;
#define ATT_SYNC() do {   \
        if (j + 1 < 12) asm volatile("s_waitcnt vmcnt(2) lgkmcnt(0)\n\ts_barrier" ::: "memory"); else asm volatile("s_waitcnt vmcnt(0) lgkmcnt(0)\n\ts_barrier" ::: "memory"); \
        if (j + 2 < 12) ATT_DMA(j + 2, (slot + 2) % 3); } while (0)
#define ATT_NEXT() do { slot = (slot + 1) % 3; ++j; } while (0)
#define ATT_TILE(NEAR) do { \
        const unsigned kb = lds0 + LK + slot * 8192 + hi * 1024 + r32 * 16; \
        const int vb = (int)(lds0 + LV + slot * 8192) + ((lane >> 4) & 1) * 32 + (lane & 3) * 8 + (4 * hi + ((lane & 15) >> 2)) * 64; \
        u32x4 kf[8]; f32x16 p0, p1; \
        _Pragma("unroll") for (int d0 = 0; d0 < 4; ++d0) { \
            asm volatile("ds_read_b128 %0,%1 offset:%c2" : "=&v"(kf[2 * d0]) : "v"(kb), "i"(d0 * 2048) : "memory"); \
            asm volatile("ds_read_b128 %0,%1 offset:%c2" : "=&v"(kf[2 * d0 + 1]) : "v"(kb), "i"(d0 * 2048 + 512) : "memory"); } \
        if (NEAR) { const int delta = ci + 8 - j;                    \
            const LAS float* tb = tbl + (32 * (wid & 1) + r32 + 64 * delta + 63 - 4 * hi); f32x16 t0, t1; \
            _Pragma("unroll") for (int r = 0; r < 16; ++r) { const int cr = (r & 3) + 8 * (r >> 2); t0[r] = tb[-cr]; t1[r] = tb[-cr - 32]; } \
            p0 = __builtin_amdgcn_mfma_f32_32x32x16_bf16(__builtin_bit_cast(bf16x8, kf[0]), qr[0], t0, 0, 0, 0); p1 = __builtin_amdgcn_mfma_f32_32x32x16_bf16(__builtin_bit_cast(bf16x8, kf[1]), qr[0], t1, 0, 0, 0); \
        } else { asm volatile("s_waitcnt lgkmcnt(6)" ::: "memory"); __builtin_amdgcn_sched_barrier(0); \
            p0 = __builtin_amdgcn_mfma_f32_32x32x16_bf16(__builtin_bit_cast(bf16x8, kf[0]), qr[0], cfar, 0, 0, 0); p1 = __builtin_amdgcn_mfma_f32_32x32x16_bf16(__builtin_bit_cast(bf16x8, kf[1]), qr[0], cfar, 0, 0, 0); } \
        asm volatile("s_waitcnt lgkmcnt(4)" ::: "memory"); __builtin_amdgcn_sched_barrier(0); \
        p0 = __builtin_amdgcn_mfma_f32_32x32x16_bf16(__builtin_bit_cast(bf16x8, kf[2]), qr[1], p0, 0, 0, 0); p1 = __builtin_amdgcn_mfma_f32_32x32x16_bf16(__builtin_bit_cast(bf16x8, kf[3]), qr[1], p1, 0, 0, 0); \
        asm volatile("s_waitcnt lgkmcnt(2)" ::: "memory"); __builtin_amdgcn_sched_barrier(0); \
        p0 = __builtin_amdgcn_mfma_f32_32x32x16_bf16(__builtin_bit_cast(bf16x8, kf[4]), qr[2], p0, 0, 0, 0); p1 = __builtin_amdgcn_mfma_f32_32x32x16_bf16(__builtin_bit_cast(bf16x8, kf[5]), qr[2], p1, 0, 0, 0); \
        asm volatile("s_waitcnt lgkmcnt(0)" ::: "memory"); __builtin_amdgcn_sched_barrier(0); \
        p0 = __builtin_amdgcn_mfma_f32_32x32x16_bf16(__builtin_bit_cast(bf16x8, kf[6]), qr[3], p0, 0, 0, 0); p1 = __builtin_amdgcn_mfma_f32_32x32x16_bf16(__builtin_bit_cast(bf16x8, kf[7]), qr[3], p1, 0, 0, 0); \
        __builtin_amdgcn_sched_barrier(0); \
        s16x4 vlo[2][4], vhi[2][4];                                  \
        _Pragma("unroll") for (int d0 = 0; d0 < 2; ++d0) _Pragma("unroll") for (int ks = 0; ks < 4; ++ks) { \
            asm volatile("ds_read_b64_tr_b16 %0,%1 offset:%c2" : "=&v"(vlo[d0][ks]) : "v"(vb), "i"(d0 * 4096 + ks * 1024) : "memory"); \
            asm volatile("ds_read_b64_tr_b16 %0,%1 offset:%c2" : "=&v"(vhi[d0][ks]) : "v"(vb), "i"(d0 * 4096 + ks * 1024 + 512) : "memory"); } \
        _Pragma("unroll") for (int r = 0; r < 16; ++r) { p0[r] = fast_exp2(p0[r]); p1[r] = fast_exp2(p1[r]); } \
        u32x4 pw0, pw1, pw2, pw3; \
        pw0 = (u32x4){cvt_pk_bf16(p0[0], p0[1]), cvt_pk_bf16(p0[2], p0[3]), cvt_pk_bf16(p0[4], p0[5]), cvt_pk_bf16(p0[6], p0[7])}; \
        pw1 = (u32x4){cvt_pk_bf16(p0[8], p0[9]), cvt_pk_bf16(p0[10], p0[11]), cvt_pk_bf16(p0[12], p0[13]), cvt_pk_bf16(p0[14], p0[15])}; \
        pw2 = (u32x4){cvt_pk_bf16(p1[0], p1[1]), cvt_pk_bf16(p1[2], p1[3]), cvt_pk_bf16(p1[4], p1[5]), cvt_pk_bf16(p1[6], p1[7])}; \
        pw3 = (u32x4){cvt_pk_bf16(p1[8], p1[9]), cvt_pk_bf16(p1[10], p1[11]), cvt_pk_bf16(p1[12], p1[13]), cvt_pk_bf16(p1[14], p1[15])}; \
        asm volatile("s_waitcnt lgkmcnt(0)" : "+v"(pw0), "+v"(pw1), "+v"(pw2), "+v"(pw3) :: "memory"); __builtin_amdgcn_sched_barrier(0); \
        o0 = __builtin_amdgcn_mfma_f32_32x32x16_bf16(__builtin_bit_cast(bf16x8, pw0), ATT_PK(0, 0), o0, 0, 0, 0); o1 = __builtin_amdgcn_mfma_f32_32x32x16_bf16(__builtin_bit_cast(bf16x8, pw0), ATT_PK(1, 0), o1, 0, 0, 0); \
        ol = __builtin_amdgcn_mfma_f32_32x32x16_bf16(__builtin_bit_cast(bf16x8, pw0), __builtin_bit_cast(bf16x8, ones), ol, 0, 0, 0); \
        o0 = __builtin_amdgcn_mfma_f32_32x32x16_bf16(__builtin_bit_cast(bf16x8, pw1), ATT_PK(0, 1), o0, 0, 0, 0); o1 = __builtin_amdgcn_mfma_f32_32x32x16_bf16(__builtin_bit_cast(bf16x8, pw1), ATT_PK(1, 1), o1, 0, 0, 0); \
        ol = __builtin_amdgcn_mfma_f32_32x32x16_bf16(__builtin_bit_cast(bf16x8, pw1), __builtin_bit_cast(bf16x8, ones), ol, 0, 0, 0); \
        o0 = __builtin_amdgcn_mfma_f32_32x32x16_bf16(__builtin_bit_cast(bf16x8, pw2), ATT_PK(0, 2), o0, 0, 0, 0); o1 = __builtin_amdgcn_mfma_f32_32x32x16_bf16(__builtin_bit_cast(bf16x8, pw2), ATT_PK(1, 2), o1, 0, 0, 0); \
        ol = __builtin_amdgcn_mfma_f32_32x32x16_bf16(__builtin_bit_cast(bf16x8, pw2), __builtin_bit_cast(bf16x8, ones), ol, 0, 0, 0); \
        o0 = __builtin_amdgcn_mfma_f32_32x32x16_bf16(__builtin_bit_cast(bf16x8, pw3), ATT_PK(0, 3), o0, 0, 0, 0); o1 = __builtin_amdgcn_mfma_f32_32x32x16_bf16(__builtin_bit_cast(bf16x8, pw3), ATT_PK(1, 3), o1, 0, 0, 0); \
        ol = __builtin_amdgcn_mfma_f32_32x32x16_bf16(__builtin_bit_cast(bf16x8, pw3), __builtin_bit_cast(bf16x8, ones), ol, 0, 0, 0); \
    } while (0)
#define ATT_PK(d, k) (bf16x8){vlo[d][k][0], vlo[d][k][1], vlo[d][k][2], vlo[d][k][3], vhi[d][k][0], vhi[d][k][1], vhi[d][k][2], vhi[d][k][3]}
    asm volatile("s_waitcnt lgkmcnt(0)\n\ts_barrier" ::: "memory");
    for (; j < ci; ) { ATT_SYNC(); ATT_NEXT(); }
    for (; j < ci + 6; ) { ATT_SYNC(); ATT_TILE(false); ATT_NEXT(); }
    for (; j <= ci + 8; ) { ATT_SYNC(); ATT_TILE(true); ATT_NEXT(); }
    for (; j < 12; ) { ATT_SYNC(); ATT_NEXT(); }
#undef ATT_PK
#undef ATT_TILE
#undef ATT_NEXT
#undef ATT_SYNC
#undef ATT_DMA
    bf16_t* Ow = Y + (rowbase + q0 + wid * 32) * 1024 + 512 + h * 64;
    LAS bf16_t* stg = (LAS bf16_t*)(lds + LOST) + wid * 2048;
#pragma unroll
    for (int r = 0; r < 16; ++r) { const int orow = crow(r, hi); const float rl = fast_rcp(ol[r]);
        stg[orow * 64 + r32] = f2bf(o0[r] * rl); stg[orow * 64 + 32 + r32] = f2bf(o1[r] * rl); }
    asm volatile("s_waitcnt lgkmcnt(0)" ::: "memory");
#pragma unroll
    for (int i = 0; i < 4; ++i) { const int row = i * 8 + (lane >> 3), ch = lane & 7; const u32x4 v = *(const LAS u32x4*)(stg + row * 64 + ch * 8); *(u32x4*)(Ow + (long)row * 1024 + ch * 8) = v; }
    asm volatile("s_waitcnt lgkmcnt(0)\n\ts_barrier" ::: "memory");
}
__device__ __forceinline__ void attn_phase(Frame& F, int l, bf16_t* Y) {
    const bf16_t* Q = (const bf16_t*)(F.dout + DO_Q); const bf16_t* K = (const bf16_t*)(F.dout + DO_K); const bf16_t* V = (const bf16_t*)(F.ws + WS_V);
    const float* tb = (const float*)(F.ws + WS_MISC + MISC_TB) + (size_t)l * 8 * 256; const float* am = (const float*)(F.ws + WS_MISC + MISC_ATTM) + l * 8;
    const bool hfix = (F.G & 7) == 0;
    const float negM0 = -__hip_atomic_load(am + (F.bx & 7), __ATOMIC_RELAXED, __HIP_MEMORY_SCOPE_AGENT);
    for (int u = F.bx; u < 4 * 32 * 8; u += F.G) {
        const int h = u & 7, cq = (u >> 3) & 31, b = u >> 8;
        const float negM = hfix ? negM0 : -__hip_atomic_load(am + h, __ATOMIC_RELAXED, __HIP_MEMORY_SCOPE_AGENT);
        attn_unit(b, cq, h, Q, K, V, Y, F.lds, tb + h * 256, negM, F.wave);
    }
}
}

__device__ __forceinline__ void sgu_unit(Frame& F, int l, int blk, int gp, bf16_t* Y) {
    using namespace att;
    const int wid = F.wave, lane = opaque(hw_lane()), tid = wid * 64 + lane, r32 = lane & 31, hi = lane >> 5;
    LAS unsigned char* lds = F.lds; const unsigned lds0 = (unsigned)(uintptr_t)lds;
    const bf16_t* Zu = (const bf16_t*)(F.ws + WS_ZU); const bf16_t* Zv = (const bf16_t*)(F.ws + WS_ZV); const float* ssv = (const float*)(F.ws + WS_SSV);
    const bf16_t* Wm = (const bf16_t*)(F.ws + WS_MISC + MISC_WM) + (size_t)l * 4 * 16384;
    const float* gn = F.in[6] + l * 256; const float* b_s = F.in[8] + l * 512;
    const long t0 = (long)blk * 128; const int rb = wid & 3, gi = wid >> 2, g = 2 * gp + gi;
    LAS float* rst = (LAS float*)(lds + 32768); LAS float* stg = (LAS float*)(lds + 34816) + wid * 2048;
#pragma unroll
    for (int sl = 0; sl < 4; ++sl) { const int jt = sl & 1, gg = 2 * gp + (sl >> 1);
        const bf16_t* vsrc = Zv + (t0 + 64 * jt + 16 * (wid & 3) + (lane >> 2)) * 256 + gg * 64 + (wid >> 2) * 32 + (lane & 3) * 8;
        glds16(vsrc, (unsigned)__builtin_amdgcn_readfirstlane(lds0 + sl * 8192 + wid * 1024)); }
    if (tid < 128) { const f32x4 v = *(const f32x4*)(ssv + (t0 + tid) * 4); rst[tid] = rsqrtf(((v[0] + v[1]) + (v[2] + v[3])) * (1.0f / 256.0f) + EPS); }
    asm volatile("s_waitcnt vmcnt(0) lgkmcnt(0)\n\ts_barrier" ::: "memory");
    f32x16 o0 = {}, o1 = {};
    const int njt = rb < 2 ? 1 : 2;
    for (int jt = 0; jt < njt; ++jt) {
        const bf16_t* wrow = Wm + (size_t)g * 16384 + (size_t)(32 * rb + r32) * 128 + 64 * jt + 4 * hi;
        float p0[16], p1[16];
#pragma unroll
        for (int rg = 0; rg < 4; ++rg) {
            const u32x2 w0 = *(const u32x2*)(wrow + 8 * rg), w1 = *(const u32x2*)(wrow + 8 * rg + 32);
            const f32x4 r0 = *(const LAS f32x4*)(rst + 64 * jt + 8 * rg + 4 * hi), r1 = *(const LAS f32x4*)(rst + 64 * jt + 8 * rg + 4 * hi + 32);
            p0[4 * rg] = bflo(w0.x) * r0[0]; p0[4 * rg + 1] = bfhi(w0.x) * r0[1]; p0[4 * rg + 2] = bflo(w0.y) * r0[2]; p0[4 * rg + 3] = bfhi(w0.y) * r0[3];
            p1[4 * rg] = bflo(w1.x) * r1[0]; p1[4 * rg + 1] = bfhi(w1.x) * r1[1]; p1[4 * rg + 2] = bflo(w1.y) * r1[2]; p1[4 * rg + 3] = bfhi(w1.y) * r1[3];
        }
        u32x4 pw0, pw1, pw2, pw3;
        pw0 = (u32x4){cvt_pk_bf16(p0[0], p0[1]), cvt_pk_bf16(p0[2], p0[3]), cvt_pk_bf16(p0[4], p0[5]), cvt_pk_bf16(p0[6], p0[7])};
        pw1 = (u32x4){cvt_pk_bf16(p0[8], p0[9]), cvt_pk_bf16(p0[10], p0[11]), cvt_pk_bf16(p0[12], p0[13]), cvt_pk_bf16(p0[14], p0[15])};
        pw2 = (u32x4){cvt_pk_bf16(p1[0], p1[1]), cvt_pk_bf16(p1[2], p1[3]), cvt_pk_bf16(p1[4], p1[5]), cvt_pk_bf16(p1[6], p1[7])};
        pw3 = (u32x4){cvt_pk_bf16(p1[8], p1[9]), cvt_pk_bf16(p1[10], p1[11]), cvt_pk_bf16(p1[12], p1[13]), cvt_pk_bf16(p1[14], p1[15])};
        const int vb = (int)(lds0 + (gi * 2 + jt) * 8192) + ((lane >> 4) & 1) * 32 + (lane & 3) * 8 + (4 * hi + ((lane & 15) >> 2)) * 64;
#pragma unroll
        for (int d0 = 0; d0 < 2; ++d0) { s16x4 vlo[4], vhi[4];
#pragma unroll
            for (int ks = 0; ks < 4; ++ks) {
                asm volatile("ds_read_b64_tr_b16 %0,%1 offset:%c2" : "=&v"(vlo[ks]) : "v"(vb), "i"(d0 * 4096 + ks * 1024) : "memory");
                asm volatile("ds_read_b64_tr_b16 %0,%1 offset:%c2" : "=&v"(vhi[ks]) : "v"(vb), "i"(d0 * 4096 + ks * 1024 + 512) : "memory"); }
            asm volatile("s_waitcnt lgkmcnt(0)" ::: "memory"); __builtin_amdgcn_sched_barrier(0);
#define SGU_PK(k) (bf16x8){vlo[k][0], vlo[k][1], vlo[k][2], vlo[k][3], vhi[k][0], vhi[k][1], vhi[k][2], vhi[k][3]}
            f32x16 oo = d0 == 0 ? o0 : o1;
            oo = __builtin_amdgcn_mfma_f32_32x32x16_bf16(__builtin_bit_cast(bf16x8, pw0), SGU_PK(0), oo, 0, 0, 0);
            oo = __builtin_amdgcn_mfma_f32_32x32x16_bf16(__builtin_bit_cast(bf16x8, pw1), SGU_PK(1), oo, 0, 0, 0);
            oo = __builtin_amdgcn_mfma_f32_32x32x16_bf16(__builtin_bit_cast(bf16x8, pw2), SGU_PK(2), oo, 0, 0, 0);
            oo = __builtin_amdgcn_mfma_f32_32x32x16_bf16(__builtin_bit_cast(bf16x8, pw3), SGU_PK(3), oo, 0, 0, 0);
#undef SGU_PK
            if (d0 == 0) o0 = oo; else o1 = oo;
        }
    }
    const float g0 = gn[g * 64 + r32], g1 = gn[g * 64 + 32 + r32];
#pragma unroll
    for (int r = 0; r < 16; ++r) { const int orow = crow(r, hi); const float bb = b_s[g * 128 + 32 * rb + orow];
        stg[orow * 64 + r32] = o0[r] * g0 + bb; stg[orow * 64 + 32 + r32] = o1[r] * g1 + bb; }
    asm volatile("s_waitcnt lgkmcnt(0)" ::: "memory");
#pragma unroll
    for (int i = 0; i < 4; ++i) { const int row = i * 8 + (lane >> 3), ch = lane & 7; const long t = t0 + 32 * rb + row;
        const f32x4 m0 = *(const LAS f32x4*)(stg + row * 64 + ch * 8), m1 = *(const LAS f32x4*)(stg + row * 64 + ch * 8 + 4);
        f32x4 ua, ub; unpack8(*(const u32x4*)(Zu + t * 256 + g * 64 + ch * 8), ua, ub);
        *(u32x4*)(Y + t * 1024 + 256 + g * 64 + ch * 8) = pack8(ua * m0, ub * m1); }
    asm volatile("s_waitcnt lgkmcnt(0)\n\ts_barrier" ::: "memory");
}
__device__ __forceinline__ void sgu_pool_phase(Frame& F, int l, bf16_t* Y, const int parts = 3) {
    if (parts & 1) for (int u = F.bx; u < 4 * 64 * 2; u += F.G) sgu_unit(F, l, u >> 1, u & 1, Y);
    if (!(parts & 2)) return;
    const bf16_t* Za = (const bf16_t*)(F.ws + WS_ZA);
    for (int it = F.bx * 512 + F.wave * 64 + opaque(hw_lane()); it < (M / 16) * 32; it += F.G * 512) {
        const int ch = it & 31, t0 = (it >> 5) * 16, w = 2 << (ch >> 3), s0 = t0 & (SEQ - 1);
        const bf16_t* zp = Za + (size_t)t0 * 256 + ch * 8;
        f32x4 sa = {0.f, 0.f, 0.f, 0.f}, sb = sa;
#pragma unroll
        for (int j = 1; j < 16; ++j) { if (j < w && j <= s0) { f32x4 a, b; unpack8(*(const u32x4*)(zp - (size_t)j * 256), a, b); sa += a; sb += b; } }
#pragma unroll
        for (int i = 0; i < 16; ++i) {
            f32x4 a, b; unpack8(*(const u32x4*)(zp + (size_t)i * 256), a, b); sa += a; sb += b;
            const int s = s0 + i; const int cnt = (s + 1 < w) ? s + 1 : w; const float ic = 1.0f / (float)cnt;
            *(u32x4*)(Y + (size_t)(t0 + i) * 1024 + ch * 8) = pack8(sa * ic - a, sb * ic - b);
            if (s + 1 >= w) { f32x4 oa, ob; unpack8(*(const u32x4*)(zp + ((ptrdiff_t)i + 1 - w) * 256), oa, ob); sa -= oa; sb -= ob; }
        }
    }
}

constexpr int NPH = 1 + 8 * DEPTH;
#ifndef PROBE_PHASE
#define PROBE_PHASE 0
#define PROBE_N 1
#endif
#ifndef PROBE_SUB
#define PROBE_SUB 0
#endif
#ifndef PHMASK
#define PHMASK 0xFFFF
#endif
#define EN(b) ((PHMASK >> (b)) & 1)
__global__ void __launch_bounds__(512, 2) fwd(Args args) {
    extern __shared__ __attribute__((aligned(16))) unsigned char lds_raw[];
    Frame F;
    F.lds = (LAS unsigned char*)lds_raw; F.ws = args.ws; F.dout = (unsigned char*)args.out; F.ctl = (gu32*)(args.ws + WS_CTL); F.in = (inptr_t)__builtin_amdgcn_kernarg_segment_ptr();
    F.tid = -1; F.lane = -1; F.wave = __builtin_amdgcn_readfirstlane(threadIdx.x >> 6); F.G = gridDim.x;
    F.bx = blockIdx.x; F.gw = F.bx * 8 + F.wave; F.NGW = F.G * 8;
    for (int u = threadIdx.x; u < (LDS_BYTES - LDSCTL_OFF) / 4; u += 512) ((LAS unsigned*)(F.lds + LDSCTL_OFF))[u] = 0u;
    __syncthreads();
    XcdBarrier bar = xcd_barrier_post((unsigned*)(F.ctl + CW_BAR), (volatile LAS unsigned*)(F.lds + LDSCTL_OFF), F.wave);
#define IN(k) true
#define SEAM(k) xcd_barrier(bar)
    for (int rp_ = 0, nr_ = (PROBE_PHASE == 9 ? args.rep_n : 1); rp_ < nr_; ++rp_) { if (rp_) xcd_barrier(bar);
    if (EN(0) && IN(0)) { prologue(F); prep_layer(F, 0); } }
    SEAM(0);
    if (PROBE_PHASE == 10) for (int rp_ = 0; rp_ < 16 * (args.rep_n - 1); ++rp_) xcd_barrier(bar);
    unsigned char* const ws0 = F.ws; unsigned char* const do0 = F.dout; const inptr_t in0 = (inptr_t)__builtin_amdgcn_kernarg_segment_ptr(); const int bx0 = blockIdx.x, G0 = gridDim.x;
    for (int l = 0; l < DEPTH; ++l) {
        const int pb = 1 + 8 * l;
#define OPQ() unsigned long long zq_ = 0; inptr_t inq = in0; asm volatile("" : "+s"(zq_), "+s"(inq)); unsigned char* ws = ws0 + zq_; unsigned char* dout = do0 + zq_; F.ws = ws; F.dout = dout; F.in = inq; \
        int bx_ = bx0, G_ = G0; asm volatile("" : "+s"(bx_), "+s"(G_)); F.bx = bx_; F.G = G_; F.gw = bx_ * 8 + F.wave; F.NGW = G_ * 8; \
        bf16_t* Xc = (bf16_t*)(ws + (l == 0 ? WS_XA : WS_XB)); bf16_t* Xo = (bf16_t*)(ws + (l == 0 ? WS_XB : WS_XA)); \
        bf16_t* Y = (l == 0) ? Xo : (bf16_t*)(dout + DO_PY); float* ss1 = (float*)(ws + WS_SS1); \
        (void)Xc; (void)Xo; (void)Y; (void)ss1;
#define SETB(S) do { (S).ws = ws; (S).dout = dout; (S).l = l; } while (0)
        for (int rp_ = 0, nr_ = (PROBE_PHASE == 1 ? args.rep_n : 1); rp_ < nr_; ++rp_) { if (rp_) xcd_barrier(bar);
        if (EN(1) && IN(pb + 0)) { OPQ();
            InGemm S; SETB(S); S.inq = inq; S.a_base = (const char*)Xc; S.lda = 2048; S.b_base = (const char*)(ws + WS_WIN); S.ldb = 2048; S.nt = 16; S.ord.init(M, 768, F.G, bx_); S.pn_off = 0; S.gsc = 1.f; S.epc = F.lds + g8::STAGE_BYTES;
            g8::gemm_phase(F.lds, S, F.wave);
            S.a_base = (const char*)(ws + WS_X8); S.lda = 1024; S.b_base = (const char*)(ws + WS_WIN8); S.ldb = 1024; S.nt = 8; S.ord.init(M, 4608, F.G, bx_); S.pn_off = 3; S.gsc = INV_S8;
            g8::gemm_phase<InGemm, false, true>(F.lds, S, F.wave);
        }
        }
        SEAM(pb + 0);
        for (int rp_ = 0, nr_ = (PROBE_PHASE == 2 ? args.rep_n : 1); rp_ < nr_; ++rp_) { if (rp_) xcd_barrier(bar);
        if (EN(2) && IN(pb + 1)) { OPQ(); const int sub_ = rp_ ? PROBE_SUB : 0; if (sub_ == 0 || sub_ == 1) att::attn_phase(F, l, Y); if (sub_ != 1) sgu_pool_phase(F, l, Y, sub_ == 2 ? 1 : (sub_ == 3 ? 2 : 3)); }
        }
        SEAM(pb + 1);
        for (int rp_ = 0, nr_ = (PROBE_PHASE == 3 ? args.rep_n : 1); rp_ < nr_; ++rp_) { if (rp_) xcd_barrier(bar);
        if (EN(3) && IN(pb + 2)) { OPQ();
            BranchGemm S; SETB(S); S.a_base = (const char*)Y; S.lda = 2048; S.b_base = (const char*)(ws + WS_WBR); S.ldb = 2048; S.nt = 16; S.ord.init(M, D, F.G, bx_);
            g8::gemm_phase<BranchGemm, true>(F.lds, S, F.wave);
        }
        }
        SEAM(pb + 2);
        for (int rp_ = 0, nr_ = (PROBE_PHASE == 4 ? args.rep_n : 1); rp_ < nr_; ++rp_) { if (rp_) xcd_barrier(bar);
        if (EN(4) && IN(pb + 3)) { OPQ();
            OutGemm S; SETB(S); S.a_base = (const char*)(ws + WS_MERGED); S.lda = 2048; S.b_base = (const char*)(ws + WS_WOUT); S.ldb = 2048; S.nt = 16; S.ord.init(M, D, F.G, bx_);
            S.alpha = rp_ ? 0.f : 1.f; g8::gemm_phase(F.lds, S, F.wave);
        }
        }
        SEAM(pb + 3);
        for (int rp_ = 0, nr_ = (PROBE_PHASE == 5 ? args.rep_n : 1); rp_ < nr_; ++rp_) { if (rp_) xcd_barrier(bar);
        if (EN(5) && IN(pb + 4)) { OPQ(); router_phase(F, l, Xc, ss1, rp_ > 0); }
        }
        SEAM(pb + 4);
        for (int rp_ = 0, nr_ = (PROBE_PHASE == 6 ? args.rep_n : 1); rp_ < nr_; ++rp_) { if (rp_) xcd_barrier(bar);
        if (EN(6) && IN(pb + 5)) { OPQ();
            gu32* cnt = (gu32*)(ws + WS_CTL) + CW_CNT + (size_t)l * 160 * 64;
            build_class_tables(F, cnt, NEXP);
            Moe1Gemm S; S.ws = ws; S.dout = dout; S.a_base = (const char*)(ws + WS_X8); S.lda = 1024; S.b_base = (const char*)(ws + WS_WEIN); S.ldb = 1024; S.nt = 8; S.G = F.G; S.c = bx_;
            S.tpre = (const LAS int*)(F.lds + LT_PRE); S.ccnt = (const LAS int*)(F.lds + LT_CNT);
            const int tot1 = S.tpre[NEXP];
            g8::gemm_phase<Moe1Gemm, false, true>(F.lds, S, F.wave);
            StoreGemm P; SETB(P); P.a_base = (const char*)(ws + WS_PB); P.lda = 512; P.b_base = (const char*)(ws + WS_WPLE + (size_t)l * MiB); P.ldb = 512; P.nt = 4;
            { const int extra = (tot1 > F.G && tot1 < 2 * F.G) ? tot1 - F.G : 0; P.nfree = F.G - extra; P.rank = (int)bx_ - extra; P.nunits = (M / 256) * 4; }
            g8::gemm_phase(F.lds, P, F.wave);
        }
        }
        SEAM(pb + 5);
        for (int rp_ = 0, nr_ = (PROBE_PHASE == 7 ? args.rep_n : 1); rp_ < nr_; ++rp_) { if (rp_) xcd_barrier(bar);
        if (EN(7) && IN(pb + 6)) { OPQ();
            gu32* cnt = (gu32*)(ws + WS_CTL) + CW_CNT + (size_t)l * 160 * 64 + 32 * 64;
            build_class_tables(F, cnt, NPAIR);
            Moe2Gemm S; S.ws = ws; S.dout = dout; S.l = l; S.a_base = (const char*)(ws + WS_H); S.lda = 512; S.b_base = (const char*)(ws + WS_WEOUT); S.ldb = 256; S.nt = 4; S.G = F.G; S.c = bx_;
            S.alpha = rp_ ? 0.f : 1.f;
            S.tpre = (const LAS int*)(F.lds + LT_PRE); S.ccnt = (const LAS int*)(F.lds + LT_CNT);
            g8::gemm_phase(F.lds, S, F.wave);
        }
        }
        SEAM(pb + 6);
        for (int rp_ = 0, nr_ = (PROBE_PHASE == 8 ? args.rep_n : 1); rp_ < nr_; ++rp_) { if (rp_) xcd_barrier(bar);
        if (EN(8) && IN(pb + 7)) { OPQ();
            if (l + 1 < DEPTH) { prep_layer(F, l + 1); __syncthreads(); }
            PleGemm S; SETB(S); S.a_base = (const char*)(ws + WS_X8P); S.lda = 1024; S.b_base = (const char*)(ws + WS_WGATE + (size_t)l * 2 * MiB); S.ldb = 1024; S.nt = 8; S.ord.init(M, D, F.G, bx_);
            S.lastl = (l == DEPTH - 1); S.gsc = INV_S8;
            g8::gemm_phase<PleGemm, false, true>(F.lds, S, F.wave);
        }
        }
        if (l + 1 < DEPTH) SEAM(pb + 7);
    }
#undef SETB
#undef OPQ
#undef IN
#undef SEAM
}

#ifndef N_LAUNCHES
#define N_LAUNCHES 1
#endif
extern "C" void kernel_launch(void* const* d_in, const int* in_sizes, int n_in, void* d_out, int out_size, void* d_ws, size_t ws_size, hipStream_t stream) {
    static int grid = 0;
    if (grid == 0) {
        if (n_in != 27 || out_size != M * D || ws_size < WS_END) { fprintf(stderr, "kernel_launch: unexpected shapes (n_in %d out %d ws %zu)\n", n_in, out_size, ws_size); grid = -1; return; }
        int dev = 0, cus = 0;
        if (hipGetDevice(&dev) != hipSuccess || hipDeviceGetAttribute(&cus, hipDeviceAttributeMultiprocessorCount, dev) != hipSuccess) { grid = -1; return; }
        if (hipFuncSetAttribute((const void*)fwd, hipFuncAttributeMaxDynamicSharedMemorySize, LDS_BYTES) != hipSuccess) { fprintf(stderr, "kernel_launch: hipFuncSetAttribute failed\n"); grid = -1; return; }
        int per_cu = 0;
        if (hipOccupancyMaxActiveBlocksPerMultiprocessor(&per_cu, (const void*)fwd, 512, LDS_BYTES) != hipSuccess || per_cu < 1) fprintf(stderr, "kernel_launch: occupancy query says %d\n", per_cu);
        (void)hipGetLastError();
        grid = cus;
    }
    if (grid < 0) return;
    (void)hipMemsetAsync((char*)d_ws + WS_CTL, 0, CTL_ZERO_BYTES, stream);
    Args a{};
    for (int i = 0; i < 27; ++i) a.in[i] = (const float*)d_in[i];
    a.out = (float*)d_out; a.ws = (unsigned char*)d_ws; a.rep_n = PROBE_N;
    hipLaunchKernelGGL(fwd, dim3(grid), dim3(512), LDS_BYTES, stream, a);
}
```
